# Optimizing an MI355X kernel written in HIP

```python
import jax
import jax.numpy as jnp
from jax import lax
import numpy as np

D_MODEL = 1024
BATCH = 8
SEQ = 2048
DEPTH = 1
DEC_BATCH = 128
DEC_SEQ = 1
PAST_LEN = 16384
PAGE_SIZE = 128

MIX_WIDTH = D_MODEL
POOL_WIDTH = MIX_WIDTH // 2
POOL_WINDOWS = (2, 4, 8, 16)
POOL_GROUPS = len(POOL_WINDOWS)
POOL_GROUP_WIDTH = POOL_WIDTH // POOL_GROUPS
POOL_BUF = max(POOL_WINDOWS) - 1
GLA_WIDTH = MIX_WIDTH - POOL_WIDTH
GLA_HEADS = 4
GLA_DV = GLA_WIDTH // GLA_HEADS
GLA_DK = GLA_DV // 2
GLA_KEY_WIDTH = GLA_HEADS * GLA_DK
GLA_GATE_RANK = 16
GLA_GATE_NORM = 16.0
GLA_CHUNK = 64
MEM_TOKENS = 256
MEM_HEADS = 4
MEM_HEAD_DIM = D_MODEL // MEM_HEADS
D_FF = 4 * D_MODEL
EPS = 1e-6
SPLITS = (POOL_WIDTH, POOL_WIDTH + GLA_KEY_WIDTH, POOL_WIDTH + 2 * GLA_KEY_WIDTH,
          POOL_WIDTH + 2 * GLA_KEY_WIDTH + GLA_WIDTH, POOL_WIDTH + 2 * GLA_KEY_WIDTH + 2 * GLA_WIDTH)
IN_COLS = POOL_WIDTH + 2 * GLA_KEY_WIDTH + 2 * GLA_WIDTH + GLA_GATE_RANK

kernel_name = 'hybrid_pool_gla_memxattn_step'


def _rmsnorm(x, g):
    xf = x.astype(jnp.float32)
    r = xf * lax.rsqrt(jnp.mean(xf * xf, axis=-1, keepdims=True) + EPS)
    return (r * g.astype(jnp.float32)).astype(x.dtype)


def _pool_mixer(u_ext, n_prefix, w_pool, pool_scale):
    b, length, _ = u_ext.shape
    uf = u_ext.astype(jnp.float32)
    cs = jnp.concatenate([jnp.zeros((b, 1, POOL_WIDTH), jnp.float32), jnp.cumsum(uf, axis=1)], axis=1)
    idx = jnp.arange(n_prefix, length)
    u_new = uf[:, n_prefix:]
    outs = []
    for gi, w in enumerate(POOL_WINDOWS):
        c0 = gi * POOL_GROUP_WIDTH
        c1 = c0 + POOL_GROUP_WIDTH
        lo = jnp.maximum(idx + 1 - w, 0)
        win_sum = cs[:, idx + 1, c0:c1] - cs[:, lo, c0:c1]
        count = (idx + 1 - lo).astype(jnp.float32)[None, :, None]
        pooled = win_sum / count - u_new[:, :, c0:c1]
        outs.append(jnp.einsum('btc,cd->btd', pooled, w_pool[gi].astype(jnp.float32)))
    y = jnp.concatenate(outs, axis=-1) * pool_scale.astype(jnp.float32)
    return y.astype(u_ext.dtype)


def _to_chunks(a, n_chunks, chunk):
    b, t, h, d = a.shape
    pad = n_chunks * chunk - t
    a = jnp.pad(a.astype(jnp.float32), ((0, 0), (0, pad), (0, 0), (0, 0)))
    a = a.reshape(b, n_chunks, chunk, h, d)
    return jnp.transpose(a, (1, 0, 3, 2, 4))


def _gla(q, k, v, log_f, s0):
    b, t = q.shape[:2]
    chunk = min(GLA_CHUNK, t)
    n_chunks = -(-t // chunk)
    qc, kc, vc, gc = (_to_chunks(a, n_chunks, chunk) for a in (q, k, v, log_f))
    cum = jnp.cumsum(gc, axis=3)
    cum_last = cum[:, :, :, -1:, :]
    q_dec = qc * jnp.exp(cum)
    k_inv = kc * jnp.exp(-cum)
    k_end = kc * jnp.exp(cum_last - cum)
    causal = jnp.tril(jnp.ones((chunk, chunk), jnp.float32))
    scores = jnp.einsum('nbhid,nbhjd->nbhij', q_dec, k_inv) * causal
    o_intra = jnp.einsum('nbhij,nbhjv->nbhiv', scores, vc)

    def step(state, inp):
        q_c, k_c, v_c, last_c = inp
        o_c = jnp.einsum('bhid,bhdv->bhiv', q_c, state)
        state = jnp.exp(last_c[:, :, 0, :])[..., None] * state + jnp.einsum('bhjd,bhjv->bhdv', k_c, v_c)
        return state, o_c

    s_fin, o_inter = lax.scan(step, s0.astype(jnp.float32), (q_dec, k_end, vc, cum_last))
    o = jnp.transpose(o_intra + o_inter, (1, 0, 3, 2, 4)).reshape(b, n_chunks * chunk, GLA_HEADS, GLA_DV)
    return o[:, :t], s_fin


def _mem_kv(mem, mem_norm_g, w_km, w_vm):
    b = mem.shape[0]
    mn = _rmsnorm(mem, mem_norm_g)
    mk = jnp.einsum('bmd,dc->bmc', mn, w_km).reshape(b, MEM_TOKENS, MEM_HEADS, MEM_HEAD_DIM)
    mv = jnp.einsum('bmd,dc->bmc', mn, w_vm).reshape(b, MEM_TOKENS, MEM_HEADS, MEM_HEAD_DIM)
    return mk, mv


def _layer(x, pool_prefix, gla_state, mem_k, mem_v, norm_mix_g, w_in, w_forget_up, b_forget, w_pool,
           pool_scale, gla_norm_g, w_out, norm_mem_g, w_qm, w_om, norm_ffn_g, w_up, w_down):
    b, t, _ = x.shape
    h = _rmsnorm(x, norm_mix_g)
    proj = jnp.einsum('btd,dc->btc', h, w_in)
    u, q, k, v, gate, f_low = jnp.split(proj, SPLITS, axis=-1)
    u_ext = jnp.concatenate([pool_prefix.astype(u.dtype), u], axis=1)
    pool_out = _pool_mixer(u_ext, pool_prefix.shape[1], w_pool, pool_scale)
    new_pool = u_ext[:, -POOL_BUF:]
    log_f = jax.nn.log_sigmoid((jnp.einsum('btr,rk->btk', f_low, w_forget_up) + b_forget).astype(jnp.float32)) / GLA_GATE_NORM
    q = q.reshape(b, t, GLA_HEADS, GLA_DK) * (GLA_DK ** -0.5)
    k = k.reshape(b, t, GLA_HEADS, GLA_DK)
    v = v.reshape(b, t, GLA_HEADS, GLA_DV)
    log_f = log_f.reshape(b, t, GLA_HEADS, GLA_DK)
    o, new_gla = _gla(q, k, v, log_f, gla_state)
    o = _rmsnorm(o, gla_norm_g).reshape(b, t, GLA_WIDTH).astype(x.dtype) * jax.nn.silu(gate)
    mixed = jnp.concatenate([pool_out, o], axis=-1)
    x = x + jnp.einsum('btc,cd->btd', mixed, w_out)
    hm = _rmsnorm(x, norm_mem_g)
    qm = jnp.einsum('btd,dc->btc', hm, w_qm).reshape(b, t, MEM_HEADS, MEM_HEAD_DIM)
    s = jnp.einsum('bthd,bmhd->bhtm', qm.astype(jnp.float32), mem_k.astype(jnp.float32)) * (MEM_HEAD_DIM ** -0.5)
    p = jax.nn.softmax(s, axis=-1)
    ctx = jnp.einsum('bhtm,bmhd->bthd', p, mem_v.astype(jnp.float32)).reshape(b, t, D_MODEL).astype(x.dtype)
    x = x + jnp.einsum('btc,cd->btd', ctx, w_om)
    hf = _rmsnorm(x, norm_ffn_g)
    a = jax.nn.relu(jnp.einsum('btd,df->btf', hf, w_up))
    x = x + jnp.einsum('btf,fd->btd', a * a, w_down)
    return x, new_pool, new_gla.astype(gla_state.dtype)


def setup_inputs(seed: int = 0) -> dict:
    key = jax.random.key(seed)
    ks = jax.random.split(key, 32)
    f32 = jnp.float32

    def nrm(k, shape, scale):
        return jax.random.normal(k, shape, f32) * scale

    def gain(k, shape):
        return 1.0 + 0.02 * jax.random.normal(k, shape, f32)

    L = DEPTH
    return {
        'x_prompt': nrm(ks[0], (BATCH, SEQ, D_MODEL), 1.0),
        'x_sample': nrm(ks[1], (DEC_BATCH, DEC_SEQ, D_MODEL), 1.0),
        'state_pool': nrm(ks[2], (L, DEC_BATCH, POOL_BUF, POOL_WIDTH), 1.0),
        'state_gla': nrm(ks[3], (L, DEC_BATCH, GLA_HEADS, GLA_DK, GLA_DV), 0.5),
        'cache_mem_k': nrm(ks[4], (L, DEC_BATCH, MEM_TOKENS, MEM_HEADS, MEM_HEAD_DIM), 1.0),
        'cache_mem_v': nrm(ks[5], (L, DEC_BATCH, MEM_TOKENS, MEM_HEADS, MEM_HEAD_DIM), 1.0),
        'mem_prompt': nrm(ks[6], (BATCH, MEM_TOKENS, D_MODEL), 1.0),
        'norm_mix_g': gain(ks[7], (L, D_MODEL)),
        'w_in': nrm(ks[8], (L, D_MODEL, IN_COLS), D_MODEL ** -0.5),
        'w_forget_up': nrm(ks[9], (L, GLA_GATE_RANK, GLA_KEY_WIDTH), GLA_GATE_RANK ** -0.5),
        'b_forget': nrm(ks[10], (L, GLA_KEY_WIDTH), 0.1),
        'w_pool': nrm(ks[11], (L, POOL_GROUPS, POOL_GROUP_WIDTH, POOL_GROUP_WIDTH), POOL_GROUP_WIDTH ** -0.5),
        'pool_scale': gain(ks[12], (L, POOL_WIDTH)),
        'gla_norm_g': gain(ks[13], (L, GLA_HEADS, GLA_DV)),
        'w_out': nrm(ks[14], (L, MIX_WIDTH, D_MODEL), MIX_WIDTH ** -0.5),
        'mem_norm_g': gain(ks[15], (L, D_MODEL)),
        'w_km': nrm(ks[16], (L, D_MODEL, D_MODEL), D_MODEL ** -0.5),
        'w_vm': nrm(ks[17], (L, D_MODEL, D_MODEL), D_MODEL ** -0.5),
        'norm_mem_g': gain(ks[18], (L, D_MODEL)),
        'w_qm': nrm(ks[19], (L, D_MODEL, D_MODEL), D_MODEL ** -0.5),
        'w_om': nrm(ks[20], (L, D_MODEL, D_MODEL), D_MODEL ** -0.5),
        'norm_ffn_g': gain(ks[21], (L, D_MODEL)),
        'w_up': nrm(ks[22], (L, D_MODEL, D_FF), D_MODEL ** -0.5),
        'w_down': nrm(ks[23], (L, D_FF, D_MODEL), D_FF ** -0.5),
        'norm_final_g': gain(ks[24], (D_MODEL,)),
    }


def reference(x_prompt, x_sample, state_pool, state_gla, cache_mem_k, cache_mem_v, mem_prompt,
              norm_mix_g, w_in, w_forget_up, b_forget, w_pool, pool_scale, gla_norm_g, w_out,
              mem_norm_g, w_km, w_vm, norm_mem_g, w_qm, w_om, norm_ffn_g, w_up, w_down, norm_final_g):
    b_p = x_prompt.shape[0]
    xp = x_prompt
    xs = x_sample
    pool_p, gla_p, mk_p, mv_p, pool_s, gla_s = [], [], [], [], [], []
    for l in range(DEPTH):
        lw = (norm_mix_g[l], w_in[l], w_forget_up[l], b_forget[l], w_pool[l], pool_scale[l], gla_norm_g[l],
              w_out[l], norm_mem_g[l], w_qm[l], w_om[l], norm_ffn_g[l], w_up[l], w_down[l])
        mk, mv = _mem_kv(mem_prompt, mem_norm_g[l], w_km[l], w_vm[l])
        xp, sp, sg = _layer(xp, jnp.zeros((b_p, 0, POOL_WIDTH), xp.dtype),
                            jnp.zeros((b_p, GLA_HEADS, GLA_DK, GLA_DV), xp.dtype), mk, mv, *lw)
        pool_p.append(sp)
        gla_p.append(sg)
        mk_p.append(mk)
        mv_p.append(mv)
        xs, ss, gs = _layer(xs, state_pool[l], state_gla[l], cache_mem_k[l], cache_mem_v[l], *lw)
        pool_s.append(ss)
        gla_s.append(gs)
    y_prompt = _rmsnorm(xp, norm_final_g)
    y_sample = _rmsnorm(xs, norm_final_g)
    return (y_prompt, y_sample, jnp.stack(pool_p), jnp.stack(gla_p), jnp.stack(mk_p), jnp.stack(mv_p),
            jnp.stack(pool_s), jnp.stack(gla_s))
```

```cpp
#include <hip/hip_runtime.h>
#include <hip/hip_cooperative_groups.h>
#include <cstdio>
#include <cstdint>
namespace cg = cooperative_groups;
namespace pg8 {
#define PG8_LAS __attribute__((address_space(3)))
typedef unsigned short bf16_t;
typedef short bf16x8 __attribute__((ext_vector_type(8)));
typedef float f32x4 __attribute__((ext_vector_type(4)));
typedef unsigned u32x4 __attribute__((ext_vector_type(4)));
constexpr int BM = 256, BK = 64, HALF = 128, HTB = HALF * BK * 2  , STAGE_BYTES = 8 * HTB, NXCD = 8, WGM = 8;

__host__ __device__ __forceinline__ int lds_byte(int r, int c) { const int st = (r >> 4) * 2 + (c >> 5), rr = r & 15, cc = c & 31, ob = rr * 64 + cc * 2; return st * 1024 + (ob ^ (((ob >> 9) & 1) << 5)); }
__host__ __device__ __forceinline__ void stage_rc(int b, int& R, int& C) { const int st = b / 1024, sb = b % 1024, swz = sb ^ (((sb >> 9) & 1) << 5); R = (st >> 1) * 16 + swz / 64; C = (st & 1) * 32 + (swz % 64) / 2; }
__host__ __device__ __forceinline__ int perm32(int rho) { const int n = rho >> 4, i = rho & 15; return 8 * (i >> 2) + 4 * n + (i & 3); }

struct Unit { int pm, pn; };
struct Gemm { const bf16_t* A; const bf16_t* Bt; int M, N, K; };

struct StaticOrder {
    int nM, nN, nwg, G, c;
    __host__ __device__ void init(int M, int N, int G_, int c_) { nM = M / BM; nN = N / BM; nwg = nM * nN; G = G_; c = c_; }
    __host__ __device__ bool next(int i, Unit& u) const {
        const long L = (long)i * G + c; if (L >= nwg) return false;
        int wgid = (int)L; { const int q = nwg / NXCD, r = nwg % NXCD, xcd = wgid % NXCD, off = wgid / NXCD; wgid = (xcd < r ? xcd * (q + 1) : r * (q + 1) + (xcd - r) * q) + off; }
        const int nig = WGM * nN, gid = wgid / nig, fm = gid * WGM, gsz = (nM - fm) < WGM ? (nM - fm) : WGM;
        u.pm = fm + ((wgid % nig) % gsz); u.pn = (wgid % nig) / gsz; return true;
    }
    __device__ __forceinline__ void a_ready(const Unit&) const {}
    __device__ __forceinline__ void done(const Unit&) const {}
};

typedef float f32x2 __attribute__((ext_vector_type(2)));
typedef __bf16 bf16x2_t __attribute__((ext_vector_type(2)));
__device__ __forceinline__ unsigned cvt_pk_bf16(float lo, float hi) { const f32x2 v = {lo, hi}; return __builtin_bit_cast(unsigned, __builtin_convertvector(v, bf16x2_t)); }
__device__ __forceinline__ int pg8_lane_id() { int l; asm volatile("v_mbcnt_lo_u32_b32 %0, -1, 0\n\tv_mbcnt_hi_u32_b32 %0, -1, %0" : "=v"(l)); return l; }
typedef unsigned u32x2 __attribute__((ext_vector_type(2)));
struct EpiPlainBf16 {
    static constexpr bool PERM = true, AFTER_DRAIN = false;
    bf16_t* O; int ldc;
    __device__ __forceinline__ void operator()(const f32x4 (&acc)[2][2][4][2], const Unit& u, int wr, int wc, int fr, int fq) const {
        const int row0 = u.pm * BM + wr * 64 + fr, col0 = u.pn * BM + wc * 32 + 8 * fq;
#pragma unroll
        for (int ai = 0; ai < 2; ++ai)
#pragma unroll
            for (int m = 0; m < 4; ++m) { bf16_t* rowp = O + (size_t)(row0 + ai * HALF + m * 16) * ldc + col0;
#pragma unroll
                for (int bj = 0; bj < 2; ++bj) { const f32x4 v0 = acc[ai][bj][m][0], v1 = acc[ai][bj][m][1];
                    u32x4 w; w.x = cvt_pk_bf16(v0[0], v0[1]); w.y = cvt_pk_bf16(v0[2], v0[3]); w.z = cvt_pk_bf16(v1[0], v1[1]); w.w = cvt_pk_bf16(v1[2], v1[3]);
                    *(u32x4*)(rowp + bj * HALF) = w; } }
    }
};
struct EpiKV {
    static constexpr bool PERM = true, AFTER_DRAIN = false;
    float* outK; float* outV; bf16_t* KB; bf16_t* VT;
    __device__ __forceinline__ void operator()(const f32x4 (&acc)[2][2][4][2], const Unit& u, int wr, int wc, int fr, int fq) const {
        const bool isV = u.pn >= 4; const int h = u.pn & 3, b = u.pm;
        float* of = isV ? outV : outK;
        const int ct0 = wc * 32 + 8 * fq;
#pragma unroll
        for (int ai = 0; ai < 2; ++ai)
#pragma unroll
            for (int m = 0; m < 4; ++m) { const int key = ai * HALF + wr * 64 + m * 16 + fr;
#pragma unroll
                for (int bj = 0; bj < 2; ++bj) { const f32x4 v0 = acc[ai][bj][m][0], v1 = acc[ai][bj][m][1]; const int ct = ct0 + bj * HALF;
                    float* fp = of + (size_t)(b * 256 + key) * 1024 + h * 256 + ct;
                    *(f32x4*)fp = v0; *(f32x4*)(fp + 4) = v1;
                    if (!isV) { u32x4 w; w.x = cvt_pk_bf16(v0[0], v0[1]); w.y = cvt_pk_bf16(v0[2], v0[3]); w.z = cvt_pk_bf16(v1[0], v1[1]); w.w = cvt_pk_bf16(v1[2], v1[3]);
                        *(u32x4*)(KB + ((size_t)(b * 4 + h) * 256 + key) * 256 + ct) = w; }
                    else { bf16_t* vp = VT + ((size_t)(b * 4 + h) * 256 + ct) * 256 + key;
#pragma unroll
                        for (int e = 0; e < 4; ++e) { vp[(size_t)e * 256] = (bf16_t)(cvt_pk_bf16(v0[e], 0.f) & 0xffffu); vp[(size_t)(e + 4) * 256] = (bf16_t)(cvt_pk_bf16(v1[e], 0.f) & 0xffffu); } }
                } }
    }
};
template <bool XB, bool SSQ> struct EpiRes {
    static constexpr bool PERM = false, AFTER_DRAIN = false;
    const float* base; float* out; bf16_t* xb; float* ssq;
    __device__ __forceinline__ void operator()(const f32x4 (&acc)[2][2][4][2], const Unit& u, int wr, int wc, int fr, int fq) const {
        const int col0 = u.pn * BM + wc * 32 + 4 * fq;
#pragma unroll
        for (int ai = 0; ai < 2; ++ai)
#pragma unroll
            for (int m = 0; m < 4; ++m) { const int r = u.pm * BM + ai * HALF + wr * 64 + m * 16 + fr; const size_t off = (size_t)r * 1024 + col0; float s = 0.f;
#pragma unroll
                for (int bj = 0; bj < 2; ++bj)
#pragma unroll
                    for (int n = 0; n < 2; ++n) { const f32x4 bs = *(const f32x4*)(base + off + bj * HALF + n * 16); const f32x4 o = bs + acc[ai][bj][m][n];
                        *(f32x4*)(out + off + bj * HALF + n * 16) = o;
                        if (SSQ) s += (o[0] * o[0] + o[1] * o[1]) + (o[2] * o[2] + o[3] * o[3]);
                        if (XB) { u32x2 w; w.x = cvt_pk_bf16(o[0], o[1]); w.y = cvt_pk_bf16(o[2], o[3]); *(u32x2*)(xb + off + bj * HALF + n * 16) = w; } }
                if (SSQ) { s += __shfl_xor(s, 16); s += __shfl_xor(s, 32); if (fq == 0) ssq[(size_t)r * 16 + u.pn * 4 + wc] = s; }
            }
    }
};
template <int MODE> struct EpiScale {
    static constexpr bool PERM = true, AFTER_DRAIN = false;
    bf16_t* O; int ldc; const float* ssq; float scale;
    __device__ __forceinline__ void operator()(const f32x4 (&acc)[2][2][4][2], const Unit& u, int wr, int wc, int fr, int fq) const {
        const int row0 = u.pm * BM + wr * 64 + fr, col0 = u.pn * BM + wc * 32 + 8 * fq;
#pragma unroll
        for (int ai = 0; ai < 2; ++ai)
#pragma unroll
            for (int m = 0; m < 4; ++m) { const int r = row0 + ai * HALF + m * 16; bf16_t* rowp = O + (size_t)r * ldc + col0;
                const f32x4* sp = (const f32x4*)(ssq + (size_t)r * 16); const f32x4 s0 = sp[0], s1 = sp[1], s2 = sp[2], s3 = sp[3];
                const float tot = ((s0[0] + s0[1]) + (s0[2] + s0[3])) + ((s1[0] + s1[1]) + (s1[2] + s1[3])) + ((s2[0] + s2[1]) + (s2[2] + s2[3])) + ((s3[0] + s3[1]) + (s3[2] + s3[3]));
                const float rs = rsqrtf(tot * (1.0f / 1024.0f) + 1e-6f) * (MODE == 0 ? scale : 1.0f);
#pragma unroll
                for (int bj = 0; bj < 2; ++bj) { f32x4 v0 = acc[ai][bj][m][0] * rs, v1 = acc[ai][bj][m][1] * rs;
                    if (MODE == 1) {
#pragma unroll
                        for (int e = 0; e < 4; ++e) { const float a0 = fmaxf(v0[e], 0.f), a1 = fmaxf(v1[e], 0.f); v0[e] = a0 * a0; v1[e] = a1 * a1; } }
                    u32x4 w; w.x = cvt_pk_bf16(v0[0], v0[1]); w.y = cvt_pk_bf16(v0[2], v0[3]); w.z = cvt_pk_bf16(v1[0], v1[1]); w.w = cvt_pk_bf16(v1[2], v1[3]);
                    *(u32x4*)(rowp + bj * HALF) = w; } }
    }
};

template <class Epi, class Sched, bool ALIGN_EPI = false, bool SP2 = false>
__device__ __forceinline__ void gemm_phase(PG8_LAS unsigned char* lds, const int wave_in, const Gemm g, const Sched& S, const Epi& E) {
    const int wid = wave_in, lane = pg8_lane_id(), tid = wid * 64 + lane, wr = wid >> 2, wc = wid & 3, fr = lane & 15, fq = lane >> 4;
    const int K = g.K, nt = K / BK;
    unsigned voffA[2], voffB[2];
#pragma unroll
    for (int i = 0; i < 2; ++i) { int R, C; stage_rc(tid * 16 + i * 8192, R, C); const int Rb = Epi::PERM ? ((R & ~31) + perm32(R & 31)) : R;
        voffA[i] = (unsigned)(R * K + C) * 2u; voffB[i] = (unsigned)(Rb * K + C) * 2u; }
    const size_t kstep = (size_t)(BK * 2);
    const size_t hstep = (size_t)HALF * K * 2;
    const size_t tstep = 2 * hstep;
    const unsigned ldsw = (unsigned)wid * 1024u;
    const int aoff = lds_byte(wr * 64 + fr, fq * 8), boff = lds_byte(wc * 32 + fr, fq * 8);
#define PG8_SA(b, h) (((b) * 2 + (h)) * HTB)
#define PG8_SB(b, h) ((4 + (b) * 2 + (h)) * HTB)
#define PG8_STAGE(bufoff, gbase, voff) do { _Pragma("unroll") for (int _i = 0; _i < 2; ++_i) \
        __builtin_amdgcn_global_load_lds((const unsigned*)((const char*)(gbase) + (voff)[_i]), (PG8_LAS unsigned*)(lds + (bufoff) + ldsw + _i * 8192), 16, 0, 0); } while (0)
#define PG8_LDA(dst, b, h) do { _Pragma("unroll") for (int m = 0; m < 4; ++m) _Pragma("unroll") for (int k = 0; k < 2; ++k) dst[m][k] = *(const PG8_LAS bf16x8*)(lds + PG8_SA(b, h) + aoff + m * 2048 + k * 1024); } while (0)
#define PG8_LDB(dst, b, h) do { _Pragma("unroll") for (int n = 0; n < 2; ++n) _Pragma("unroll") for (int k = 0; k < 2; ++k) dst[n][k] = *(const PG8_LAS bf16x8*)(lds + PG8_SB(b, h) + boff + n * 2048 + k * 1024); } while (0)
#define PG8_MMA(ai, bj, At, Bt) do { __builtin_amdgcn_s_setprio(1); _Pragma("unroll") for (int m = 0; m < 4; ++m) _Pragma("unroll") for (int n = 0; n < 2; ++n) _Pragma("unroll") for (int k = 0; k < 2; ++k) \
        acc[ai][bj][m][n] = __builtin_amdgcn_mfma_f32_16x16x32_bf16(Bt[n][k], At[m][k], acc[ai][bj][m][n], 0, 0, 0); __builtin_amdgcn_s_setprio(0); } while (0)
#define PG8_WAIT_V(n) asm volatile("s_waitcnt vmcnt(" #n ")" ::: "memory")
#define PG8_WAIT_L(n) asm volatile("s_waitcnt lgkmcnt(" #n ")" ::: "memory")
#define PG8_BAR __builtin_amdgcn_s_barrier()
#define PG8_SCHED __builtin_amdgcn_sched_barrier(0)
    Unit cur, nxt; int ui = 0;
    if (!S.next(0, cur)) return;
    f32x4 acc[2][2][4][2];
#pragma unroll
    for (int a = 0; a < 2; ++a)
#pragma unroll
        for (int b = 0; b < 2; ++b)
#pragma unroll
            for (int m = 0; m < 4; ++m)
#pragma unroll
                for (int n = 0; n < 2; ++n) acc[a][b][m][n] = (f32x4){0.f, 0.f, 0.f, 0.f};
    bf16x8 At[4][2], B0[2][2], B1[2][2];
    const char* cA = (const char*)g.A + (size_t)cur.pm * tstep; const char* cB = (const char*)g.Bt + (size_t)cur.pn * tstep;
    S.a_ready(cur);
    if constexpr (SP2) {
        PG8_STAGE(PG8_SB(0, 0), cB, voffB); PG8_STAGE(PG8_SB(0, 1), cB + hstep, voffB); PG8_STAGE(PG8_SA(0, 0), cA, voffA); PG8_STAGE(PG8_SA(0, 1), cA + hstep, voffA);
        if (wr == 1) PG8_BAR;
        PG8_WAIT_V(2); PG8_BAR;
        PG8_STAGE(PG8_SB(1, 0), cB + kstep, voffB); PG8_STAGE(PG8_SA(1, 0), cA + kstep, voffA); PG8_STAGE(PG8_SB(1, 1), cB + hstep + kstep, voffB);
        PG8_WAIT_V(6); PG8_BAR;
    } else {
        PG8_STAGE(PG8_SB(0, 0), cB, voffB); PG8_STAGE(PG8_SA(0, 0), cA, voffA); PG8_STAGE(PG8_SB(0, 1), cB + hstep, voffB); PG8_STAGE(PG8_SA(0, 1), cA + hstep, voffA);
        if (wr == 1) PG8_BAR;
        PG8_WAIT_V(4); PG8_BAR;
        PG8_STAGE(PG8_SB(1, 0), cB + kstep, voffB); PG8_STAGE(PG8_SA(1, 0), cA + kstep, voffA); PG8_STAGE(PG8_SB(1, 1), cB + hstep + kstep, voffB);
        PG8_WAIT_V(6); PG8_BAR;
    }
    for (;;) {
        const bool has_next = S.next(ui + 1, nxt);
        const char* nA = has_next ? (const char*)g.A + (size_t)nxt.pm * tstep : cA; const char* nB = has_next ? (const char*)g.Bt + (size_t)nxt.pn * tstep : cB;
        for (int t = 0; t < nt; t += 2) {
            const bool last = (t == nt - 2);
            const char* a1 = cA + (size_t)(t + 1) * kstep;
            const char* a2 = last ? nA : cA + (size_t)(t + 2) * kstep; const char* b2 = last ? nB : cB + (size_t)(t + 2) * kstep;
            const char* a3 = a2 + kstep; const char* b3 = b2 + kstep;
            if (last && has_next) S.a_ready(nxt);
            if constexpr (SP2) {
            PG8_LDB(B0, 0, 0); PG8_LDB(B1, 0, 1); PG8_SCHED; PG8_LDA(At, 0, 0); PG8_STAGE(PG8_SA(1, 1), a1 + hstep, voffA);
            PG8_WAIT_V(8); PG8_WAIT_L(0); PG8_BAR; PG8_MMA(0, 0, At, B0); PG8_MMA(0, 1, At, B1); PG8_BAR; PG8_SCHED;
            PG8_LDA(At, 0, 1); PG8_STAGE(PG8_SB(0, 0), b2, voffB); PG8_STAGE(PG8_SB(0, 1), b2 + hstep, voffB); PG8_STAGE(PG8_SA(0, 0), a2, voffA);
            PG8_WAIT_V(8); PG8_WAIT_L(0); PG8_BAR; PG8_MMA(1, 0, At, B0); PG8_MMA(1, 1, At, B1); PG8_BAR; PG8_SCHED;
            PG8_LDB(B0, 1, 0); PG8_LDB(B1, 1, 1); PG8_SCHED; PG8_LDA(At, 1, 0); PG8_STAGE(PG8_SA(0, 1), a2 + hstep, voffA);
            PG8_WAIT_V(8); PG8_WAIT_L(0); PG8_BAR; PG8_MMA(0, 0, At, B0); PG8_MMA(0, 1, At, B1); PG8_BAR; PG8_SCHED;
            PG8_LDA(At, 1, 1); PG8_STAGE(PG8_SB(1, 0), b3, voffB); PG8_STAGE(PG8_SB(1, 1), b3 + hstep, voffB); PG8_STAGE(PG8_SA(1, 0), a3, voffA);
            PG8_WAIT_V(8); PG8_WAIT_L(0); PG8_BAR; PG8_MMA(1, 0, At, B0); PG8_MMA(1, 1, At, B1); PG8_BAR; PG8_SCHED;
            } else {
            PG8_LDB(B0, 0, 0); PG8_SCHED; PG8_LDA(At, 0, 0); PG8_STAGE(PG8_SA(1, 1), a1 + hstep, voffA);
            PG8_WAIT_L(8); PG8_BAR; PG8_WAIT_L(0); PG8_MMA(0, 0, At, B0); PG8_BAR; PG8_SCHED;
            PG8_LDB(B1, 0, 1); PG8_STAGE(PG8_SB(0, 0), b2, voffB);
            PG8_BAR; PG8_WAIT_L(0); PG8_MMA(0, 1, At, B1); PG8_BAR;
            PG8_LDA(At, 0, 1); PG8_STAGE(PG8_SA(0, 0), a2, voffA);
            PG8_BAR; PG8_WAIT_L(0); PG8_MMA(1, 0, At, B0); PG8_BAR; PG8_SCHED;
            PG8_STAGE(PG8_SB(0, 1), b2 + hstep, voffB);
            PG8_WAIT_V(6); PG8_BAR; PG8_MMA(1, 1, At, B1); PG8_BAR;
            PG8_LDB(B0, 1, 0); PG8_SCHED; PG8_LDA(At, 1, 0); PG8_STAGE(PG8_SA(0, 1), a2 + hstep, voffA);
            PG8_WAIT_L(8); PG8_BAR; PG8_WAIT_L(0); PG8_MMA(0, 0, At, B0); PG8_BAR; PG8_SCHED;
            PG8_LDB(B1, 1, 1); PG8_STAGE(PG8_SB(1, 0), b3, voffB);
            PG8_BAR; PG8_WAIT_L(0); PG8_MMA(0, 1, At, B1); PG8_BAR;
            PG8_LDA(At, 1, 1); PG8_STAGE(PG8_SA(1, 0), a3, voffA);
            PG8_BAR; PG8_WAIT_L(0); PG8_MMA(1, 0, At, B0); PG8_BAR; PG8_SCHED;
            PG8_STAGE(PG8_SB(1, 1), b3 + hstep, voffB);
            PG8_WAIT_V(6); PG8_BAR; PG8_MMA(1, 1, At, B1); PG8_BAR;
            }
        }
        if constexpr (ALIGN_EPI) { if (wr == 0) PG8_BAR; }
        if constexpr (!Epi::AFTER_DRAIN) { E(acc, cur, wr, wc, fr, fq); S.done(cur); }
        if (!has_next) break;
#pragma unroll
        for (int a = 0; a < 2; ++a)
#pragma unroll
            for (int b = 0; b < 2; ++b)
#pragma unroll
                for (int m = 0; m < 4; ++m)
#pragma unroll
                    for (int n = 0; n < 2; ++n) acc[a][b][m][n] = (f32x4){0.f, 0.f, 0.f, 0.f};
        cur = nxt; cA = nA; cB = nB; ++ui;
        if constexpr (ALIGN_EPI) { if (wr == 1) PG8_BAR; }
    }
    PG8_WAIT_V(0);
    if constexpr (!ALIGN_EPI) { if (wr == 0) PG8_BAR; }
    PG8_BAR;
    if constexpr (Epi::AFTER_DRAIN) { E.fused(acc, cur, wr, wc, fr, fq, lds, wid, lane); S.done(cur); }
#undef PG8_SA
#undef PG8_SB
#undef PG8_STAGE
#undef PG8_LDA
#undef PG8_LDB
#undef PG8_MMA
#undef PG8_WAIT_V
#undef PG8_WAIT_L
#undef PG8_BAR
#undef PG8_SCHED
}
}
constexpr int NWAVES = 8;
constexpr int DM = 1024, MP = 16384, SEQ = 2048, NB = 8, MS = 128;
constexpr int INC = 2064, INP = 2304;
constexpr int C_Q = 512, C_K = 768, C_V = 1024, C_G = 1536, C_F = 2048;
constexpr int FF = 4096;
constexpr float EPS = 1e-6f;
constexpr size_t O_YP = 0, O_YS = 16777216, O_SPP = O_YS + 131072, O_SGP = O_SPP + 61440, O_KP = O_SGP + 262144, O_VP = O_KP + 2097152, O_SPS = O_VP + 2097152, O_SGS = O_SPS + 983040;
constexpr size_t MiB = 1u << 20;
constexpr size_t WS_WIN = 2 * MiB, WS_WKV = 8 * MiB, WS_WOUT = 12 * MiB, WS_WQM = 14 * MiB, WS_WOM = 16 * MiB, WS_WUP = 18 * MiB, WS_WDN = 26 * MiB;
constexpr size_t WS_MN = 34 * MiB, WS_KB = 38 * MiB, WS_VT = 42 * MiB, WS_SSQ1 = 46 * MiB, WS_SSQ2 = 47 * MiB;
constexpr size_t WS_PROJS = 49 * MiB  , WS_MIXS = 51 * MiB  , WS_QS = 52 * MiB, WS_CTXS = 53 * MiB, WS_HFFS = 54 * MiB  , WS_PARTS = 56 * MiB  ;
constexpr size_t WS_H = 64 * MiB  , WS_XB = 96 * MiB, WS_Q = 128 * MiB, WS_CTX = 160 * MiB;
constexpr size_t WS_PROJ = 192 * MiB  , WS_GL = 264 * MiB  , WS_CUM = 296 * MiB  , WS_ST = 312 * MiB  ;
constexpr size_t WS_HFF = 192 * MiB  ;
constexpr size_t WS_END = 328 * MiB;
constexpr int LDS_BYTES = 147456;

#define LAS __attribute__((address_space(3)))
typedef unsigned short bf16;
typedef unsigned u32x4 __attribute__((ext_vector_type(4)));
typedef unsigned u32x2 __attribute__((ext_vector_type(2)));
typedef float f32x4 __attribute__((ext_vector_type(4)));
typedef short bf16x8 __attribute__((ext_vector_type(8)));
typedef short bf16x4 __attribute__((ext_vector_type(4)));
#define LDS_WAIT() asm volatile("s_waitcnt lgkmcnt(0)" ::: "memory")
__device__ __forceinline__ unsigned pk2(float lo, float hi) { return pg8::cvt_pk_bf16(lo, hi); }
__device__ __forceinline__ float bf2f(unsigned short h) { return __uint_as_float((unsigned)h << 16); }
__device__ __forceinline__ float bflo(unsigned w) { return __uint_as_float(w << 16); }
__device__ __forceinline__ float bfhi(unsigned w) { return __uint_as_float(w & 0xffff0000u); }
__device__ __forceinline__ float wave_sum(float v) {
#pragma unroll
    for (int o = 1; o < 64; o <<= 1) v += __shfl_xor(v, o);
    return v;
}
__device__ __forceinline__ float wave_max(float v) {
#pragma unroll
    for (int o = 1; o < 64; o <<= 1) v = fmaxf(v, __shfl_xor(v, o));
    return v;
}
__device__ __forceinline__ float logsig(float x) { return fminf(x, 0.f) - log1pf(__expf(-fabsf(x))); }
__device__ __forceinline__ float silu(float x) { return x / (1.f + __expf(-x)); }
__device__ __forceinline__ f32x4 mfma16(bf16x8 a, bf16x8 b, f32x4 c) { return __builtin_amdgcn_mfma_f32_16x16x32_bf16(a, b, c, 0, 0, 0); }

struct Frame {
    LAS unsigned char* lds;
    int wave, G, blk;
    const float* in[25]; float* out; unsigned char* ws;
};
#define WSP(T, off) ((T*)(F.ws + (off)))

__device__ __forceinline__ void transpose_item(const float* W, int ldw, int nreal, bf16* WT, int ldt, int row_off, const float* gain, LAS float* scr, int k0, int n0, int lane) {
    const int n = n0 + (lane & 31);
#pragma unroll 8
    for (int i = 0; i < 32; ++i) { const int kk = 2 * i + (lane >> 5); float v = (n < nreal) ? W[(size_t)(k0 + kk) * ldw + n] : 0.f; if (gain) v *= gain[k0 + kk]; scr[kk * 33 + (lane & 31)] = v; }
    LDS_WAIT(); asm volatile("" ::: "memory");
    const int c = lane & 7;
#pragma unroll
    for (int j = 0; j < 4; ++j) { const int nn = (lane >> 3) + 8 * j; const LAS float* s = scr + (8 * c) * 33 + nn;
        u32x4 o; o.x = pk2(s[0 * 33], s[1 * 33]); o.y = pk2(s[2 * 33], s[3 * 33]); o.z = pk2(s[4 * 33], s[5 * 33]); o.w = pk2(s[6 * 33], s[7 * 33]);
        *(u32x4*)(WT + (size_t)(row_off + n0 + nn) * ldt + k0 + 8 * c) = o; }
    LDS_WAIT(); asm volatile("" ::: "memory");
}
__device__ __forceinline__ void rms_row_to_bf16(const float* xrow, bf16* orow, int lane) {
    const f32x4* xr = (const f32x4*)xrow + lane;
    f32x4 v[4]; float s = 0.f;
#pragma unroll
    for (int j = 0; j < 4; ++j) { v[j] = xr[64 * j]; s += (v[j].x * v[j].x + v[j].y * v[j].y) + (v[j].z * v[j].z + v[j].w * v[j].w); }
    const float rstd = rsqrtf(wave_sum(s) * (1.f / DM) + EPS);
    unsigned long long* o8 = (unsigned long long*)orow + lane;
#pragma unroll
    for (int j = 0; j < 4; ++j) o8[64 * j] = (unsigned long long)pk2(v[j].x * rstd, v[j].y * rstd) | ((unsigned long long)pk2(v[j].z * rstd, v[j].w * rstd) << 32);
}
__device__ __forceinline__ void p0_prologue(const Frame& F) {
    const int lane = pg8::pg8_lane_id(), tid = F.wave * 64 + lane; (void)tid;
    LAS float* scr = (LAS float*)(F.lds + F.wave * 8704);
    const int gw = F.blk * NWAVES + F.wave, NGW = F.G * NWAVES;
    constexpr int I_IN = 16 * 72, I_SQ = 16 * 32, I_OUT = 8 * 32, I_UP = 16 * 128, I_DN = 64 * 32;
    constexpr int NITEMS = I_IN + 2 * I_SQ + I_OUT + 2 * I_SQ + I_UP + I_DN;
    for (int it = gw; it < NITEMS; it += NGW) {
        int r = it;
        if (r < I_IN) { transpose_item(F.in[8], INC, INC, WSP(bf16, WS_WIN), DM, 0, F.in[7], scr, 64 * (r / 72), 32 * (r % 72), lane); continue; } r -= I_IN;
        if (r < I_SQ) { transpose_item(F.in[16], DM, DM, WSP(bf16, WS_WKV), DM, 0, F.in[15], scr, 64 * (r / 32), 32 * (r % 32), lane); continue; } r -= I_SQ;
        if (r < I_SQ) { transpose_item(F.in[17], DM, DM, WSP(bf16, WS_WKV), DM, DM, F.in[15], scr, 64 * (r / 32), 32 * (r % 32), lane); continue; } r -= I_SQ;
        if (r < I_OUT) { transpose_item(F.in[14], DM, DM, WSP(bf16, WS_WOUT), DM, 0, nullptr, scr, 512 + 64 * (r / 32), 32 * (r % 32), lane); continue; } r -= I_OUT;
        if (r < I_SQ) { transpose_item(F.in[19], DM, DM, WSP(bf16, WS_WQM), DM, 0, F.in[18], scr, 64 * (r / 32), 32 * (r % 32), lane); continue; } r -= I_SQ;
        if (r < I_SQ) { transpose_item(F.in[20], DM, DM, WSP(bf16, WS_WOM), DM, 0, nullptr, scr, 64 * (r / 32), 32 * (r % 32), lane); continue; } r -= I_SQ;
        if (r < I_UP) { transpose_item(F.in[22], FF, FF, WSP(bf16, WS_WUP), DM, 0, F.in[21], scr, 64 * (r / 128), 32 * (r % 128), lane); continue; } r -= I_UP;
        transpose_item(F.in[23], DM, DM, WSP(bf16, WS_WDN), FF, 0, nullptr, scr, 64 * (r / 32), 32 * (r % 32), lane);
    }
    { const float* wp = F.in[11]; const float* ps = F.in[12]; const float* wo = F.in[14]; bf16* wt = WSP(bf16, WS_WOUT);
      for (int idx = F.blk * 512 + tid; idx < 512 * 1024; idx += F.G * 512) { const int n = idx & 1023, kc = idx >> 10, g = kc >> 7;
          const float* wpr = wp + (size_t)kc * 128; const float* psr = ps + g * 128; const float* wor = wo + (size_t)(g * 128) * DM + n; float s = 0.f;
#pragma unroll 8
          for (int d = 0; d < 128; ++d) s += wpr[d] * psr[d] * wor[(size_t)d * DM];
          wt[(size_t)n * DM + kc] = (bf16)(pk2(s, 0.f) & 0xffffu); } }
    for (int m = gw; m < MP; m += NGW) rms_row_to_bf16(F.in[0] + (size_t)m * DM, WSP(bf16, WS_H) + (size_t)m * DM, lane);
    for (int m = gw; m < NB * 256; m += NGW) rms_row_to_bf16(F.in[6] + (size_t)m * DM, WSP(bf16, WS_MN) + (size_t)m * DM, lane);
}

template <bool NORM, class Epi>
__device__ __forceinline__ void skinny_gemm(const Frame& F, const float* A, int lda, const bf16* Bt, int ldb, int K, int nslab, int ksplit, const Epi& E) {
    const int lane = pg8::pg8_lane_id(), tid = F.wave * 64 + lane; (void)tid;
    const int fr = lane & 15, fq = lane >> 4;
    for (int item = F.blk; item < nslab * ksplit; item += F.G) {
        const int slab = item % nslab, ks = item / nslab;
        const float* ap = A + (size_t)(F.wave * 16 + fr) * lda + (size_t)ks * K + fq * 8;
        const bf16* bp = Bt + (size_t)(slab * 16 + fr) * ldb + (size_t)ks * K + fq * 8;
        f32x4 acc = {0.f, 0.f, 0.f, 0.f}; float ss = 0.f;
#pragma unroll 8
        for (int k0 = 0; k0 < K; k0 += 32) {
            const f32x4 a0 = *(const f32x4*)(ap + k0), a1 = *(const f32x4*)(ap + k0 + 4);
            const bf16x8 b = *(const bf16x8*)(bp + k0);
            if (NORM) ss += ((a0[0] * a0[0] + a0[1] * a0[1]) + (a0[2] * a0[2] + a0[3] * a0[3])) + ((a1[0] * a1[0] + a1[1] * a1[1]) + (a1[2] * a1[2] + a1[3] * a1[3]));
            u32x4 aw; aw.x = pk2(a0[0], a0[1]); aw.y = pk2(a0[2], a0[3]); aw.z = pk2(a1[0], a1[1]); aw.w = pk2(a1[2], a1[3]);
            acc = mfma16(b, __builtin_bit_cast(bf16x8, aw), acc);
        }
        if (NORM) { ss += __shfl_xor(ss, 16); ss += __shfl_xor(ss, 32); acc = acc * rsqrtf(ss / (float)K + EPS); }
        E(F.wave * 16 + fr, slab * 16 + fq * 4, ks, acc);
    }
}
struct SEpiStore { float* O; int ldc; float scale; __device__ __forceinline__ void operator()(int row, int col, int, f32x4 v) const { *(f32x4*)(O + (size_t)row * ldc + col) = v * scale; } };
struct SEpiPart  { float* O; __device__ __forceinline__ void operator()(int row, int col, int ks, f32x4 v) const { *(f32x4*)(O + ((size_t)ks * MS + row) * DM + col) = v; } };
struct SEpiRes   { const float* base; float* O; __device__ __forceinline__ void operator()(int row, int col, int, f32x4 v) const { const f32x4 b = *(const f32x4*)(base + (size_t)row * DM + col); *(f32x4*)(O + (size_t)row * DM + col) = b + v; } };
struct SEpiRelu2 { float* O; __device__ __forceinline__ void operator()(int row, int col, int, f32x4 v) const { f32x4 o;
#pragma unroll
    for (int e = 0; e < 4; ++e) { const float a = fmaxf(v[e], 0.f); o[e] = a * a; } *(f32x4*)(O + (size_t)row * FF + col) = o; } };
__device__ __forceinline__ void p2_pool_prompt(const Frame& F) {
    const bf16* proj = WSP(const bf16, WS_PROJ); bf16* mixed = WSP(bf16, WS_H);
    const int lane = pg8::pg8_lane_id(), tid = F.wave * 64 + lane; (void)tid;
    const int c8 = (tid & 63) * 8, g = c8 >> 7, w = 2 << g;
    for (int it = F.blk; it < MP / 8; it += F.G) {
        const int row = it * 8 + F.wave, t = row & (SEQ - 1), b = row >> 11, cnt = (t + 1 < w) ? (t + 1) : w;
        const u32x4 u0 = *(const u32x4*)(proj + (size_t)row * INP + c8);
        float s[8]; s[0] = bflo(u0.x); s[1] = bfhi(u0.x); s[2] = bflo(u0.y); s[3] = bfhi(u0.y); s[4] = bflo(u0.z); s[5] = bfhi(u0.z); s[6] = bflo(u0.w); s[7] = bfhi(u0.w);
        float un[8];
#pragma unroll
        for (int e = 0; e < 8; ++e) un[e] = s[e];
        for (int j = 1; j < cnt; ++j) { const u32x4 uj = *(const u32x4*)(proj + (size_t)(row - j) * INP + c8);
            s[0] += bflo(uj.x); s[1] += bfhi(uj.x); s[2] += bflo(uj.y); s[3] += bfhi(uj.y); s[4] += bflo(uj.z); s[5] += bfhi(uj.z); s[6] += bflo(uj.w); s[7] += bfhi(uj.w); }
        const float inv = 1.f / (float)cnt;
        u32x4 o; o.x = pk2(s[0] * inv - un[0], s[1] * inv - un[1]); o.y = pk2(s[2] * inv - un[2], s[3] * inv - un[3]); o.z = pk2(s[4] * inv - un[4], s[5] * inv - un[5]); o.w = pk2(s[6] * inv - un[6], s[7] * inv - un[7]);
        *(u32x4*)(mixed + (size_t)row * DM + c8) = o;
        if (t >= SEQ - 15) { float* sp = F.out + O_SPP + ((size_t)b * 15 + (t - (SEQ - 15))) * 512 + c8; *(f32x4*)sp = (f32x4){un[0], un[1], un[2], un[3]}; *(f32x4*)(sp + 4) = (f32x4){un[4], un[5], un[6], un[7]}; }
    }
}
__device__ __forceinline__ void p2_gla_local(const Frame& F) {
    const bf16* proj = WSP(const bf16, WS_PROJ); float* GL = WSP(float, WS_GL); float* CUM = WSP(float, WS_CUM);
    LAS float* fl = (LAS float*)(F.lds);
    LAS float* segt = (LAS float*)(F.lds + 4096);
    LAS bf16* Aop = (LAS bf16*)(F.lds + 8192);
    LAS bf16* Bop = (LAS bf16*)(F.lds + 8192 + 9216);
    const int lane = pg8::pg8_lane_id(), tid = F.wave * 64 + lane; const int wave = F.wave, fr = lane & 15, fq = lane >> 4;
    for (int unit = F.blk; unit < 1024; unit += F.G) {
        const int b = unit >> 7, n = (unit >> 2) & 31, h = unit & 3; const size_t r0 = (size_t)b * SEQ + n * 64;
        for (int e = tid; e < 1024; e += 512) fl[e] = bf2f(proj[(r0 + (e >> 4)) * INP + C_F + (e & 15)]);
        const int d = tid & 63, seg = tid >> 6;
        float wf[16];
#pragma unroll
        for (int r = 0; r < 16; ++r) wf[r] = F.in[9][r * 256 + h * 64 + d];
        const float bias = F.in[10][h * 64 + d];
        __syncthreads();
        float cum[8]; float run = 0.f;
#pragma unroll
        for (int i = 0; i < 8; ++i) { const int t = seg * 8 + i; float pre = bias;
#pragma unroll
            for (int r = 0; r < 16; ++r) pre += fl[t * 16 + r] * wf[r];
            run += logsig(pre) * (1.f / 16.f); cum[i] = run; }
        segt[seg * 64 + d] = run;
        __syncthreads();
        float pre_s = 0.f, tot = 0.f;
#pragma unroll
        for (int s2 = 0; s2 < 8; ++s2) { const float v = segt[s2 * 64 + d]; tot += v; if (s2 < seg) pre_s += v; }
        float ke[8];
#pragma unroll
        for (int i = 0; i < 8; ++i) { const int t = seg * 8 + i; cum[i] += pre_s; CUM[(size_t)unit * 4096 + t * 64 + d] = cum[i];
            ke[i] = bf2f(proj[(r0 + t) * INP + C_K + h * 64 + d]) * __expf(tot - cum[i]); }
        { u32x4 o; o.x = pk2(ke[0], ke[1]); o.y = pk2(ke[2], ke[3]); o.z = pk2(ke[4], ke[5]); o.w = pk2(ke[6], ke[7]); *(LAS u32x4*)(Aop + d * 72 + seg * 8) = o; }
        { const int dv = tid & 127, ts = tid >> 7; unsigned short vv[16];
#pragma unroll
          for (int i = 0; i < 16; ++i) vv[i] = proj[(r0 + ts * 16 + i) * INP + C_V + h * 128 + dv];
          u32x4 o0, o1; o0.x = vv[0] | ((unsigned)vv[1] << 16); o0.y = vv[2] | ((unsigned)vv[3] << 16); o0.z = vv[4] | ((unsigned)vv[5] << 16); o0.w = vv[6] | ((unsigned)vv[7] << 16);
          o1.x = vv[8] | ((unsigned)vv[9] << 16); o1.y = vv[10] | ((unsigned)vv[11] << 16); o1.z = vv[12] | ((unsigned)vv[13] << 16); o1.w = vv[14] | ((unsigned)vv[15] << 16);
          *(LAS u32x4*)(Bop + dv * 72 + ts * 16) = o0; *(LAS u32x4*)(Bop + dv * 72 + ts * 16 + 8) = o1; }
        __syncthreads();
        const int mi = wave & 3;
#pragma unroll
        for (int jj = 0; jj < 4; ++jj) { const int nj = (wave >> 2) * 4 + jj; f32x4 acc = {0.f, 0.f, 0.f, 0.f};
#pragma unroll
            for (int ks = 0; ks < 2; ++ks) { const bf16x8 a = *(const LAS bf16x8*)(Aop + (mi * 16 + fr) * 72 + ks * 32 + fq * 8); const bf16x8 bb = *(const LAS bf16x8*)(Bop + (nj * 16 + fr) * 72 + ks * 32 + fq * 8);
                acc = mfma16(bb, a, acc); }
            *(f32x4*)(GL + (size_t)unit * 8192 + (mi * 16 + fr) * 128 + nj * 16 + fq * 4) = acc; }
        __syncthreads();
    }
}
__device__ __forceinline__ void p3_gla_scan(const Frame& F) {
    const float* GL = WSP(const float, WS_GL); const float* CUM = WSP(const float, WS_CUM); bf16* ST = WSP(bf16, WS_ST);
    const int lane = pg8::pg8_lane_id(), tid = F.wave * 64 + lane; (void)tid;
    for (int e = F.blk * 512 + tid; e < 65536; e += F.G * 512) {
        const int dv = e & 127, dg = (e >> 7) & 15, bh = e >> 11, b = bh >> 2, h = bh & 3;
        float S[4] = {0.f, 0.f, 0.f, 0.f};
#pragma unroll 4
        for (int n = 0; n < 32; ++n) { const size_t unit = (size_t)(b * 32 + n) * 4 + h;
            const f32x4 cl = *(const f32x4*)(CUM + unit * 4096 + 63 * 64 + dg * 4);
            float Lv[4];
#pragma unroll
            for (int i = 0; i < 4; ++i) Lv[i] = GL[unit * 8192 + (dg * 4 + i) * 128 + dv];
            u32x2 o; o.x = pk2(S[0], S[1]); o.y = pk2(S[2], S[3]); *(u32x2*)(ST + unit * 8192 + dv * 64 + dg * 4) = o;
#pragma unroll
            for (int i = 0; i < 4; ++i) S[i] = __expf(cl[i]) * S[i] + Lv[i]; }
#pragma unroll
        for (int i = 0; i < 4; ++i) F.out[O_SGP + ((size_t)(b * 4 + h) * 64 + dg * 4 + i) * 128 + dv] = S[i];
    }
}
__device__ __forceinline__ void p4_gla_out(const Frame& F) {
    const bf16* proj = WSP(const bf16, WS_PROJ); const float* CUM = WSP(const float, WS_CUM); const bf16* ST = WSP(const bf16, WS_ST); bf16* mixed = WSP(bf16, WS_H);
    LAS bf16* Aq = (LAS bf16*)(F.lds);
    LAS bf16* Bk = (LAS bf16*)(F.lds + 9216);
    LAS bf16* Bv = (LAS bf16*)(F.lds + 18432);
    LAS bf16* Bs = (LAS bf16*)(F.lds + 36864);
    LAS bf16* Ap = (LAS bf16*)(F.lds + 55296);
    LAS float* red = (LAS float*)(F.lds + 64512);
    const int lane = pg8::pg8_lane_id(), tid = F.wave * 64 + lane; const int wave = F.wave, fr = lane & 15, fq = lane >> 4;
    for (int unit = F.blk; unit < 1024; unit += F.G) {
        const int b = unit >> 7, n = (unit >> 2) & 31, h = unit & 3; const size_t r0 = (size_t)b * SEQ + n * 64;
        { const int t = tid >> 3, d8 = (tid & 7) * 8;
          const f32x4 c0 = *(const f32x4*)(CUM + (size_t)unit * 4096 + t * 64 + d8), c1 = *(const f32x4*)(CUM + (size_t)unit * 4096 + t * 64 + d8 + 4);
          const u32x4 qw = *(const u32x4*)(proj + (r0 + t) * INP + C_Q + h * 64 + d8), kw = *(const u32x4*)(proj + (r0 + t) * INP + C_K + h * 64 + d8);
          float cu[8] = {c0[0], c0[1], c0[2], c0[3], c1[0], c1[1], c1[2], c1[3]};
          float qv[8] = {bflo(qw.x), bfhi(qw.x), bflo(qw.y), bfhi(qw.y), bflo(qw.z), bfhi(qw.z), bflo(qw.w), bfhi(qw.w)};
          float kv[8] = {bflo(kw.x), bfhi(kw.x), bflo(kw.y), bfhi(kw.y), bflo(kw.z), bfhi(kw.z), bflo(kw.w), bfhi(kw.w)};
#pragma unroll
          for (int e = 0; e < 8; ++e) { const float ex = __expf(cu[e]); qv[e] = qv[e] * 0.125f * ex; kv[e] = kv[e] / ex; }
          u32x4 o; o.x = pk2(qv[0], qv[1]); o.y = pk2(qv[2], qv[3]); o.z = pk2(qv[4], qv[5]); o.w = pk2(qv[6], qv[7]); *(LAS u32x4*)(Aq + t * 72 + d8) = o;
          o.x = pk2(kv[0], kv[1]); o.y = pk2(kv[2], kv[3]); o.z = pk2(kv[4], kv[5]); o.w = pk2(kv[6], kv[7]); *(LAS u32x4*)(Bk + t * 72 + d8) = o; }
        { const int dv = tid & 127, ts = tid >> 7; unsigned short vv[16];
#pragma unroll
          for (int i = 0; i < 16; ++i) vv[i] = proj[(r0 + ts * 16 + i) * INP + C_V + h * 128 + dv];
          u32x4 o0, o1; o0.x = vv[0] | ((unsigned)vv[1] << 16); o0.y = vv[2] | ((unsigned)vv[3] << 16); o0.z = vv[4] | ((unsigned)vv[5] << 16); o0.w = vv[6] | ((unsigned)vv[7] << 16);
          o1.x = vv[8] | ((unsigned)vv[9] << 16); o1.y = vv[10] | ((unsigned)vv[11] << 16); o1.z = vv[12] | ((unsigned)vv[13] << 16); o1.w = vv[14] | ((unsigned)vv[15] << 16);
          *(LAS u32x4*)(Bv + dv * 72 + ts * 16) = o0; *(LAS u32x4*)(Bv + dv * 72 + ts * 16 + 8) = o1; }
#pragma unroll
        for (int p = 0; p < 2; ++p) { const int pc = tid + p * 512, dv = pc >> 3, part = pc & 7;
            *(LAS u32x4*)(Bs + dv * 72 + part * 8) = *(const u32x4*)(ST + (size_t)unit * 8192 + dv * 64 + part * 8); }
        __syncthreads();
        const int mi = wave & 3;
#pragma unroll
        for (int jj = 0; jj < 2; ++jj) { const int nj = (wave >> 2) * 2 + jj; f32x4 acc = {0.f, 0.f, 0.f, 0.f};
#pragma unroll
            for (int ks = 0; ks < 2; ++ks) { const bf16x8 a = *(const LAS bf16x8*)(Aq + (mi * 16 + fr) * 72 + ks * 32 + fq * 8); const bf16x8 bb = *(const LAS bf16x8*)(Bk + (nj * 16 + fr) * 72 + ks * 32 + fq * 8);
                acc = mfma16(bb, a, acc); }
            const int i = mi * 16 + fr, j0 = nj * 16 + fq * 4;
#pragma unroll
            for (int r = 0; r < 4; ++r) if (j0 + r > i) acc[r] = 0.f;
            u32x2 o; o.x = pk2(acc[0], acc[1]); o.y = pk2(acc[2], acc[3]); *(LAS u32x2*)(Ap + i * 72 + j0) = o; }
        __syncthreads();
        f32x4 oacc[4]; float ssq = 0.f;
#pragma unroll
        for (int jj = 0; jj < 4; ++jj) { const int nj = (wave >> 2) * 4 + jj; f32x4 acc = {0.f, 0.f, 0.f, 0.f};
#pragma unroll
            for (int ks = 0; ks < 2; ++ks) {
                const bf16x8 ap = *(const LAS bf16x8*)(Ap + (mi * 16 + fr) * 72 + ks * 32 + fq * 8), bv = *(const LAS bf16x8*)(Bv + (nj * 16 + fr) * 72 + ks * 32 + fq * 8);
                acc = mfma16(bv, ap, acc);
                const bf16x8 aq = *(const LAS bf16x8*)(Aq + (mi * 16 + fr) * 72 + ks * 32 + fq * 8), bs = *(const LAS bf16x8*)(Bs + (nj * 16 + fr) * 72 + ks * 32 + fq * 8);
                acc = mfma16(bs, aq, acc); }
            oacc[jj] = acc; ssq += (acc[0] * acc[0] + acc[1] * acc[1]) + (acc[2] * acc[2] + acc[3] * acc[3]); }
        ssq += __shfl_xor(ssq, 16); ssq += __shfl_xor(ssq, 32);
        if (fq == 0) red[(wave >> 2) * 64 + mi * 16 + fr] = ssq;
        __syncthreads();
        const float rstd = rsqrtf((red[mi * 16 + fr] + red[64 + mi * 16 + fr]) * (1.f / 128.f) + EPS);
        const size_t row = r0 + mi * 16 + fr;
#pragma unroll
        for (int jj = 0; jj < 4; ++jj) { const int dv0 = ((wave >> 2) * 4 + jj) * 16 + fq * 4;
            const f32x4 gn = *(const f32x4*)(F.in[13] + h * 128 + dv0); const u32x2 gw = *(const u32x2*)(proj + row * INP + C_G + h * 128 + dv0);
            const float g0 = silu(bflo(gw.x)), g1 = silu(bfhi(gw.x)), g2 = silu(bflo(gw.y)), g3 = silu(bfhi(gw.y));
            u32x2 o; o.x = pk2(oacc[jj][0] * rstd * gn[0] * g0, oacc[jj][1] * rstd * gn[1] * g1); o.y = pk2(oacc[jj][2] * rstd * gn[2] * g2, oacc[jj][3] * rstd * gn[3] * g3);
            *(u32x2*)(mixed + row * DM + 512 + h * 128 + dv0) = o; }
        __syncthreads();
    }
}

__device__ __forceinline__ void s_mixers(const Frame& F) {
    const float* projs = WSP(const float, WS_PROJS); float* mixs = WSP(float, WS_MIXS);
    const float* spool = F.in[2]; const float* sgla = F.in[3];
    const int lane = pg8::pg8_lane_id(), tid = F.wave * 64 + lane; (void)tid;
    for (int e = F.blk * 512 + tid; e < MS * 512; e += F.G * 512) { const int b = e >> 9, c = e & 511, g = c >> 7, w = 2 << g;
        const float u = projs[(size_t)b * INC + c]; float s = u;
        for (int j = 1; j < w; ++j) s += spool[((size_t)b * 15 + 15 - j) * 512 + c];
        mixs[(size_t)b * DM + c] = s / (float)w - u;
        float* so = F.out + O_SPS + (size_t)b * 15 * 512 + c;
#pragma unroll
        for (int i = 0; i < 14; ++i) so[(size_t)i * 512] = spool[((size_t)b * 15 + i + 1) * 512 + c];
        so[(size_t)14 * 512] = u; }
    LAS float* dec = (LAS float*)(F.lds); LAS float* qs = dec + 64; LAS float* ks = dec + 128; LAS float* vs = dec + 192;
    LAS float* red = dec + 320;
    LAS float* red2 = red + 2048;
    for (int it = F.blk; it < MS * 4; it += F.G) { const int b = it >> 2, h = it & 3; const float* pr = projs + (size_t)b * INC;
        if (tid < 64) { float pre = F.in[10][h * 64 + tid];
#pragma unroll
            for (int r = 0; r < 16; ++r) pre += pr[C_F + r] * F.in[9][r * 256 + h * 64 + tid];
            dec[tid] = __expf(logsig(pre) * (1.f / 16.f)); qs[tid] = pr[C_Q + h * 64 + tid] * 0.125f; ks[tid] = pr[C_K + h * 64 + tid]; }
        else if (tid < 192) vs[tid - 64] = pr[C_V + h * 128 + (tid - 64)];
        __syncthreads();
        { const int v4 = (tid & 31) * 4, dgp = tid >> 5; const f32x4 vv = *(const LAS f32x4*)(vs + v4); f32x4 po = {0.f, 0.f, 0.f, 0.f};
#pragma unroll
          for (int i = 0; i < 4; ++i) { const int d = dgp * 4 + i; const size_t off = ((size_t)(b * 4 + h) * 64 + d) * 128 + v4;
              const f32x4 s0 = *(const f32x4*)(sgla + off); const f32x4 sn = s0 * dec[d] + vv * ks[d]; *(f32x4*)(F.out + O_SGS + off) = sn; po += sn * qs[d]; }
          *(LAS f32x4*)(red + dgp * 128 + v4) = po; }
        __syncthreads();
        float o = 0.f;
        if (tid < 128) {
#pragma unroll
            for (int g = 0; g < 16; ++g) o += red[g * 128 + tid];
            const float s2 = wave_sum(o * o); if (lane == 0) red2[tid >> 6] = s2; }
        __syncthreads();
        if (tid < 128) { const float rstd = rsqrtf((red2[0] + red2[1]) * (1.f / 128.f) + EPS);
            mixs[(size_t)b * DM + 512 + h * 128 + tid] = o * rstd * F.in[13][h * 128 + tid] * silu(pr[C_G + h * 128 + tid]); }
        __syncthreads();
    }
}
constexpr int KST = 264;
__device__ __forceinline__ void p7_attn_prompt(const Frame& F) {
    const bf16* Q = WSP(const bf16, WS_Q); const bf16* KB = WSP(const bf16, WS_KB); const bf16* VT = WSP(const bf16, WS_VT); bf16* CTX = WSP(bf16, WS_CTX);
    LAS bf16* L = (LAS bf16*)F.lds;
    const int lane = pg8::pg8_lane_id(), tid = F.wave * 64 + lane; const int wave = F.wave, fr = lane & 15, fq = lane >> 4;
    for (int unit = F.blk; unit < 256; unit += F.G) {
        const int b = unit >> 5, h = (unit >> 3) & 3, qt = unit & 7; const size_t row0 = (size_t)b * SEQ + qt * 256 + wave * 32;
        const bf16* kg = KB + (size_t)(b * 4 + h) * 65536; const bf16* vg = VT + (size_t)(b * 4 + h) * 65536;
        bf16x8 qf[2][8];
#pragma unroll
        for (int mi = 0; mi < 2; ++mi)
#pragma unroll
            for (int ks = 0; ks < 8; ++ks) qf[mi][ks] = *(const bf16x8*)(Q + (row0 + mi * 16 + fr) * DM + h * 256 + ks * 32 + fq * 8);
#pragma unroll 4
        for (int p = tid; p < 8192; p += 512) { const int key = p >> 5, piece = p & 31; *(LAS u32x4*)(L + key * KST + piece * 8) = *(const u32x4*)(kg + key * 256 + piece * 8); }
        __syncthreads();
        f32x4 sacc[2][16];
#pragma unroll
        for (int nj = 0; nj < 16; ++nj) { sacc[0][nj] = (f32x4){0.f, 0.f, 0.f, 0.f}; sacc[1][nj] = (f32x4){0.f, 0.f, 0.f, 0.f};
#pragma unroll
            for (int ks = 0; ks < 8; ++ks) { const bf16x8 kf = *(const LAS bf16x8*)(L + (nj * 16 + fr) * KST + ks * 32 + fq * 8);
                sacc[0][nj] = mfma16(kf, qf[0][ks], sacc[0][nj]); sacc[1][nj] = mfma16(kf, qf[1][ks], sacc[1][nj]); } }
        float inv[2]; bf16x8 pf[2][8];
#pragma unroll
        for (int mi = 0; mi < 2; ++mi) { float mx = -3.0e38f;
#pragma unroll
            for (int nj = 0; nj < 16; ++nj) mx = fmaxf(mx, fmaxf(fmaxf(sacc[mi][nj][0], sacc[mi][nj][1]), fmaxf(sacc[mi][nj][2], sacc[mi][nj][3])));
            mx = fmaxf(mx, __shfl_xor(mx, 16)); mx = fmaxf(mx, __shfl_xor(mx, 32));
            float sm = 0.f;
#pragma unroll
            for (int s = 0; s < 8; ++s) { float e[8];
#pragma unroll
                for (int r = 0; r < 4; ++r) { e[r] = __expf(sacc[mi][2 * s][r] - mx); e[4 + r] = __expf(sacc[mi][2 * s + 1][r] - mx); }
                sm += ((e[0] + e[1]) + (e[2] + e[3])) + ((e[4] + e[5]) + (e[6] + e[7]));
                u32x4 w; w.x = pk2(e[0], e[1]); w.y = pk2(e[2], e[3]); w.z = pk2(e[4], e[5]); w.w = pk2(e[6], e[7]); pf[mi][s] = __builtin_bit_cast(bf16x8, w); }
            sm += __shfl_xor(sm, 16); sm += __shfl_xor(sm, 32); inv[mi] = 1.f / sm; }
        __syncthreads();
#pragma unroll 4
        for (int p = tid; p < 8192; p += 512) { const int d = p >> 5, piece = p & 31; *(LAS u32x4*)(L + d * KST + piece * 8) = *(const u32x4*)(vg + d * 256 + piece * 8); }
        __syncthreads();
#pragma unroll
        for (int nj = 0; nj < 16; ++nj) { f32x4 o0 = {0.f, 0.f, 0.f, 0.f}, o1 = {0.f, 0.f, 0.f, 0.f};
#pragma unroll
            for (int s = 0; s < 8; ++s) { const LAS bf16* vp = L + (nj * 16 + fr) * KST + (2 * s) * 16 + fq * 4;
                const u32x2 lo = *(const LAS u32x2*)vp, hi = *(const LAS u32x2*)(vp + 16); u32x4 w; w.x = lo.x; w.y = lo.y; w.z = hi.x; w.w = hi.y; const bf16x8 vf = __builtin_bit_cast(bf16x8, w);
                o0 = mfma16(vf, pf[0][s], o0); o1 = mfma16(vf, pf[1][s], o1); }
            const int d0 = h * 256 + nj * 16 + fq * 4;
            u32x2 w0; w0.x = pk2(o0[0] * inv[0], o0[1] * inv[0]); w0.y = pk2(o0[2] * inv[0], o0[3] * inv[0]); *(u32x2*)(CTX + (row0 + fr) * DM + d0) = w0;
            u32x2 w1; w1.x = pk2(o1[0] * inv[1], o1[1] * inv[1]); w1.y = pk2(o1[2] * inv[1], o1[3] * inv[1]); *(u32x2*)(CTX + (row0 + 16 + fr) * DM + d0) = w1; }
        __syncthreads();
    }
}
__device__ __forceinline__ void s_attn(const Frame& F) {
    const float* qsb = WSP(const float, WS_QS); float* ctxs = WSP(float, WS_CTXS); const float* ck = F.in[4]; const float* cv = F.in[5];
    LAS float* qv = (LAS float*)F.lds; LAS float* sc = qv + 256; LAS float* part = sc + 256;
    const int lane = pg8::pg8_lane_id(), tid = F.wave * 64 + lane; const int wave = F.wave;
    for (int it = F.blk; it < MS * 4; it += F.G) { const int b = it >> 2, h = it & 3;
        if (tid < 256) qv[tid] = qsb[(size_t)b * DM + h * 256 + tid];
        __syncthreads();
        const f32x4 q4 = *(const LAS f32x4*)(qv + lane * 4);
        const float* kb = ck + ((size_t)b * 256 * 4 + h) * 256 + lane * 4;
#pragma unroll 8
        for (int i = 0; i < 32; ++i) { const int m = wave * 32 + i; const f32x4 k4 = *(const f32x4*)(kb + (size_t)m * 1024);
            const float s = wave_sum((k4[0] * q4[0] + k4[1] * q4[1]) + (k4[2] * q4[2] + k4[3] * q4[3])); if (lane == 0) sc[m] = s; }
        __syncthreads();
        const f32x4 s4 = *(const LAS f32x4*)(sc + lane * 4);
        const float mx = wave_max(fmaxf(fmaxf(s4[0], s4[1]), fmaxf(s4[2], s4[3])));
        const f32x4 e4 = {__expf(s4[0] - mx), __expf(s4[1] - mx), __expf(s4[2] - mx), __expf(s4[3] - mx)};
        const float isum = 1.f / wave_sum((e4[0] + e4[1]) + (e4[2] + e4[3]));
        const float* vb = cv + ((size_t)b * 256 * 4 + h) * 256 + lane * 4;
        f32x4 acc = {0.f, 0.f, 0.f, 0.f};
#pragma unroll 2
        for (int io = 0; io < 8; ++io) {
#pragma unroll
            for (int r = 0; r < 4; ++r) { const int m = wave * 32 + io * 4 + r; const f32x4 v4 = *(const f32x4*)(vb + (size_t)m * 1024);
                const float p = __shfl(e4[r], wave * 8 + io) * isum; acc += v4 * p; } }
        *(LAS f32x4*)(part + wave * 256 + lane * 4) = acc;
        __syncthreads();
        if (tid < 256) { float o = 0.f;
#pragma unroll
            for (int w = 0; w < 8; ++w) o += part[w * 256 + tid];
            ctxs[(size_t)b * DM + h * 256 + tid] = o; }
        __syncthreads();
    }
}
__device__ __forceinline__ void final_norm_prompt(const Frame& F) {
    const int lane = pg8::pg8_lane_id(), tid = F.wave * 64 + lane; (void)tid;
    const int gw = F.blk * NWAVES + F.wave, NGW = F.G * NWAVES; const f32x4* g4 = (const f32x4*)F.in[24] + lane;
    for (int m = gw; m < MP; m += NGW) { f32x4* xr = (f32x4*)(F.out + O_YP + (size_t)m * DM) + lane; f32x4 v[4]; float s = 0.f;
#pragma unroll
        for (int j = 0; j < 4; ++j) { v[j] = xr[64 * j]; s += (v[j].x * v[j].x + v[j].y * v[j].y) + (v[j].z * v[j].z + v[j].w * v[j].w); }
        const float rstd = rsqrtf(wave_sum(s) * (1.f / DM) + EPS);
#pragma unroll
        for (int j = 0; j < 4; ++j) xr[64 * j] = v[j] * rstd * g4[64 * j]; }
}
__device__ __forceinline__ void final_norm_sample(const Frame& F) {
    const int lane = pg8::pg8_lane_id(), tid = F.wave * 64 + lane; (void)tid;
    const int gw = F.blk * NWAVES + F.wave, NGW = F.G * NWAVES; const f32x4* g4 = (const f32x4*)F.in[24] + lane; const float* parts = WSP(const float, WS_PARTS);
    for (int m = gw; m < MS; m += NGW) { f32x4* xr = (f32x4*)(F.out + O_YS + (size_t)m * DM) + lane; f32x4 v[4]; float s = 0.f;
#pragma unroll
        for (int j = 0; j < 4; ++j) { v[j] = xr[64 * j];
#pragma unroll
            for (int ks = 0; ks < 4; ++ks) v[j] += ((const f32x4*)(parts + ((size_t)ks * MS + m) * DM) + lane)[64 * j];
            s += (v[j].x * v[j].x + v[j].y * v[j].y) + (v[j].z * v[j].z + v[j].w * v[j].w); }
        const float rstd = rsqrtf(wave_sum(s) * (1.f / DM) + EPS);
#pragma unroll
        for (int j = 0; j < 4; ++j) xr[64 * j] = v[j] * rstd * g4[64 * j]; }
}
#ifndef MK_N_LAUNCHES
#define MK_N_LAUNCHES 1
#endif
constexpr int N_PHASES = 12;
struct Args { const float* in[25]; float* out; unsigned char* ws; int ph_lo, ph_hi; };
struct RotOrder {
    pg8::StaticOrder S;
    __device__ void init(int M, int N, int G, int c, int rot) { S.init(M, N, G, (c + G - (rot % G)) % G); }
    __device__ bool next(int i, pg8::Unit& u) const { return S.next(i, u); }
    __device__ __forceinline__ void a_ready(const pg8::Unit&) const {}
    __device__ __forceinline__ void done(const pg8::Unit&) const {}
};
__device__ __forceinline__ void grid_bar(unsigned* ctr, unsigned target) {
    asm volatile("s_waitcnt vmcnt(0) lgkmcnt(0)" ::: "memory");
    __syncthreads();
    if (__builtin_amdgcn_readfirstlane((int)threadIdx.x >> 6) == 0 && pg8::pg8_lane_id() == 0) {
        __builtin_amdgcn_fence(__ATOMIC_RELEASE, "agent");
        asm volatile("s_waitcnt vmcnt(0)" ::: "memory");
        __hip_atomic_fetch_add(ctr, 1u, __ATOMIC_RELAXED, __HIP_MEMORY_SCOPE_AGENT);
        unsigned spins = 0;
        while (__hip_atomic_load(ctr, __ATOMIC_RELAXED, __HIP_MEMORY_SCOPE_AGENT) < target) { __builtin_amdgcn_s_sleep(2); if (++spins > (1u << 24)) break; }
        __builtin_amdgcn_fence(__ATOMIC_ACQUIRE, "agent");
        asm volatile("s_waitcnt vmcnt(0)" ::: "memory");
    }
    __syncthreads();
}
__global__ void __launch_bounds__(NWAVES * 64, 2) mk_fwd(Args args) {
    extern __shared__ __attribute__((aligned(16))) unsigned char lds_raw[];
    Frame F;
    F.lds = (LAS unsigned char*)lds_raw;
    F.wave = __builtin_amdgcn_readfirstlane((int)threadIdx.x >> 6);
    F.G = gridDim.x; F.blk = blockIdx.x;
#pragma unroll
    for (int i = 0; i < 25; ++i) F.in[i] = args.in[i];
    F.out = args.out; F.ws = args.ws;
    const int lo = args.ph_lo, hi = args.ph_hi;
#define IN(k) (lo <= (k) && (k) < hi)
    unsigned nbar = 0; unsigned* const barw = (unsigned*)args.ws;
    if (hi - lo > 1) cg::this_grid().sync();
#define SEAM(k) do { if (IN(k) && IN((k) + 1)) { ++nbar; grid_bar(barw, nbar * (unsigned)F.G); } } while (0)
    typedef pg8::bf16_t pb;
    if (IN(0)) { p0_prologue(F); __syncthreads(); }
    SEAM(0);
    if (IN(1)) {
        { SEpiStore E{WSP(float, WS_PROJS), INC, 1.f}; skinny_gemm<true>(F, F.in[1], DM, WSP(const bf16, WS_WIN), DM, DM, INC / 16, 1, E); }
        { pg8::Gemm g{WSP(const pb, WS_H), WSP(const pb, WS_WIN), MP, INP, DM}; pg8::StaticOrder S; S.init(MP, INP, F.G, F.blk);
          pg8::EpiPlainBf16 E{WSP(pb, WS_PROJ), INP}; pg8::gemm_phase<pg8::EpiPlainBf16, pg8::StaticOrder, true, true>(F.lds, F.wave, g, S, E); }
        { pg8::Gemm g{WSP(const pb, WS_MN), WSP(const pb, WS_WKV), NB * 256, 2048, DM}; RotOrder S; S.init(NB * 256, 2048, F.G, F.blk, 64);
          pg8::EpiKV E{F.out + O_KP, F.out + O_VP, WSP(pb, WS_KB), WSP(pb, WS_VT)}; pg8::gemm_phase<pg8::EpiKV, RotOrder, true, true>(F.lds, F.wave, g, S, E); }
    }
    SEAM(1);
    if (IN(2)) { s_mixers(F); p2_pool_prompt(F); p2_gla_local(F); }
    SEAM(2);
    if (IN(3)) {
        { SEpiRes E{F.in[1], F.out + O_YS}; skinny_gemm<false>(F, WSP(const float, WS_MIXS), DM, WSP(const bf16, WS_WOUT), DM, DM, DM / 16, 1, E); }
        p3_gla_scan(F);
    }
    SEAM(3);
    if (IN(4)) {
        { SEpiStore E{WSP(float, WS_QS), DM, 0.0625f}; skinny_gemm<true>(F, F.out + O_YS, DM, WSP(const bf16, WS_WQM), DM, DM, DM / 16, 1, E); }
        p4_gla_out(F);
    }
    SEAM(4);
    if (IN(5)) {
        s_attn(F);
        { pg8::Gemm g{WSP(const pb, WS_H), WSP(const pb, WS_WOUT), MP, DM, DM}; pg8::StaticOrder S; S.init(MP, DM, F.G, F.blk);
          pg8::EpiRes<true, true> E{F.in[0], F.out + O_YP, WSP(pb, WS_XB), WSP(float, WS_SSQ1)}; pg8::gemm_phase<pg8::EpiRes<true, true>, pg8::StaticOrder, true, true>(F.lds, F.wave, g, S, E); }
    }
    SEAM(5);
    if (IN(6)) {
        { SEpiRes E{F.out + O_YS, F.out + O_YS}; skinny_gemm<false>(F, WSP(const float, WS_CTXS), DM, WSP(const bf16, WS_WOM), DM, DM, DM / 16, 1, E); }
        { pg8::Gemm g{WSP(const pb, WS_XB), WSP(const pb, WS_WQM), MP, DM, DM}; pg8::StaticOrder S; S.init(MP, DM, F.G, F.blk);
          pg8::EpiScale<0> E{WSP(pb, WS_Q), DM, WSP(const float, WS_SSQ1), 0.0625f}; pg8::gemm_phase<pg8::EpiScale<0>, pg8::StaticOrder, true, true>(F.lds, F.wave, g, S, E); }
    }
    SEAM(6);
    if (IN(7)) {
        { SEpiRelu2 E{WSP(float, WS_HFFS)}; skinny_gemm<true>(F, F.out + O_YS, DM, WSP(const bf16, WS_WUP), DM, DM, FF / 16, 1, E); }
        __syncthreads();
        p7_attn_prompt(F);
    }
    SEAM(7);
    if (IN(8)) {
        { SEpiPart E{WSP(float, WS_PARTS)}; skinny_gemm<false>(F, WSP(const float, WS_HFFS), FF, WSP(const bf16, WS_WDN), FF, DM, DM / 16, 4, E); }
        { pg8::Gemm g{WSP(const pb, WS_CTX), WSP(const pb, WS_WOM), MP, DM, DM}; pg8::StaticOrder S; S.init(MP, DM, F.G, F.blk);
          pg8::EpiRes<true, true> E{F.out + O_YP, F.out + O_YP, WSP(pb, WS_XB), WSP(float, WS_SSQ2)}; pg8::gemm_phase<pg8::EpiRes<true, true>, pg8::StaticOrder, true, true>(F.lds, F.wave, g, S, E); }
    }
    SEAM(8);
    if (IN(9)) {
        final_norm_sample(F);
        { pg8::Gemm g{WSP(const pb, WS_XB), WSP(const pb, WS_WUP), MP, FF, DM}; pg8::StaticOrder S; S.init(MP, FF, F.G, F.blk);
          pg8::EpiScale<1> E{WSP(pb, WS_HFF), FF, WSP(const float, WS_SSQ2), 1.f}; pg8::gemm_phase<pg8::EpiScale<1>, pg8::StaticOrder, true, true>(F.lds, F.wave, g, S, E); }
    }
    SEAM(9);
    if (IN(10)) {
        pg8::Gemm g{WSP(const pb, WS_HFF), WSP(const pb, WS_WDN), MP, DM, FF}; pg8::StaticOrder S; S.init(MP, DM, F.G, F.blk);
        pg8::EpiRes<false, false> E{F.out + O_YP, F.out + O_YP, nullptr, nullptr}; pg8::gemm_phase<pg8::EpiRes<false, false>, pg8::StaticOrder, true, true>(F.lds, F.wave, g, S, E);
    }
    SEAM(10);
    if (IN(11)) final_norm_prompt(F);
#undef IN
#undef SEAM
}

extern "C" void kernel_launch(void* const* d_in, const int* in_sizes, int n_in, void* d_out, int out_size, void* d_ws, size_t ws_size, hipStream_t stream) {
    static int grid = 0;
    if (grid == 0) {
        if (n_in != 25 || ws_size < WS_END) { fprintf(stderr, "kernel_launch: unexpected inputs (n_in %d, ws %zu)\n", n_in, ws_size); grid = -1; return; }
        int dev = 0, cus = 0, per_cu = 0;
        hipGetDevice(&dev); hipDeviceGetAttribute(&cus, hipDeviceAttributeMultiprocessorCount, dev);
        if (hipFuncSetAttribute((const void*)mk_fwd, hipFuncAttributeMaxDynamicSharedMemorySize, LDS_BYTES) != hipSuccess) { fprintf(stderr, "kernel_launch: hipFuncSetAttribute failed\n"); grid = -1; return; }
        if (hipOccupancyMaxActiveBlocksPerMultiprocessor(&per_cu, (const void*)mk_fwd, NWAVES * 64, LDS_BYTES) != hipSuccess || per_cu < 1) { fprintf(stderr, "kernel_launch: occupancy query says %d\n", per_cu); per_cu = 1; }
        (void)hipGetLastError();
        grid = cus * 1;
        fprintf(stderr, "kernel_launch: grid %d (cus %d, per_cu %d)\n", grid, cus, per_cu);
    }
    if (grid < 0) return;
    if (hipMemsetAsync(d_ws, 0, 256, stream) != hipSuccess) { fprintf(stderr, "kernel_launch: memset failed\n"); return; }
    Args a{};
    for (int i = 0; i < 25; ++i) a.in[i] = (const float*)d_in[i];
    a.out = (float*)d_out; a.ws = (unsigned char*)d_ws;
#if MK_N_LAUNCHES == 1
    a.ph_lo = 0; a.ph_hi = N_PHASES;
    void* kargs[] = {&a};
    hipError_t e = hipLaunchCooperativeKernel((const void*)mk_fwd, dim3(grid), dim3(NWAVES * 64), kargs, LDS_BYTES, stream);
    if (e != hipSuccess) fprintf(stderr, "cooperative launch failed: %s (grid %d)\n", hipGetErrorString(e), grid);
#else
    for (int p = 0; p < N_PHASES; ++p) { a.ph_lo = p; a.ph_hi = p + 1; hipLaunchKernelGGL(mk_fwd, dim3(grid), dim3(NWAVES * 64), LDS_BYTES, stream, a); }
#endif
}
```

```cpp
#include <hip/hip_runtime.h>
#include <hip/hip_cooperative_groups.h>
#include <cstdio>
#include <cstdint>
namespace cg = cooperative_groups;
namespace pg8 {
#define PG8_LAS __attribute__((address_space(3)))
typedef unsigned short bf16_t;
typedef short bf16x8 __attribute__((ext_vector_type(8)));
typedef float f32x4 __attribute__((ext_vector_type(4)));
typedef unsigned u32x4 __attribute__((ext_vector_type(4)));
constexpr int BM = 256, BK = 64, HALF = 128, HTB = HALF * BK * 2  , STAGE_BYTES = 8 * HTB, NXCD = 8, WGM = 8;

__host__ __device__ __forceinline__ int lds_byte(int r, int c) { const int st = (r >> 4) * 2 + (c >> 5), rr = r & 15, cc = c & 31, ob = rr * 64 + cc * 2; return st * 1024 + (ob ^ (((ob >> 9) & 1) << 5)); }
__host__ __device__ __forceinline__ void stage_rc(int b, int& R, int& C) { const int st = b / 1024, sb = b % 1024, swz = sb ^ (((sb >> 9) & 1) << 5); R = (st >> 1) * 16 + swz / 64; C = (st & 1) * 32 + (swz % 64) / 2; }
__host__ __device__ __forceinline__ int perm32(int rho) { const int n = rho >> 4, i = rho & 15; return 8 * (i >> 2) + 4 * n + (i & 3); }

struct Unit { int pm, pn; };
struct Gemm { const bf16_t* A; const bf16_t* Bt; int M, N, K; };

struct StaticOrder {
    int nM, nN, nwg, G, c;
    __host__ __device__ void init(int M, int N, int G_, int c_) { nM = M / BM; nN = N / BM; nwg = nM * nN; G = G_; c = c_; }
    __host__ __device__ bool next(int i, Unit& u) const {
        const long L = (long)i * G + c; if (L >= nwg) return false;
        int wgid = (int)L; { const int q = nwg / NXCD, r = nwg % NXCD, xcd = wgid % NXCD, off = wgid / NXCD; wgid = (xcd < r ? xcd * (q + 1) : r * (q + 1) + (xcd - r) * q) + off; }
        const int nig = WGM * nN, gid = wgid / nig, fm = gid * WGM, gsz = (nM - fm) < WGM ? (nM - fm) : WGM;
        u.pm = fm + ((wgid % nig) % gsz); u.pn = (wgid % nig) / gsz; return true;
    }
    __device__ __forceinline__ void a_ready(const Unit&) const {}
    __device__ __forceinline__ void done(const Unit&) const {}
};

typedef float f32x2 __attribute__((ext_vector_type(2)));
typedef __bf16 bf16x2_t __attribute__((ext_vector_type(2)));
__device__ __forceinline__ unsigned cvt_pk_bf16(float lo, float hi) { const f32x2 v = {lo, hi}; return __builtin_bit_cast(unsigned, __builtin_convertvector(v, bf16x2_t)); }
__device__ __forceinline__ int pg8_lane_id() { int l; asm volatile("v_mbcnt_lo_u32_b32 %0, -1, 0\n\tv_mbcnt_hi_u32_b32 %0, -1, %0" : "=v"(l)); return l; }
typedef unsigned u32x2 __attribute__((ext_vector_type(2)));
struct EpiPlainBf16 {
    static constexpr bool PERM = true, AFTER_DRAIN = false;
    bf16_t* O; int ldc;
    __device__ __forceinline__ void operator()(const f32x4 (&acc)[2][2][4][2], const Unit& u, int wr, int wc, int fr, int fq) const {
        const int row0 = u.pm * BM + wr * 64 + fr, col0 = u.pn * BM + wc * 32 + 8 * fq;
#pragma unroll
        for (int ai = 0; ai < 2; ++ai)
#pragma unroll
            for (int m = 0; m < 4; ++m) { bf16_t* rowp = O + (size_t)(row0 + ai * HALF + m * 16) * ldc + col0;
#pragma unroll
                for (int bj = 0; bj < 2; ++bj) { const f32x4 v0 = acc[ai][bj][m][0], v1 = acc[ai][bj][m][1];
                    u32x4 w; w.x = cvt_pk_bf16(v0[0], v0[1]); w.y = cvt_pk_bf16(v0[2], v0[3]); w.z = cvt_pk_bf16(v1[0], v1[1]); w.w = cvt_pk_bf16(v1[2], v1[3]);
                    *(u32x4*)(rowp + bj * HALF) = w; } }
    }
};
struct EpiKV {
    static constexpr bool PERM = true, AFTER_DRAIN = false;
    float* outK; float* outV; bf16_t* KB; bf16_t* VT;
    __device__ __forceinline__ void operator()(const f32x4 (&acc)[2][2][4][2], const Unit& u, int wr, int wc, int fr, int fq) const {
        const bool isV = u.pn >= 4; const int h = u.pn & 3, b = u.pm;
        float* of = isV ? outV : outK;
        const int ct0 = wc * 32 + 8 * fq;
#pragma unroll
        for (int ai = 0; ai < 2; ++ai)
#pragma unroll
            for (int m = 0; m < 4; ++m) { const int key = ai * HALF + wr * 64 + m * 16 + fr;
#pragma unroll
                for (int bj = 0; bj < 2; ++bj) { const f32x4 v0 = acc[ai][bj][m][0], v1 = acc[ai][bj][m][1]; const int ct = ct0 + bj * HALF;
                    float* fp = of + (size_t)(b * 256 + key) * 1024 + h * 256 + ct;
                    *(f32x4*)fp = v0; *(f32x4*)(fp + 4) = v1;
                    if (!isV) { u32x4 w; w.x = cvt_pk_bf16(v0[0], v0[1]); w.y = cvt_pk_bf16(v0[2], v0[3]); w.z = cvt_pk_bf16(v1[0], v1[1]); w.w = cvt_pk_bf16(v1[2], v1[3]);
                        *(u32x4*)(KB + ((size_t)(b * 4 + h) * 256 + key) * 256 + ct) = w; }
                    else { bf16_t* vp = VT + ((size_t)(b * 4 + h) * 256 + ct) * 256 + key;
#pragma unroll
                        for (int e = 0; e < 4; ++e) { vp[(size_t)e * 256] = (bf16_t)(cvt_pk_bf16(v0[e], 0.f) & 0xffffu); vp[(size_t)(e + 4) * 256] = (bf16_t)(cvt_pk_bf16(v1[e], 0.f) & 0xffffu); } }
                } }
    }
};
template <bool XB, bool SSQ> struct EpiRes {
    static constexpr bool PERM = false, AFTER_DRAIN = false;
    const float* base; float* out; bf16_t* xb; float* ssq;
    __device__ __forceinline__ void operator()(const f32x4 (&acc)[2][2][4][2], const Unit& u, int wr, int wc, int fr, int fq) const {
        const int col0 = u.pn * BM + wc * 32 + 4 * fq;
#pragma unroll
        for (int ai = 0; ai < 2; ++ai)
#pragma unroll
            for (int m = 0; m < 4; ++m) { const int r = u.pm * BM + ai * HALF + wr * 64 + m * 16 + fr; const size_t off = (size_t)r * 1024 + col0; float s = 0.f;
#pragma unroll
                for (int bj = 0; bj < 2; ++bj)
#pragma unroll
                    for (int n = 0; n < 2; ++n) { const f32x4 bs = *(const f32x4*)(base + off + bj * HALF + n * 16); const f32x4 o = bs + acc[ai][bj][m][n];
                        *(f32x4*)(out + off + bj * HALF + n * 16) = o;
                        if (SSQ) s += (o[0] * o[0] + o[1] * o[1]) + (o[2] * o[2] + o[3] * o[3]);
                        if (XB) { u32x2 w; w.x = cvt_pk_bf16(o[0], o[1]); w.y = cvt_pk_bf16(o[2], o[3]); *(u32x2*)(xb + off + bj * HALF + n * 16) = w; } }
                if (SSQ) { s += __shfl_xor(s, 16); s += __shfl_xor(s, 32); if (fq == 0) ssq[(size_t)r * 16 + u.pn * 4 + wc] = s; }
            }
    }
};
template <int MODE> struct EpiScale {
    static constexpr bool PERM = true, AFTER_DRAIN = false;
    bf16_t* O; int ldc; const float* ssq; float scale;
    __device__ __forceinline__ void operator()(const f32x4 (&acc)[2][2][4][2], const Unit& u, int wr, int wc, int fr, int fq) const {
        const int row0 = u.pm * BM + wr * 64 + fr, col0 = u.pn * BM + wc * 32 + 8 * fq;
#pragma unroll
        for (int ai = 0; ai < 2; ++ai)
#pragma unroll
            for (int m = 0; m < 4; ++m) { const int r = row0 + ai * HALF + m * 16; bf16_t* rowp = O + (size_t)r * ldc + col0;
                const f32x4* sp = (const f32x4*)(ssq + (size_t)r * 16); const f32x4 s0 = sp[0], s1 = sp[1], s2 = sp[2], s3 = sp[3];
                const float tot = ((s0[0] + s0[1]) + (s0[2] + s0[3])) + ((s1[0] + s1[1]) + (s1[2] + s1[3])) + ((s2[0] + s2[1]) + (s2[2] + s2[3])) + ((s3[0] + s3[1]) + (s3[2] + s3[3]));
                const float rs = rsqrtf(tot * (1.0f / 1024.0f) + 1e-6f) * (MODE == 0 ? scale : 1.0f);
#pragma unroll
                for (int bj = 0; bj < 2; ++bj) { f32x4 v0 = acc[ai][bj][m][0] * rs, v1 = acc[ai][bj][m][1] * rs;
                    if (MODE == 1) {
#pragma unroll
                        for (int e = 0; e < 4; ++e) { const float a0 = fmaxf(v0[e], 0.f), a1 = fmaxf(v1[e], 0.f); v0[e] = a0 * a0; v1[e] = a1 * a1; } }
                    u32x4 w; w.x = cvt_pk_bf16(v0[0], v0[1]); w.y = cvt_pk_bf16(v0[2], v0[3]); w.z = cvt_pk_bf16(v1[0], v1[1]); w.w = cvt_pk_bf16(v1[2], v1[3]);
                    *(u32x4*)(rowp + bj * HALF) = w; } }
    }
};

template <class Epi, class Sched, bool ALIGN_EPI = false, bool SP2 = false>
__device__ __forceinline__ void gemm_phase(PG8_LAS unsigned char* lds, const int wave_in, const Gemm g, const Sched& S, const Epi& E) {
    const int wid = wave_in, lane = pg8_lane_id(), tid = wid * 64 + lane, wr = wid >> 2, wc = wid & 3, fr = lane & 15, fq = lane >> 4;
    const int K = g.K, nt = K / BK;
    unsigned voffA[2], voffB[2];
#pragma unroll
    for (int i = 0; i < 2; ++i) { int R, C; stage_rc(tid * 16 + i * 8192, R, C); const int Rb = Epi::PERM ? ((R & ~31) + perm32(R & 31)) : R;
        voffA[i] = (unsigned)(R * K + C) * 2u; voffB[i] = (unsigned)(Rb * K + C) * 2u; }
    const size_t kstep = (size_t)(BK * 2);
    const size_t hstep = (size_t)HALF * K * 2;
    const size_t tstep = 2 * hstep;
    const unsigned ldsw = (unsigned)wid * 1024u;
    const int aoff = lds_byte(wr * 64 + fr, fq * 8), boff = lds_byte(wc * 32 + fr, fq * 8);
#define PG8_SA(b, h) (((b) * 2 + (h)) * HTB)
#define PG8_SB(b, h) ((4 + (b) * 2 + (h)) * HTB)
#define PG8_STAGE(bufoff, gbase, voff) do { _Pragma("unroll") for (int _i = 0; _i < 2; ++_i) \
        __builtin_amdgcn_global_load_lds((const unsigned*)((const char*)(gbase) + (voff)[_i]), (PG8_LAS unsigned*)(lds + (bufoff) + ldsw + _i * 8192), 16, 0, 0); } while (0)
#define PG8_LDA(dst, b, h) do { _Pragma("unroll") for (int m = 0; m < 4; ++m) _Pragma("unroll") for (int k = 0; k < 2; ++k) dst[m][k] = *(const PG8_LAS bf16x8*)(lds + PG8_SA(b, h) + aoff + m * 2048 + k * 1024); } while (0)
#define PG8_LDB(dst, b, h) do { _Pragma("unroll") for (int n = 0; n < 2; ++n) _Pragma("unroll") for (int k = 0; k < 2; ++k) dst[n][k] = *(const PG8_LAS bf16x8*)(lds + PG8_SB(b, h) + boff + n * 2048 + k * 1024); } while (0)
#define PG8_MMA(ai, bj, At, Bt) do { __builtin_amdgcn_s_setprio(1); _Pragma("unroll") for (int m = 0; m < 4; ++m) _Pragma("unroll") for (int n = 0; n < 2; ++n) _Pragma("unroll") for (int k = 0; k < 2; ++k) \
        acc[ai][bj][m][n] = __builtin_amdgcn_mfma_f32_16x16x32_bf16(Bt[n][k], At[m][k], acc[ai][bj][m][n], 0, 0, 0); __builtin_amdgcn_s_setprio(0); } while (0)
#define PG8_WAIT_V(n) asm volatile("s_waitcnt vmcnt(" #n ")" ::: "memory")
#define PG8_WAIT_L(n) asm volatile("s_waitcnt lgkmcnt(" #n ")" ::: "memory")
#define PG8_BAR __builtin_amdgcn_s_barrier()
#define PG8_SCHED __builtin_amdgcn_sched_barrier(0)
    Unit cur, nxt; int ui = 0;
    if (!S.next(0, cur)) return;
    f32x4 acc[2][2][4][2];
#pragma unroll
    for (int a = 0; a < 2; ++a)
#pragma unroll
        for (int b = 0; b < 2; ++b)
#pragma unroll
            for (int m = 0; m < 4; ++m)
#pragma unroll
                for (int n = 0; n < 2; ++n) acc[a][b][m][n] = (f32x4){0.f, 0.f, 0.f, 0.f};
    bf16x8 At[4][2], B0[2][2], B1[2][2];
    const char* cA = (const char*)g.A + (size_t)cur.pm * tstep; const char* cB = (const char*)g.Bt + (size_t)cur.pn * tstep;
    S.a_ready(cur);
    if constexpr (SP2) {
        PG8_STAGE(PG8_SB(0, 0), cB, voffB); PG8_STAGE(PG8_SB(0, 1), cB + hstep, voffB); PG8_STAGE(PG8_SA(0, 0), cA, voffA); PG8_STAGE(PG8_SA(0, 1), cA + hstep, voffA);
        if (wr == 1) PG8_BAR;
        PG8_WAIT_V(2); PG8_BAR;
        PG8_STAGE(PG8_SB(1, 0), cB + kstep, voffB); PG8_STAGE(PG8_SA(1, 0), cA + kstep, voffA); PG8_STAGE(PG8_SB(1, 1), cB + hstep + kstep, voffB);
        PG8_WAIT_V(6); PG8_BAR;
    } else {
        PG8_STAGE(PG8_SB(0, 0), cB, voffB); PG8_STAGE(PG8_SA(0, 0), cA, voffA); PG8_STAGE(PG8_SB(0, 1), cB + hstep, voffB); PG8_STAGE(PG8_SA(0, 1), cA + hstep, voffA);
        if (wr == 1) PG8_BAR;
        PG8_WAIT_V(4); PG8_BAR;
        PG8_STAGE(PG8_SB(1, 0), cB + kstep, voffB); PG8_STAGE(PG8_SA(1, 0), cA + kstep, voffA); PG8_STAGE(PG8_SB(1, 1), cB + hstep + kstep, voffB);
        PG8_WAIT_V(6); PG8_BAR;
    }
    for (;;) {
        const bool has_next = S.next(ui + 1, nxt);
        const char* nA = has_next ? (const char*)g.A + (size_t)nxt.pm * tstep : cA; const char* nB = has_next ? (const char*)g.Bt + (size_t)nxt.pn * tstep : cB;
        for (int t = 0; t < nt; t += 2) {
            const bool last = (t == nt - 2);
            const char* a1 = cA + (size_t)(t + 1) * kstep;
            const char* a2 = last ? nA : cA + (size_t)(t + 2) * kstep; const char* b2 = last ? nB : cB + (size_t)(t + 2) * kstep;
            const char* a3 = a2 + kstep; const char* b3 = b2 + kstep;
            if (last && has_next) S.a_ready(nxt);
            if constexpr (SP2) {
            PG8_LDB(B0, 0, 0); PG8_LDB(B1, 0, 1); PG8_SCHED; PG8_LDA(At, 0, 0); PG8_STAGE(PG8_SA(1, 1), a1 + hstep, voffA);
            PG8_WAIT_V(8); PG8_WAIT_L(0); PG8_BAR; PG8_MMA(0, 0, At, B0); PG8_MMA(0, 1, At, B1); PG8_BAR; PG8_SCHED;
            PG8_LDA(At, 0, 1); PG8_STAGE(PG8_SB(0, 0), b2, voffB); PG8_STAGE(PG8_SB(0, 1), b2 + hstep, voffB); PG8_STAGE(PG8_SA(0, 0), a2, voffA);
            PG8_WAIT_V(8); PG8_WAIT_L(0); PG8_BAR; PG8_MMA(1, 0, At, B0); PG8_MMA(1, 1, At, B1); PG8_BAR; PG8_SCHED;
            PG8_LDB(B0, 1, 0); PG8_LDB(B1, 1, 1); PG8_SCHED; PG8_LDA(At, 1, 0); PG8_STAGE(PG8_SA(0, 1), a2 + hstep, voffA);
            PG8_WAIT_V(8); PG8_WAIT_L(0); PG8_BAR; PG8_MMA(0, 0, At, B0); PG8_MMA(0, 1, At, B1); PG8_BAR; PG8_SCHED;
            PG8_LDA(At, 1, 1); PG8_STAGE(PG8_SB(1, 0), b3, voffB); PG8_STAGE(PG8_SB(1, 1), b3 + hstep, voffB); PG8_STAGE(PG8_SA(1, 0), a3, voffA);
            PG8_WAIT_V(8); PG8_WAIT_L(0); PG8_BAR; PG8_MMA(1, 0, At, B0); PG8_MMA(1, 1, At, B1); PG8_BAR; PG8_SCHED;
            } else {
            PG8_LDB(B0, 0, 0); PG8_SCHED; PG8_LDA(At, 0, 0); PG8_STAGE(PG8_SA(1, 1), a1 + hstep, voffA);
            PG8_WAIT_L(8); PG8_BAR; PG8_WAIT_L(0); PG8_MMA(0, 0, At, B0); PG8_BAR; PG8_SCHED;
            PG8_LDB(B1, 0, 1); PG8_STAGE(PG8_SB(0, 0), b2, voffB);
            PG8_BAR; PG8_WAIT_L(0); PG8_MMA(0, 1, At, B1); PG8_BAR;
            PG8_LDA(At, 0, 1); PG8_STAGE(PG8_SA(0, 0), a2, voffA);
            PG8_BAR; PG8_WAIT_L(0); PG8_MMA(1, 0, At, B0); PG8_BAR; PG8_SCHED;
            PG8_STAGE(PG8_SB(0, 1), b2 + hstep, voffB);
            PG8_WAIT_V(6); PG8_BAR; PG8_MMA(1, 1, At, B1); PG8_BAR;
            PG8_LDB(B0, 1, 0); PG8_SCHED; PG8_LDA(At, 1, 0); PG8_STAGE(PG8_SA(0, 1), a2 + hstep, voffA);
            PG8_WAIT_L(8); PG8_BAR; PG8_WAIT_L(0); PG8_MMA(0, 0, At, B0); PG8_BAR; PG8_SCHED;
            PG8_LDB(B1, 1, 1); PG8_STAGE(PG8_SB(1, 0), b3, voffB);
            PG8_BAR; PG8_WAIT_L(0); PG8_MMA(0, 1, At, B1); PG8_BAR;
            PG8_LDA(At, 1, 1); PG8_STAGE(PG8_SA(1, 0), a3, voffA);
            PG8_BAR; PG8_WAIT_L(0); PG8_MMA(1, 0, At, B0); PG8_BAR; PG8_SCHED;
            PG8_STAGE(PG8_SB(1, 1), b3 + hstep, voffB);
            PG8_WAIT_V(6); PG8_BAR; PG8_MMA(1, 1, At, B1); PG8_BAR;
            }
        }
        if constexpr (ALIGN_EPI) { if (wr == 0) PG8_BAR; }
        if constexpr (!Epi::AFTER_DRAIN) { E(acc, cur, wr, wc, fr, fq); S.done(cur); }
        if (!has_next) break;
#pragma unroll
        for (int a = 0; a < 2; ++a)
#pragma unroll
            for (int b = 0; b < 2; ++b)
#pragma unroll
                for (int m = 0; m < 4; ++m)
#pragma unroll
                    for (int n = 0; n < 2; ++n) acc[a][b][m][n] = (f32x4){0.f, 0.f, 0.f, 0.f};
        cur = nxt; cA = nA; cB = nB; ++ui;
        if constexpr (ALIGN_EPI) { if (wr == 1) PG8_BAR; }
    }
    PG8_WAIT_V(0);
    if constexpr (!ALIGN_EPI) { if (wr == 0) PG8_BAR; }
    PG8_BAR;
    if constexpr (Epi::AFTER_DRAIN) { E.fused(acc, cur, wr, wc, fr, fq, lds, wid, lane); S.done(cur); }
#undef PG8_SA
#undef PG8_SB
#undef PG8_STAGE
#undef PG8_LDA
#undef PG8_LDB
#undef PG8_MMA
#undef PG8_WAIT_V
#undef PG8_WAIT_L
#undef PG8_BAR
#undef PG8_SCHED
}
}
constexpr int NWAVES = 8;
constexpr int DM = 1024, MP = 16384, SEQ = 2048, NB = 8, MS = 128;
constexpr int INC = 2064, INP = 2304;
constexpr int C_Q = 512, C_K = 768, C_V = 1024, C_G = 1536, C_F = 2048;
constexpr int FF = 4096;
constexpr float EPS = 1e-6f;
constexpr size_t O_YP = 0, O_YS = 16777216, O_SPP = O_YS + 131072, O_SGP = O_SPP + 61440, O_KP = O_SGP + 262144, O_VP = O_KP + 2097152, O_SPS = O_VP + 2097152, O_SGS = O_SPS + 983040;
constexpr size_t MiB = 1u << 20;
constexpr size_t WS_WIN = 2 * MiB, WS_WKV = 8 * MiB, WS_WOUT = 12 * MiB, WS_WQM = 14 * MiB, WS_WOM = 16 * MiB, WS_WUP = 18 * MiB, WS_WDN = 26 * MiB;
constexpr size_t WS_MN = 34 * MiB, WS_KB = 38 * MiB, WS_VT = 42 * MiB, WS_SSQ1 = 46 * MiB, WS_SSQ2 = 47 * MiB;
constexpr size_t WS_PROJS = 49 * MiB  , WS_MIXS = 51 * MiB  , WS_QS = 52 * MiB, WS_CTXS = 53 * MiB, WS_HFFS = 54 * MiB  , WS_PARTS = 56 * MiB  ;
constexpr size_t WS_H = 64 * MiB  , WS_XB = 96 * MiB, WS_Q = 128 * MiB, WS_CTX = 160 * MiB;
constexpr size_t WS_PROJ = 192 * MiB  , WS_GL = 264 * MiB  , WS_CUM = 296 * MiB  , WS_ST = 312 * MiB  ;
constexpr size_t WS_HFF = 192 * MiB  ;
constexpr size_t WS_END = 328 * MiB;
constexpr int LDS_BYTES = 147456;

#define LAS __attribute__((address_space(3)))
typedef unsigned short bf16;
typedef unsigned u32x4 __attribute__((ext_vector_type(4)));
typedef unsigned u32x2 __attribute__((ext_vector_type(2)));
typedef float f32x4 __attribute__((ext_vector_type(4)));
typedef short bf16x8 __attribute__((ext_vector_type(8)));
typedef short bf16x4 __attribute__((ext_vector_type(4)));
#define LDS_WAIT() asm volatile("s_waitcnt lgkmcnt(0)" ::: "memory")
__device__ __forceinline__ unsigned pk2(float lo, float hi) { return pg8::cvt_pk_bf16(lo, hi); }
__device__ __forceinline__ float bf2f(unsigned short h) { return __uint_as_float((unsigned)h << 16); }
__device__ __forceinline__ float bflo(unsigned w) { return __uint_as_float(w << 16); }
__device__ __forceinline__ float bfhi(unsigned w) { return __uint_as_float(w & 0xffff0000u); }
__device__ __forceinline__ float wave_sum(float v) {
#pragma unroll
    for (int o = 1; o < 64; o <<= 1) v += __shfl_xor(v, o);
    return v;
}
__device__ __forceinline__ float wave_max(float v) {
#pragma unroll
    for (int o = 1; o < 64; o <<= 1) v = fmaxf(v, __shfl_xor(v, o));
    return v;
}
__device__ __forceinline__ float logsig(float x) { return fminf(x, 0.f) - log1pf(__expf(-fabsf(x))); }
__device__ __forceinline__ float silu(float x) { return x / (1.f + __expf(-x)); }
__device__ __forceinline__ f32x4 mfma16(bf16x8 a, bf16x8 b, f32x4 c) { return __builtin_amdgcn_mfma_f32_16x16x32_bf16(a, b, c, 0, 0, 0); }

struct Frame {
    LAS unsigned char* lds;
    int wave, G, blk;
    const float* in[25]; float* out; unsigned char* ws;
};
#define WSP(T, off) ((T*)(F.ws + (off)))

__device__ __forceinline__ void transpose_item(const float* W, int ldw, int nreal, bf16* WT, int ldt, int row_off, const float* gain, LAS float* scr, int k0, int n0, int lane) {
    const int n = n0 + (lane & 31);
#pragma unroll 8
    for (int i = 0; i < 32; ++i) { const int kk = 2 * i + (lane >> 5); float v = (n < nreal) ? W[(size_t)(k0 + kk) * ldw + n] : 0.f; if (gain) v *= gain[k0 + kk]; scr[kk * 33 + (lane & 31)] = v; }
    LDS_WAIT(); asm volatile("" ::: "memory");
    const int c = lane & 7;
#pragma unroll
    for (int j = 0; j < 4; ++j) { const int nn = (lane >> 3) + 8 * j; const LAS float* s = scr + (8 * c) * 33 + nn;
        u32x4 o; o.x = pk2(s[0 * 33], s[1 * 33]); o.y = pk2(s[2 * 33], s[3 * 33]); o.z = pk2(s[4 * 33], s[5 * 33]); o.w = pk2(s[6 * 33], s[7 * 33]);
        *(u32x4*)(WT + (size_t)(row_off + n0 + nn) * ldt + k0 + 8 * c) = o; }
    LDS_WAIT(); asm volatile("" ::: "memory");
}
__device__ __forceinline__ void rms_row_to_bf16(const float* xrow, bf16* orow, int lane) {
    const f32x4* xr = (const f32x4*)xrow + lane;
    f32x4 v[4]; float s = 0.f;
#pragma unroll
    for (int j = 0; j < 4; ++j) { v[j] = xr[64 * j]; s += (v[j].x * v[j].x + v[j].y * v[j].y) + (v[j].z * v[j].z + v[j].w * v[j].w); }
    const float rstd = rsqrtf(wave_sum(s) * (1.f / DM) + EPS);
    unsigned long long* o8 = (unsigned long long*)orow + lane;
#pragma unroll
    for (int j = 0; j < 4; ++j) o8[64 * j] = (unsigned long long)pk2(v[j].x * rstd, v[j].y * rstd) | ((unsigned long long)pk2(v[j].z * rstd, v[j].w * rstd) << 32);
}
__device__ __forceinline__ void p0_prologue(const Frame& F) {
    const int lane = pg8::pg8_lane_id(), tid = F.wave * 64 + lane; (void)tid;
    LAS float* scr = (LAS float*)(F.lds + F.wave * 8704);
    { const float* wp = F.in[11]; const float* ps = F.in[12]; const float* wo = F.in[14]; bf16* wt = WSP(bf16, WS_WOUT);
      LAS float* Wp = (LAS float*)F.lds; LAS float* Wo = (LAS float*)(F.lds + 65536);
      for (int it = F.blk; it < 64; it += F.G) { const int g = it >> 4, n0 = (it & 15) * 64;
#pragma unroll
          for (int i = 0; i < 8; ++i) { const int i4 = (i * 512 + tid) * 4; *(LAS f32x4*)(Wp + i4) = *(const f32x4*)(wp + (size_t)g * 16384 + i4); }
#pragma unroll
          for (int i = 0; i < 16; ++i) { const int e = i * 512 + tid, d = e >> 6, nn = e & 63; Wo[e] = wo[(size_t)(g * 128 + d) * DM + n0 + nn] * ps[g * 128 + d]; }
          __syncthreads();
          const int n = tid & 63; float acc[16];
#pragma unroll
          for (int ci = 0; ci < 16; ++ci) acc[ci] = 0.f;
#pragma unroll 2
          for (int d4 = 0; d4 < 32; ++d4) { const float a0 = Wo[(d4 * 4 + 0) * 64 + n], a1 = Wo[(d4 * 4 + 1) * 64 + n], a2 = Wo[(d4 * 4 + 2) * 64 + n], a3 = Wo[(d4 * 4 + 3) * 64 + n];
#pragma unroll
              for (int ci = 0; ci < 16; ++ci) { const f32x4 w4 = *(const LAS f32x4*)(Wp + (F.wave * 16 + ci) * 128 + d4 * 4); acc[ci] += (w4[0] * a0 + w4[1] * a1) + (w4[2] * a2 + w4[3] * a3); } }
          u32x4* dst = (u32x4*)(wt + (size_t)(n0 + n) * DM + g * 128 + F.wave * 16);
          dst[0] = (u32x4){pk2(acc[0], acc[1]), pk2(acc[2], acc[3]), pk2(acc[4], acc[5]), pk2(acc[6], acc[7])};
          dst[1] = (u32x4){pk2(acc[8], acc[9]), pk2(acc[10], acc[11]), pk2(acc[12], acc[13]), pk2(acc[14], acc[15])};
          __syncthreads(); } }
    const int gw = F.blk * NWAVES + F.wave, NGW = F.G * NWAVES;
    constexpr int I_IN = 16 * 72, I_SQ = 16 * 32, I_OUT = 8 * 32, I_UP = 16 * 128, I_DN = 64 * 32;
    constexpr int NITEMS = I_IN + 2 * I_SQ + I_OUT + 2 * I_SQ + I_UP + I_DN;
    for (int it = gw; it < NITEMS; it += NGW) {
        int r = it;
        if (r < I_IN) { transpose_item(F.in[8], INC, INC, WSP(bf16, WS_WIN), DM, 0, F.in[7], scr, 64 * (r / 72), 32 * (r % 72), lane); continue; } r -= I_IN;
        if (r < I_SQ) { transpose_item(F.in[16], DM, DM, WSP(bf16, WS_WKV), DM, 0, F.in[15], scr, 64 * (r / 32), 32 * (r % 32), lane); continue; } r -= I_SQ;
        if (r < I_SQ) { transpose_item(F.in[17], DM, DM, WSP(bf16, WS_WKV), DM, DM, F.in[15], scr, 64 * (r / 32), 32 * (r % 32), lane); continue; } r -= I_SQ;
        if (r < I_OUT) { transpose_item(F.in[14], DM, DM, WSP(bf16, WS_WOUT), DM, 0, nullptr, scr, 512 + 64 * (r / 32), 32 * (r % 32), lane); continue; } r -= I_OUT;
        if (r < I_SQ) { transpose_item(F.in[19], DM, DM, WSP(bf16, WS_WQM), DM, 0, F.in[18], scr, 64 * (r / 32), 32 * (r % 32), lane); continue; } r -= I_SQ;
        if (r < I_SQ) { transpose_item(F.in[20], DM, DM, WSP(bf16, WS_WOM), DM, 0, nullptr, scr, 64 * (r / 32), 32 * (r % 32), lane); continue; } r -= I_SQ;
        if (r < I_UP) { transpose_item(F.in[22], FF, FF, WSP(bf16, WS_WUP), DM, 0, F.in[21], scr, 64 * (r / 128), 32 * (r % 128), lane); continue; } r -= I_UP;
        transpose_item(F.in[23], DM, DM, WSP(bf16, WS_WDN), FF, 0, nullptr, scr, 64 * (r / 32), 32 * (r % 32), lane);
    }
    for (int m = gw; m < MP; m += NGW) rms_row_to_bf16(F.in[0] + (size_t)m * DM, WSP(bf16, WS_H) + (size_t)m * DM, lane);
    for (int m = gw; m < NB * 256; m += NGW) rms_row_to_bf16(F.in[6] + (size_t)m * DM, WSP(bf16, WS_MN) + (size_t)m * DM, lane);
}

template <bool NORM, class Epi>
__device__ __forceinline__ void skinny_gemm(const Frame& F, const float* A, int lda, const bf16* Bt, int ldb, int K, int nslab, int ksplit, const Epi& E) {
    const int lane = pg8::pg8_lane_id(), tid = F.wave * 64 + lane; (void)tid;
    const int fr = lane & 15, fq = lane >> 4;
    for (int item = F.blk; item < nslab * ksplit; item += F.G) {
        const int slab = item % nslab, ks = item / nslab;
        const float* ap = A + (size_t)(F.wave * 16 + fr) * lda + (size_t)ks * K + fq * 8;
        const bf16* bp = Bt + (size_t)(slab * 16 + fr) * ldb + (size_t)ks * K + fq * 8;
        f32x4 acc = {0.f, 0.f, 0.f, 0.f}; float ss = 0.f;
#pragma unroll 8
        for (int k0 = 0; k0 < K; k0 += 32) {
            const f32x4 a0 = *(const f32x4*)(ap + k0), a1 = *(const f32x4*)(ap + k0 + 4);
            const bf16x8 b = *(const bf16x8*)(bp + k0);
            if (NORM) ss += ((a0[0] * a0[0] + a0[1] * a0[1]) + (a0[2] * a0[2] + a0[3] * a0[3])) + ((a1[0] * a1[0] + a1[1] * a1[1]) + (a1[2] * a1[2] + a1[3] * a1[3]));
            u32x4 aw; aw.x = pk2(a0[0], a0[1]); aw.y = pk2(a0[2], a0[3]); aw.z = pk2(a1[0], a1[1]); aw.w = pk2(a1[2], a1[3]);
            acc = mfma16(b, __builtin_bit_cast(bf16x8, aw), acc);
        }
        if (NORM) { ss += __shfl_xor(ss, 16); ss += __shfl_xor(ss, 32); acc = acc * rsqrtf(ss / (float)K + EPS); }
        E(F.wave * 16 + fr, slab * 16 + fq * 4, ks, acc);
    }
}
struct SEpiStore { float* O; int ldc; float scale; __device__ __forceinline__ void operator()(int row, int col, int, f32x4 v) const { *(f32x4*)(O + (size_t)row * ldc + col) = v * scale; } };
struct SEpiPart  { float* O; __device__ __forceinline__ void operator()(int row, int col, int ks, f32x4 v) const { *(f32x4*)(O + ((size_t)ks * MS + row) * DM + col) = v; } };
struct SEpiRes   { const float* base; float* O; __device__ __forceinline__ void operator()(int row, int col, int, f32x4 v) const { const f32x4 b = *(const f32x4*)(base + (size_t)row * DM + col); *(f32x4*)(O + (size_t)row * DM + col) = b + v; } };
struct SEpiRelu2 { float* O; __device__ __forceinline__ void operator()(int row, int col, int, f32x4 v) const { f32x4 o;
#pragma unroll
    for (int e = 0; e < 4; ++e) { const float a = fmaxf(v[e], 0.f); o[e] = a * a; } *(f32x4*)(O + (size_t)row * FF + col) = o; } };
__device__ __forceinline__ void p2_pool_prompt(const Frame& F) {
    const bf16* proj = WSP(const bf16, WS_PROJ); bf16* mixed = WSP(bf16, WS_H);
    const int lane = pg8::pg8_lane_id(), tid = F.wave * 64 + lane; (void)tid;
    const int c8 = (tid & 63) * 8, g = c8 >> 7, w = 2 << g;
    for (int it = F.blk; it < MP / 8; it += F.G) {
        const int row = it * 8 + F.wave, t = row & (SEQ - 1), b = row >> 11, cnt = (t + 1 < w) ? (t + 1) : w;
        const u32x4 u0 = *(const u32x4*)(proj + (size_t)row * INP + c8);
        float s[8]; s[0] = bflo(u0.x); s[1] = bfhi(u0.x); s[2] = bflo(u0.y); s[3] = bfhi(u0.y); s[4] = bflo(u0.z); s[5] = bfhi(u0.z); s[6] = bflo(u0.w); s[7] = bfhi(u0.w);
        float un[8];
#pragma unroll
        for (int e = 0; e < 8; ++e) un[e] = s[e];
        u32x4 uj[15];
#pragma unroll
        for (int j = 1; j < 16; ++j) { uj[j - 1] = (u32x4){0u, 0u, 0u, 0u}; if (j < cnt) uj[j - 1] = *(const u32x4*)(proj + (size_t)(row - j) * INP + c8); }
#pragma unroll
        for (int j = 0; j < 15; ++j) { s[0] += bflo(uj[j].x); s[1] += bfhi(uj[j].x); s[2] += bflo(uj[j].y); s[3] += bfhi(uj[j].y); s[4] += bflo(uj[j].z); s[5] += bfhi(uj[j].z); s[6] += bflo(uj[j].w); s[7] += bfhi(uj[j].w); }
        const float inv = 1.f / (float)cnt;
        u32x4 o; o.x = pk2(s[0] * inv - un[0], s[1] * inv - un[1]); o.y = pk2(s[2] * inv - un[2], s[3] * inv - un[3]); o.z = pk2(s[4] * inv - un[4], s[5] * inv - un[5]); o.w = pk2(s[6] * inv - un[6], s[7] * inv - un[7]);
        *(u32x4*)(mixed + (size_t)row * DM + c8) = o;
        if (t >= SEQ - 15) { float* sp = F.out + O_SPP + ((size_t)b * 15 + (t - (SEQ - 15))) * 512 + c8; *(f32x4*)sp = (f32x4){un[0], un[1], un[2], un[3]}; *(f32x4*)(sp + 4) = (f32x4){un[4], un[5], un[6], un[7]}; }
    }
}
__device__ __forceinline__ void p2_gla_local(const Frame& F) {
    const bf16* proj = WSP(const bf16, WS_PROJ); float* GL = WSP(float, WS_GL); float* CUM = WSP(float, WS_CUM);
    LAS float* fl = (LAS float*)(F.lds);
    LAS float* segt = (LAS float*)(F.lds + 4096);
    LAS bf16* Aop = (LAS bf16*)(F.lds + 8192);
    LAS bf16* Bop = (LAS bf16*)(F.lds + 8192 + 9216);
    const int lane = pg8::pg8_lane_id(), tid = F.wave * 64 + lane; const int wave = F.wave, fr = lane & 15, fq = lane >> 4;
    for (int unit = F.blk; unit < 1024; unit += F.G) {
        const int b = unit >> 7, n = (unit >> 2) & 31, h = unit & 3; const size_t r0 = (size_t)b * SEQ + n * 64;
        for (int e = tid; e < 1024; e += 512) fl[e] = bf2f(proj[(r0 + (e >> 4)) * INP + C_F + (e & 15)]);
        const int d = tid & 63, seg = tid >> 6;
        float wf[16];
#pragma unroll
        for (int r = 0; r < 16; ++r) wf[r] = F.in[9][r * 256 + h * 64 + d];
        const float bias = F.in[10][h * 64 + d];
        __syncthreads();
        float cum[8]; float run = 0.f;
#pragma unroll
        for (int i = 0; i < 8; ++i) { const int t = seg * 8 + i; float pre = bias;
#pragma unroll
            for (int r = 0; r < 16; ++r) pre += fl[t * 16 + r] * wf[r];
            run += logsig(pre) * (1.f / 16.f); cum[i] = run; }
        segt[seg * 64 + d] = run;
        __syncthreads();
        float pre_s = 0.f, tot = 0.f;
#pragma unroll
        for (int s2 = 0; s2 < 8; ++s2) { const float v = segt[s2 * 64 + d]; tot += v; if (s2 < seg) pre_s += v; }
        float ke[8];
#pragma unroll
        for (int i = 0; i < 8; ++i) { const int t = seg * 8 + i; cum[i] += pre_s; CUM[(size_t)unit * 4096 + t * 64 + d] = cum[i];
            ke[i] = bf2f(proj[(r0 + t) * INP + C_K + h * 64 + d]) * __expf(tot - cum[i]); }
        { u32x4 o; o.x = pk2(ke[0], ke[1]); o.y = pk2(ke[2], ke[3]); o.z = pk2(ke[4], ke[5]); o.w = pk2(ke[6], ke[7]); *(LAS u32x4*)(Aop + d * 72 + seg * 8) = o; }
        { const int dv = tid & 127, ts = tid >> 7; unsigned short vv[16];
#pragma unroll
          for (int i = 0; i < 16; ++i) vv[i] = proj[(r0 + ts * 16 + i) * INP + C_V + h * 128 + dv];
          u32x4 o0, o1; o0.x = vv[0] | ((unsigned)vv[1] << 16); o0.y = vv[2] | ((unsigned)vv[3] << 16); o0.z = vv[4] | ((unsigned)vv[5] << 16); o0.w = vv[6] | ((unsigned)vv[7] << 16);
          o1.x = vv[8] | ((unsigned)vv[9] << 16); o1.y = vv[10] | ((unsigned)vv[11] << 16); o1.z = vv[12] | ((unsigned)vv[13] << 16); o1.w = vv[14] | ((unsigned)vv[15] << 16);
          *(LAS u32x4*)(Bop + dv * 72 + ts * 16) = o0; *(LAS u32x4*)(Bop + dv * 72 + ts * 16 + 8) = o1; }
        __syncthreads();
        const int mi = wave & 3;
#pragma unroll
        for (int jj = 0; jj < 4; ++jj) { const int nj = (wave >> 2) * 4 + jj; f32x4 acc = {0.f, 0.f, 0.f, 0.f};
#pragma unroll
            for (int ks = 0; ks < 2; ++ks) { const bf16x8 a = *(const LAS bf16x8*)(Aop + (mi * 16 + fr) * 72 + ks * 32 + fq * 8); const bf16x8 bb = *(const LAS bf16x8*)(Bop + (nj * 16 + fr) * 72 + ks * 32 + fq * 8);
                acc = mfma16(bb, a, acc); }
            *(f32x4*)(GL + (size_t)unit * 8192 + (mi * 16 + fr) * 128 + nj * 16 + fq * 4) = acc; }
        __syncthreads();
    }
}
__device__ __forceinline__ void p3_gla_scan(const Frame& F) {
    const float* GL = WSP(const float, WS_GL); const float* CUM = WSP(const float, WS_CUM); bf16* ST = WSP(bf16, WS_ST);
    const int lane = pg8::pg8_lane_id(), tid = F.wave * 64 + lane; (void)tid;
    for (int e = F.blk * 512 + tid; e < 65536; e += F.G * 512) {
        const int dv = e & 127, dg = (e >> 7) & 15, bh = e >> 11, b = bh >> 2, h = bh & 3;
        float S[4] = {0.f, 0.f, 0.f, 0.f};
#pragma unroll 4
        for (int n = 0; n < 32; ++n) { const size_t unit = (size_t)(b * 32 + n) * 4 + h;
            const f32x4 cl = *(const f32x4*)(CUM + unit * 4096 + 63 * 64 + dg * 4);
            float Lv[4];
#pragma unroll
            for (int i = 0; i < 4; ++i) Lv[i] = GL[unit * 8192 + (dg * 4 + i) * 128 + dv];
            u32x2 o; o.x = pk2(S[0], S[1]); o.y = pk2(S[2], S[3]); *(u32x2*)(ST + unit * 8192 + dv * 64 + dg * 4) = o;
#pragma unroll
            for (int i = 0; i < 4; ++i) S[i] = __expf(cl[i]) * S[i] + Lv[i]; }
#pragma unroll
        for (int i = 0; i < 4; ++i) F.out[O_SGP + ((size_t)(b * 4 + h) * 64 + dg * 4 + i) * 128 + dv] = S[i];
    }
}
__device__ __forceinline__ void p4_gla_out(const Frame& F) {
    const bf16* proj = WSP(const bf16, WS_PROJ); const float* CUM = WSP(const float, WS_CUM); const bf16* ST = WSP(const bf16, WS_ST); bf16* mixed = WSP(bf16, WS_H);
    LAS bf16* Aq = (LAS bf16*)(F.lds);
    LAS bf16* Bk = (LAS bf16*)(F.lds + 9216);
    LAS bf16* Bv = (LAS bf16*)(F.lds + 18432);
    LAS bf16* Bs = (LAS bf16*)(F.lds + 36864);
    LAS bf16* Ap = (LAS bf16*)(F.lds + 55296);
    LAS float* red = (LAS float*)(F.lds + 64512);
    const int lane = pg8::pg8_lane_id(), tid = F.wave * 64 + lane; const int wave = F.wave, fr = lane & 15, fq = lane >> 4;
    for (int unit = F.blk; unit < 1024; unit += F.G) {
        const int b = unit >> 7, n = (unit >> 2) & 31, h = unit & 3; const size_t r0 = (size_t)b * SEQ + n * 64;
        { const int t = tid >> 3, d8 = (tid & 7) * 8;
          const f32x4 c0 = *(const f32x4*)(CUM + (size_t)unit * 4096 + t * 64 + d8), c1 = *(const f32x4*)(CUM + (size_t)unit * 4096 + t * 64 + d8 + 4);
          const u32x4 qw = *(const u32x4*)(proj + (r0 + t) * INP + C_Q + h * 64 + d8), kw = *(const u32x4*)(proj + (r0 + t) * INP + C_K + h * 64 + d8);
          float cu[8] = {c0[0], c0[1], c0[2], c0[3], c1[0], c1[1], c1[2], c1[3]};
          float qv[8] = {bflo(qw.x), bfhi(qw.x), bflo(qw.y), bfhi(qw.y), bflo(qw.z), bfhi(qw.z), bflo(qw.w), bfhi(qw.w)};
          float kv[8] = {bflo(kw.x), bfhi(kw.x), bflo(kw.y), bfhi(kw.y), bflo(kw.z), bfhi(kw.z), bflo(kw.w), bfhi(kw.w)};
#pragma unroll
          for (int e = 0; e < 8; ++e) { const float ex = __expf(cu[e]); qv[e] = qv[e] * 0.125f * ex; kv[e] = kv[e] / ex; }
          u32x4 o; o.x = pk2(qv[0], qv[1]); o.y = pk2(qv[2], qv[3]); o.z = pk2(qv[4], qv[5]); o.w = pk2(qv[6], qv[7]); *(LAS u32x4*)(Aq + t * 72 + d8) = o;
          o.x = pk2(kv[0], kv[1]); o.y = pk2(kv[2], kv[3]); o.z = pk2(kv[4], kv[5]); o.w = pk2(kv[6], kv[7]); *(LAS u32x4*)(Bk + t * 72 + d8) = o; }
        { const int dv = tid & 127, ts = tid >> 7; unsigned short vv[16];
#pragma unroll
          for (int i = 0; i < 16; ++i) vv[i] = proj[(r0 + ts * 16 + i) * INP + C_V + h * 128 + dv];
          u32x4 o0, o1; o0.x = vv[0] | ((unsigned)vv[1] << 16); o0.y = vv[2] | ((unsigned)vv[3] << 16); o0.z = vv[4] | ((unsigned)vv[5] << 16); o0.w = vv[6] | ((unsigned)vv[7] << 16);
          o1.x = vv[8] | ((unsigned)vv[9] << 16); o1.y = vv[10] | ((unsigned)vv[11] << 16); o1.z = vv[12] | ((unsigned)vv[13] << 16); o1.w = vv[14] | ((unsigned)vv[15] << 16);
          *(LAS u32x4*)(Bv + dv * 72 + ts * 16) = o0; *(LAS u32x4*)(Bv + dv * 72 + ts * 16 + 8) = o1; }
#pragma unroll
        for (int p = 0; p < 2; ++p) { const int pc = tid + p * 512, dv = pc >> 3, part = pc & 7;
            *(LAS u32x4*)(Bs + dv * 72 + part * 8) = *(const u32x4*)(ST + (size_t)unit * 8192 + dv * 64 + part * 8); }
        __syncthreads();
        const int mi = wave & 3;
#pragma unroll
        for (int jj = 0; jj < 2; ++jj) { const int nj = (wave >> 2) * 2 + jj; f32x4 acc = {0.f, 0.f, 0.f, 0.f};
#pragma unroll
            for (int ks = 0; ks < 2; ++ks) { const bf16x8 a = *(const LAS bf16x8*)(Aq + (mi * 16 + fr) * 72 + ks * 32 + fq * 8); const bf16x8 bb = *(const LAS bf16x8*)(Bk + (nj * 16 + fr) * 72 + ks * 32 + fq * 8);
                acc = mfma16(bb, a, acc); }
            const int i = mi * 16 + fr, j0 = nj * 16 + fq * 4;
#pragma unroll
            for (int r = 0; r < 4; ++r) if (j0 + r > i) acc[r] = 0.f;
            u32x2 o; o.x = pk2(acc[0], acc[1]); o.y = pk2(acc[2], acc[3]); *(LAS u32x2*)(Ap + i * 72 + j0) = o; }
        __syncthreads();
        f32x4 oacc[4]; float ssq = 0.f;
#pragma unroll
        for (int jj = 0; jj < 4; ++jj) { const int nj = (wave >> 2) * 4 + jj; f32x4 acc = {0.f, 0.f, 0.f, 0.f};
#pragma unroll
            for (int ks = 0; ks < 2; ++ks) {
                const bf16x8 ap = *(const LAS bf16x8*)(Ap + (mi * 16 + fr) * 72 + ks * 32 + fq * 8), bv = *(const LAS bf16x8*)(Bv + (nj * 16 + fr) * 72 + ks * 32 + fq * 8);
                acc = mfma16(bv, ap, acc);
                const bf16x8 aq = *(const LAS bf16x8*)(Aq + (mi * 16 + fr) * 72 + ks * 32 + fq * 8), bs = *(const LAS bf16x8*)(Bs + (nj * 16 + fr) * 72 + ks * 32 + fq * 8);
                acc = mfma16(bs, aq, acc); }
            oacc[jj] = acc; ssq += (acc[0] * acc[0] + acc[1] * acc[1]) + (acc[2] * acc[2] + acc[3] * acc[3]); }
        ssq += __shfl_xor(ssq, 16); ssq += __shfl_xor(ssq, 32);
        if (fq == 0) red[(wave >> 2) * 64 + mi * 16 + fr] = ssq;
        __syncthreads();
        const float rstd = rsqrtf((red[mi * 16 + fr] + red[64 + mi * 16 + fr]) * (1.f / 128.f) + EPS);
        const size_t row = r0 + mi * 16 + fr;
#pragma unroll
        for (int jj = 0; jj < 4; ++jj) { const int dv0 = ((wave >> 2) * 4 + jj) * 16 + fq * 4;
            const f32x4 gn = *(const f32x4*)(F.in[13] + h * 128 + dv0); const u32x2 gw = *(const u32x2*)(proj + row * INP + C_G + h * 128 + dv0);
            const float g0 = silu(bflo(gw.x)), g1 = silu(bfhi(gw.x)), g2 = silu(bflo(gw.y)), g3 = silu(bfhi(gw.y));
            u32x2 o; o.x = pk2(oacc[jj][0] * rstd * gn[0] * g0, oacc[jj][1] * rstd * gn[1] * g1); o.y = pk2(oacc[jj][2] * rstd * gn[2] * g2, oacc[jj][3] * rstd * gn[3] * g3);
            *(u32x2*)(mixed + row * DM + 512 + h * 128 + dv0) = o; }
        __syncthreads();
    }
}

__device__ __forceinline__ void s_mixers(const Frame& F) {
    const float* projs = WSP(const float, WS_PROJS); float* mixs = WSP(float, WS_MIXS);
    const float* spool = F.in[2]; const float* sgla = F.in[3];
    const int lane = pg8::pg8_lane_id(), tid = F.wave * 64 + lane; (void)tid;
    for (int e = F.blk * 512 + tid; e < MS * 512; e += F.G * 512) { const int b = e >> 9, c = e & 511, g = c >> 7, w = 2 << g;
        const float u = projs[(size_t)b * INC + c]; float s = u;
        for (int j = 1; j < w; ++j) s += spool[((size_t)b * 15 + 15 - j) * 512 + c];
        mixs[(size_t)b * DM + c] = s / (float)w - u;
        float* so = F.out + O_SPS + (size_t)b * 15 * 512 + c;
#pragma unroll
        for (int i = 0; i < 14; ++i) so[(size_t)i * 512] = spool[((size_t)b * 15 + i + 1) * 512 + c];
        so[(size_t)14 * 512] = u; }
    LAS float* dec = (LAS float*)(F.lds); LAS float* qs = dec + 64; LAS float* ks = dec + 128; LAS float* vs = dec + 192;
    LAS float* red = dec + 320;
    LAS float* red2 = red + 2048;
    for (int it = F.blk; it < MS * 4; it += F.G) { const int b = it >> 2, h = it & 3; const float* pr = projs + (size_t)b * INC;
        if (tid < 64) { float pre = F.in[10][h * 64 + tid];
#pragma unroll
            for (int r = 0; r < 16; ++r) pre += pr[C_F + r] * F.in[9][r * 256 + h * 64 + tid];
            dec[tid] = __expf(logsig(pre) * (1.f / 16.f)); qs[tid] = pr[C_Q + h * 64 + tid] * 0.125f; ks[tid] = pr[C_K + h * 64 + tid]; }
        else if (tid < 192) vs[tid - 64] = pr[C_V + h * 128 + (tid - 64)];
        __syncthreads();
        { const int v4 = (tid & 31) * 4, dgp = tid >> 5; const f32x4 vv = *(const LAS f32x4*)(vs + v4); f32x4 po = {0.f, 0.f, 0.f, 0.f};
#pragma unroll
          for (int i = 0; i < 4; ++i) { const int d = dgp * 4 + i; const size_t off = ((size_t)(b * 4 + h) * 64 + d) * 128 + v4;
              const f32x4 s0 = *(const f32x4*)(sgla + off); const f32x4 sn = s0 * dec[d] + vv * ks[d]; *(f32x4*)(F.out + O_SGS + off) = sn; po += sn * qs[d]; }
          *(LAS f32x4*)(red + dgp * 128 + v4) = po; }
        __syncthreads();
        float o = 0.f;
        if (tid < 128) {
#pragma unroll
            for (int g = 0; g < 16; ++g) o += red[g * 128 + tid];
            const float s2 = wave_sum(o * o); if (lane == 0) red2[tid >> 6] = s2; }
        __syncthreads();
        if (tid < 128) { const float rstd = rsqrtf((red2[0] + red2[1]) * (1.f / 128.f) + EPS);
            mixs[(size_t)b * DM + 512 + h * 128 + tid] = o * rstd * F.in[13][h * 128 + tid] * silu(pr[C_G + h * 128 + tid]); }
        __syncthreads();
    }
}
constexpr int KST = 264;
__device__ __forceinline__ void p7_attn_prompt(const Frame& F) {
    const bf16* Q = WSP(const bf16, WS_Q); const bf16* KB = WSP(const bf16, WS_KB); const bf16* VT = WSP(const bf16, WS_VT); bf16* CTX = WSP(bf16, WS_CTX);
    LAS bf16* L = (LAS bf16*)F.lds;
    const int lane = pg8::pg8_lane_id(), tid = F.wave * 64 + lane; const int wave = F.wave, fr = lane & 15, fq = lane >> 4;
    for (int unit = F.blk; unit < 256; unit += F.G) {
        const int b = unit >> 5, h = (unit >> 3) & 3, qt = unit & 7; const size_t row0 = (size_t)b * SEQ + qt * 256 + wave * 32;
        const bf16* kg = KB + (size_t)(b * 4 + h) * 65536; const bf16* vg = VT + (size_t)(b * 4 + h) * 65536;
        bf16x8 qf[2][8];
#pragma unroll
        for (int mi = 0; mi < 2; ++mi)
#pragma unroll
            for (int ks = 0; ks < 8; ++ks) qf[mi][ks] = *(const bf16x8*)(Q + (row0 + mi * 16 + fr) * DM + h * 256 + ks * 32 + fq * 8);
#pragma unroll 4
        for (int p = tid; p < 8192; p += 512) { const int key = p >> 5, piece = p & 31; *(LAS u32x4*)(L + key * KST + piece * 8) = *(const u32x4*)(kg + key * 256 + piece * 8); }
        __syncthreads();
        f32x4 sacc[2][16];
#pragma unroll
        for (int nj = 0; nj < 16; ++nj) { sacc[0][nj] = (f32x4){0.f, 0.f, 0.f, 0.f}; sacc[1][nj] = (f32x4){0.f, 0.f, 0.f, 0.f};
#pragma unroll
            for (int ks = 0; ks < 8; ++ks) { const bf16x8 kf = *(const LAS bf16x8*)(L + (nj * 16 + fr) * KST + ks * 32 + fq * 8);
                sacc[0][nj] = mfma16(kf, qf[0][ks], sacc[0][nj]); sacc[1][nj] = mfma16(kf, qf[1][ks], sacc[1][nj]); } }
        float inv[2]; bf16x8 pf[2][8];
#pragma unroll
        for (int mi = 0; mi < 2; ++mi) { float mx = -3.0e38f;
#pragma unroll
            for (int nj = 0; nj < 16; ++nj) mx = fmaxf(mx, fmaxf(fmaxf(sacc[mi][nj][0], sacc[mi][nj][1]), fmaxf(sacc[mi][nj][2], sacc[mi][nj][3])));
            mx = fmaxf(mx, __shfl_xor(mx, 16)); mx = fmaxf(mx, __shfl_xor(mx, 32));
            float sm = 0.f;
#pragma unroll
            for (int s = 0; s < 8; ++s) { float e[8];
#pragma unroll
                for (int r = 0; r < 4; ++r) { e[r] = __expf(sacc[mi][2 * s][r] - mx); e[4 + r] = __expf(sacc[mi][2 * s + 1][r] - mx); }
                sm += ((e[0] + e[1]) + (e[2] + e[3])) + ((e[4] + e[5]) + (e[6] + e[7]));
                u32x4 w; w.x = pk2(e[0], e[1]); w.y = pk2(e[2], e[3]); w.z = pk2(e[4], e[5]); w.w = pk2(e[6], e[7]); pf[mi][s] = __builtin_bit_cast(bf16x8, w); }
            sm += __shfl_xor(sm, 16); sm += __shfl_xor(sm, 32); inv[mi] = 1.f / sm; }
        __syncthreads();
#pragma unroll 4
        for (int p = tid; p < 8192; p += 512) { const int d = p >> 5, piece = p & 31; *(LAS u32x4*)(L + d * KST + piece * 8) = *(const u32x4*)(vg + d * 256 + piece * 8); }
        __syncthreads();
#pragma unroll
        for (int nj = 0; nj < 16; ++nj) { f32x4 o0 = {0.f, 0.f, 0.f, 0.f}, o1 = {0.f, 0.f, 0.f, 0.f};
#pragma unroll
            for (int s = 0; s < 8; ++s) { const LAS bf16* vp = L + (nj * 16 + fr) * KST + (2 * s) * 16 + fq * 4;
                const u32x2 lo = *(const LAS u32x2*)vp, hi = *(const LAS u32x2*)(vp + 16); u32x4 w; w.x = lo.x; w.y = lo.y; w.z = hi.x; w.w = hi.y; const bf16x8 vf = __builtin_bit_cast(bf16x8, w);
                o0 = mfma16(vf, pf[0][s], o0); o1 = mfma16(vf, pf[1][s], o1); }
            const int d0 = h * 256 + nj * 16 + fq * 4;
            u32x2 w0; w0.x = pk2(o0[0] * inv[0], o0[1] * inv[0]); w0.y = pk2(o0[2] * inv[0], o0[3] * inv[0]); *(u32x2*)(CTX + (row0 + fr) * DM + d0) = w0;
            u32x2 w1; w1.x = pk2(o1[0] * inv[1], o1[1] * inv[1]); w1.y = pk2(o1[2] * inv[1], o1[3] * inv[1]); *(u32x2*)(CTX + (row0 + 16 + fr) * DM + d0) = w1; }
        __syncthreads();
    }
}
__device__ __forceinline__ void s_attn(const Frame& F) {
    const float* qsb = WSP(const float, WS_QS); float* ctxs = WSP(float, WS_CTXS); const float* ck = F.in[4]; const float* cv = F.in[5];
    LAS float* part = (LAS float*)F.lds; LAS float* ml = part + 8 * 256;
    const int lane = pg8::pg8_lane_id(), tid = F.wave * 64 + lane; const int wave = F.wave;
    for (int it = F.blk; it < MS * 4; it += F.G) { const int b = it >> 2, h = it & 3;
        const f32x4 q4 = *(const f32x4*)(qsb + (size_t)b * DM + h * 256 + lane * 4);
        const float* kb = ck + ((size_t)b * 256 * 4 + h) * 256 + lane * 4 + (size_t)(wave * 32) * 1024;
        const float* vb = cv + ((size_t)b * 256 * 4 + h) * 256 + lane * 4 + (size_t)(wave * 32) * 1024;
        float mrun = -3.0e38f, l = 0.f; f32x4 acc = {0.f, 0.f, 0.f, 0.f};
#pragma unroll 1
        for (int i0 = 0; i0 < 32; i0 += 8) { f32x4 k4[8], v4[8]; float sc[8];
#pragma unroll
            for (int u = 0; u < 8; ++u) { k4[u] = *(const f32x4*)(kb + (size_t)(i0 + u) * 1024); v4[u] = *(const f32x4*)(vb + (size_t)(i0 + u) * 1024); }
            float mx = mrun;
#pragma unroll
            for (int u = 0; u < 8; ++u) { sc[u] = wave_sum((k4[u][0] * q4[0] + k4[u][1] * q4[1]) + (k4[u][2] * q4[2] + k4[u][3] * q4[3])); mx = fmaxf(mx, sc[u]); }
            const float rescale = __expf(mrun - mx); l *= rescale; acc = acc * rescale; mrun = mx;
#pragma unroll
            for (int u = 0; u < 8; ++u) { const float p = __expf(sc[u] - mx); l += p; acc += v4[u] * p; } }
        *(LAS f32x4*)(part + wave * 256 + lane * 4) = acc; if (lane == 0) { ml[wave * 2] = mrun; ml[wave * 2 + 1] = l; }
        __syncthreads();
        if (tid < 256) { float M = -3.0e38f;
#pragma unroll
            for (int w = 0; w < 8; ++w) M = fmaxf(M, ml[w * 2]);
            float o = 0.f, L = 0.f;
#pragma unroll
            for (int w = 0; w < 8; ++w) { const float e = __expf(ml[w * 2] - M); L += e * ml[w * 2 + 1]; o += e * part[w * 256 + tid]; }
            ctxs[(size_t)b * DM + h * 256 + tid] = o / L; }
        __syncthreads();
    }
}
__device__ __forceinline__ void final_norm_prompt(const Frame& F) {
    const int lane = pg8::pg8_lane_id(), tid = F.wave * 64 + lane; (void)tid;
    const int gw = F.blk * NWAVES + F.wave, NGW = F.G * NWAVES; const f32x4* g4 = (const f32x4*)F.in[24] + lane;
    for (int m = gw; m < MP; m += NGW) { f32x4* xr = (f32x4*)(F.out + O_YP + (size_t)m * DM) + lane; f32x4 v[4]; float s = 0.f;
#pragma unroll
        for (int j = 0; j < 4; ++j) { v[j] = xr[64 * j]; s += (v[j].x * v[j].x + v[j].y * v[j].y) + (v[j].z * v[j].z + v[j].w * v[j].w); }
        const float rstd = rsqrtf(wave_sum(s) * (1.f / DM) + EPS);
#pragma unroll
        for (int j = 0; j < 4; ++j) xr[64 * j] = v[j] * rstd * g4[64 * j]; }
}
__device__ __forceinline__ void final_norm_sample(const Frame& F) {
    const int lane = pg8::pg8_lane_id(), tid = F.wave * 64 + lane; (void)tid;
    const int gw = F.blk * NWAVES + F.wave, NGW = F.G * NWAVES; const f32x4* g4 = (const f32x4*)F.in[24] + lane; const float* parts = WSP(const float, WS_PARTS);
    for (int m = gw; m < MS; m += NGW) { f32x4* xr = (f32x4*)(F.out + O_YS + (size_t)m * DM) + lane; f32x4 v[4]; float s = 0.f;
#pragma unroll
        for (int j = 0; j < 4; ++j) { v[j] = xr[64 * j];
#pragma unroll
            for (int ks = 0; ks < 4; ++ks) v[j] += ((const f32x4*)(parts + ((size_t)ks * MS + m) * DM) + lane)[64 * j];
            s += (v[j].x * v[j].x + v[j].y * v[j].y) + (v[j].z * v[j].z + v[j].w * v[j].w); }
        const float rstd = rsqrtf(wave_sum(s) * (1.f / DM) + EPS);
#pragma unroll
        for (int j = 0; j < 4; ++j) xr[64 * j] = v[j] * rstd * g4[64 * j]; }
}
#define RLX_AGENT __ATOMIC_RELAXED, __HIP_MEMORY_SCOPE_AGENT
#define XB_TMO      128
#define XB_XCNT(j)  (256  + 64 * (j))
#define XB_XSUB(j)  (1280 + 64 * (j))
#define XB_XGEN(j)  (2304 + 64 * (j))
#define XB_TOP      3328
#define XB_TOPGEN   3392
#define XCD_BAR_WORDS 3456
#define XB_SPIN_CAP (1u << 18)

__device__ __forceinline__ unsigned xb_ld(unsigned* p)              { return __hip_atomic_load(p, __ATOMIC_RELAXED, __HIP_MEMORY_SCOPE_AGENT); }
__device__ __forceinline__ unsigned xb_add(unsigned* p, unsigned v) { return __hip_atomic_fetch_add(p, v, __ATOMIC_RELAXED, __HIP_MEMORY_SCOPE_AGENT); }
__device__ __forceinline__ unsigned xb_xcc_id() { return (unsigned)__builtin_amdgcn_s_getreg((3 << 11) | 20) & 0xFu; }
#define XB_SPIN(cond, bar) do { unsigned _sp = 0; while (cond) { __builtin_amdgcn_s_sleep(1); \
    if ((++_sp & 255u) == 0u) { if (xb_ld(&(bar)[XB_TMO])) break; if (_sp > XB_SPIN_CAP) { atomicAdd(&(bar)[XB_TMO], 1u); break; } } } } while (0)

struct XcdBarrier {
    unsigned* bar; unsigned x;
    volatile LAS unsigned* st;
};

__device__ __forceinline__ XcdBarrier xcd_barrier_post(unsigned* bar, volatile LAS unsigned* st, bool t0) {
    XcdBarrier b; b.bar = bar; b.x = xb_xcc_id(); b.st = st;
    if (t0) (void)xb_add(&bar[XB_XCNT(b.x)], 1u);
    return b;
}
__device__ __forceinline__ void xcd_barrier_complete(unsigned* bar, unsigned x, unsigned& nloc, unsigned& nx) {
    const unsigned G = gridDim.x * gridDim.y * gridDim.z;
    unsigned sum, cnt, mine, sp = 0u;
    for (;;) {
        sum = 0u; cnt = 0u; mine = 0u;
#pragma unroll
        for (unsigned j = 0; j < 16; ++j) { const unsigned c = xb_ld(&bar[XB_XCNT(j)]); sum += c; cnt += (c > 0u) ? 1u : 0u; mine = (j == x) ? c : mine; }
        if (sum == G) break;
        __builtin_amdgcn_s_sleep(1);
        if ((++sp & 255u) == 0u) { if (xb_ld(&bar[XB_TMO])) break; if (sp > XB_SPIN_CAP) { atomicAdd(&bar[XB_TMO], 1u); break; } }
    }
    nloc = mine > 0u ? mine : 1u; nx = cnt > 0u ? cnt : 1u;
}

__device__ __forceinline__ void xcd_barrier(const XcdBarrier& b, int wave) {
    asm volatile("s_waitcnt vmcnt(0)" ::: "memory");
    __syncthreads();
    if (wave == 0 && pg8::pg8_lane_id() == 0) {
        unsigned* bar = b.bar;
        __builtin_amdgcn_s_waitcnt(0);
        unsigned nloc = b.st[0], nx = b.st[1];
        if (nloc == 0u) { xcd_barrier_complete(bar, b.x, nloc, nx); b.st[0] = nloc; b.st[1] = nx; }
        const unsigned old = xb_add(&bar[XB_XSUB(b.x)], 1u);
        const unsigned gen = old / nloc;
        if (old + 1u == (gen + 1u) * nloc) {
            __builtin_amdgcn_fence(__ATOMIC_RELEASE, "agent");
            asm volatile("s_waitcnt vmcnt(0)" ::: "memory");
            const unsigned og = xb_add(&bar[XB_TOP], 1u);
            const unsigned tg = og / nx;
            if (og + 1u == (tg + 1u) * nx) xb_add(&bar[XB_TOPGEN], 1u);
            else XB_SPIN(xb_ld(&bar[XB_TOPGEN]) == tg, bar);
            __builtin_amdgcn_fence(__ATOMIC_ACQUIRE, "agent");
            xb_add(&bar[XB_XGEN(b.x)], 1u);
            asm volatile("s_waitcnt vmcnt(0)" ::: "memory");
        } else {
            XB_SPIN(xb_ld(&bar[XB_XGEN(b.x)]) == gen, bar);
            __builtin_amdgcn_fence(__ATOMIC_ACQUIRE, "agent");
            asm volatile("s_waitcnt vmcnt(0)" ::: "memory");
        }
    }
    __syncthreads();
}
#ifndef MK_N_LAUNCHES
#define MK_N_LAUNCHES 1
#endif
constexpr int N_PHASES = 12;
#ifndef REPX
#define REPX 0
#endif
#define RX(bit) for (int rx_ = 0; rx_ < 1 + ((REPX >> (bit)) & 1); ++rx_)
struct Args { const float* in[25]; float* out; unsigned char* ws; int ph_lo, ph_hi; };
struct RotOrder {
    pg8::StaticOrder S;
    __device__ void init(int M, int N, int G, int c, int rot) { S.init(M, N, G, (c + G - (rot % G)) % G); }
    __device__ bool next(int i, pg8::Unit& u) const { return S.next(i, u); }
    __device__ __forceinline__ void a_ready(const pg8::Unit&) const {}
    __device__ __forceinline__ void done(const pg8::Unit&) const {}
};
__global__ void __launch_bounds__(NWAVES * 64, 2) mk_fwd(Args args) {
    extern __shared__ __attribute__((aligned(16))) unsigned char lds_raw[];
    Frame F;
    F.lds = (LAS unsigned char*)lds_raw;
    F.wave = __builtin_amdgcn_readfirstlane((int)threadIdx.x >> 6);
    F.G = gridDim.x; F.blk = blockIdx.x;
#pragma unroll
    for (int i = 0; i < 25; ++i) F.in[i] = args.in[i];
    F.out = args.out; F.ws = args.ws;
    const int lo = args.ph_lo, hi = args.ph_hi;
#define IN(k) (lo <= (k) && (k) < hi)
    volatile LAS unsigned* bst = (volatile LAS unsigned*)(F.lds + 143360);
    { const int l0 = pg8::pg8_lane_id(); if (F.wave == 0 && l0 < 2) bst[l0] = 0u; }
    __syncthreads();
    XcdBarrier bar = xcd_barrier_post((unsigned*)args.ws, bst, F.wave == 0 && pg8::pg8_lane_id() == 0);
    if (lo < 0) cg::this_grid().sync();
#define GRID_BAR() xcd_barrier(bar, F.wave)
#define SEAM(k) do { if (IN(k) && IN((k) + 1)) GRID_BAR(); } while (0)
    typedef pg8::bf16_t pb;
    if (IN(0)) { constexpr int rep = 0; (void)rep; p0_prologue(F); __syncthreads(); }
    SEAM(0);
    if (IN(1)) { constexpr int rep = 0; (void)rep;
        RX(10) { SEpiStore E{WSP(float, WS_PROJS), INC, 1.f}; skinny_gemm<true>(F, F.in[1], DM, WSP(const bf16, WS_WIN), DM, DM, INC / 16, 1, E); }
        { pg8::Gemm g{WSP(const pb, WS_H), WSP(const pb, WS_WIN), MP, INP, DM}; pg8::StaticOrder S; S.init(MP, INP, F.G, F.blk);
          pg8::EpiPlainBf16 E{WSP(pb, WS_PROJ), INP}; pg8::gemm_phase<pg8::EpiPlainBf16, pg8::StaticOrder, true, true>(F.lds, F.wave, g, S, E); }
        { pg8::Gemm g{WSP(const pb, WS_MN), WSP(const pb, WS_WKV), NB * 256, 2048, DM}; RotOrder S; S.init(NB * 256, 2048, F.G, F.blk, 64);
          pg8::EpiKV E{F.out + O_KP, F.out + O_VP, WSP(pb, WS_KB), WSP(pb, WS_VT)}; pg8::gemm_phase<pg8::EpiKV, RotOrder, true, true>(F.lds, F.wave, g, S, E); }
    }
    SEAM(1);
    if (IN(2)) { constexpr int rep = 0; (void)rep; RX(7) s_mixers(F); RX(6) p2_pool_prompt(F); RX(5) p2_gla_local(F); }
    SEAM(2);
    if (IN(3)) { constexpr int rep = 0; (void)rep;
        { SEpiRes E{F.in[1], F.out + O_YS}; skinny_gemm<false>(F, WSP(const float, WS_MIXS), DM, WSP(const bf16, WS_WOUT), DM, DM, DM / 16, 1, E); }
        RX(2) p3_gla_scan(F);
    }
    SEAM(3);
    if (IN(4)) { constexpr int rep = 0; (void)rep;
        RX(4) { SEpiStore E{WSP(float, WS_QS), DM, 0.0625f}; skinny_gemm<true>(F, F.out + O_YS, DM, WSP(const bf16, WS_WQM), DM, DM, DM / 16, 1, E); }
        RX(3) p4_gla_out(F);
    }
    SEAM(4);
    if (IN(5)) { constexpr int rep = 0; (void)rep;
        RX(9) s_attn(F);
        { pg8::Gemm g{WSP(const pb, WS_H), WSP(const pb, WS_WOUT), MP, DM, DM}; pg8::StaticOrder S; S.init(MP, DM, F.G, F.blk);
          pg8::EpiRes<true, true> E{F.in[0], F.out + O_YP, WSP(pb, WS_XB), WSP(float, WS_SSQ1)}; pg8::gemm_phase<pg8::EpiRes<true, true>, pg8::StaticOrder, true, true>(F.lds, F.wave, g, S, E); }
    }
    SEAM(5);
    if (IN(6)) { constexpr int rep = 0; (void)rep;
        if (rep == 0) { SEpiRes E{F.out + O_YS, F.out + O_YS}; skinny_gemm<false>(F, WSP(const float, WS_CTXS), DM, WSP(const bf16, WS_WOM), DM, DM, DM / 16, 1, E); }
        { pg8::Gemm g{WSP(const pb, WS_XB), WSP(const pb, WS_WQM), MP, DM, DM}; pg8::StaticOrder S; S.init(MP, DM, F.G, F.blk);
          pg8::EpiScale<0> E{WSP(pb, WS_Q), DM, WSP(const float, WS_SSQ1), 0.0625f}; pg8::gemm_phase<pg8::EpiScale<0>, pg8::StaticOrder, true, true>(F.lds, F.wave, g, S, E); }
    }
    SEAM(6);
    if (IN(7)) { constexpr int rep = 0; (void)rep;
        RX(0) { SEpiRelu2 E{WSP(float, WS_HFFS)}; skinny_gemm<true>(F, F.out + O_YS, DM, WSP(const bf16, WS_WUP), DM, DM, FF / 16, 1, E); }
        __syncthreads();
        RX(1) p7_attn_prompt(F);
    }
    SEAM(7);
    if (IN(8)) { constexpr int rep = 0; (void)rep;
        { SEpiPart E{WSP(float, WS_PARTS)}; skinny_gemm<false>(F, WSP(const float, WS_HFFS), FF, WSP(const bf16, WS_WDN), FF, DM, DM / 16, 4, E); }
        { pg8::Gemm g{WSP(const pb, WS_CTX), WSP(const pb, WS_WOM), MP, DM, DM}; pg8::StaticOrder S; S.init(MP, DM, F.G, F.blk);
          pg8::EpiRes<true, true> E{F.out + O_YP, F.out + O_YP, WSP(pb, WS_XB), WSP(float, WS_SSQ2)}; pg8::gemm_phase<pg8::EpiRes<true, true>, pg8::StaticOrder, true, true>(F.lds, F.wave, g, S, E); }
    }
    SEAM(8);
    if (IN(9)) { constexpr int rep = 0; (void)rep;
        if (rep == 0) final_norm_sample(F);
        { pg8::Gemm g{WSP(const pb, WS_XB), WSP(const pb, WS_WUP), MP, FF, DM}; pg8::StaticOrder S; S.init(MP, FF, F.G, F.blk);
          pg8::EpiScale<1> E{WSP(pb, WS_HFF), FF, WSP(const float, WS_SSQ2), 1.f}; pg8::gemm_phase<pg8::EpiScale<1>, pg8::StaticOrder, true, true>(F.lds, F.wave, g, S, E); }
    }
    SEAM(9);
    if (IN(10)) { constexpr int rep = 0; (void)rep;
        pg8::Gemm g{WSP(const pb, WS_HFF), WSP(const pb, WS_WDN), MP, DM, FF}; pg8::StaticOrder S; S.init(MP, DM, F.G, F.blk);
        pg8::EpiRes<false, false> E{F.out + O_YP, F.out + O_YP, nullptr, nullptr}; pg8::gemm_phase<pg8::EpiRes<false, false>, pg8::StaticOrder, true, true>(F.lds, F.wave, g, S, E);
    }
    SEAM(10);
    if (IN(11)) final_norm_prompt(F);
    if ((REPX >> 8) & 1) { for (int q = 0; q < 4; ++q) { GRID_BAR(); } }
#undef IN
#undef SEAM
}

extern "C" void kernel_launch(void* const* d_in, const int* in_sizes, int n_in, void* d_out, int out_size, void* d_ws, size_t ws_size, hipStream_t stream) {
    static int grid = 0;
    if (grid == 0) {
        if (n_in != 25 || ws_size < WS_END) { fprintf(stderr, "kernel_launch: unexpected inputs (n_in %d, ws %zu)\n", n_in, ws_size); grid = -1; return; }
        int dev = 0, cus = 0, per_cu = 0;
        hipGetDevice(&dev); hipDeviceGetAttribute(&cus, hipDeviceAttributeMultiprocessorCount, dev);
        if (hipFuncSetAttribute((const void*)mk_fwd, hipFuncAttributeMaxDynamicSharedMemorySize, LDS_BYTES) != hipSuccess) { fprintf(stderr, "kernel_launch: hipFuncSetAttribute failed\n"); grid = -1; return; }
        if (hipOccupancyMaxActiveBlocksPerMultiprocessor(&per_cu, (const void*)mk_fwd, NWAVES * 64, LDS_BYTES) != hipSuccess || per_cu < 1) { fprintf(stderr, "kernel_launch: occupancy query says %d\n", per_cu); per_cu = 1; }
        (void)hipGetLastError();
        grid = cus * 1;
        fprintf(stderr, "kernel_launch: grid %d (cus %d, per_cu %d)\n", grid, cus, per_cu);
    }
    if (grid < 0) return;
    if (hipMemsetAsync(d_ws, 0, 16384, stream) != hipSuccess) { fprintf(stderr, "kernel_launch: memset failed\n"); return; }
    Args a{};
    for (int i = 0; i < 25; ++i) a.in[i] = (const float*)d_in[i];
    a.out = (float*)d_out; a.ws = (unsigned char*)d_ws;
#if MK_N_LAUNCHES == 1
    a.ph_lo = 0; a.ph_hi = N_PHASES;
    void* kargs[] = {&a};
    hipError_t e = hipLaunchCooperativeKernel((const void*)mk_fwd, dim3(grid), dim3(NWAVES * 64), kargs, LDS_BYTES, stream);
    if (e != hipSuccess) fprintf(stderr, "cooperative launch failed: %s (grid %d)\n", hipGetErrorString(e), grid);
#else
    for (int p = 0; p < N_PHASES; ++p) { a.ph_lo = p; a.ph_hi = p + 1; hipLaunchKernelGGL(mk_fwd, dim3(grid), dim3(NWAVES * 64), LDS_BYTES, stream, a); }
#endif
}
```

```cpp
#include <hip/hip_runtime.h>
#include <hip/hip_cooperative_groups.h>
#include <cstdio>
#include <cstdint>
namespace cg = cooperative_groups;
namespace pg8 {
#define PG8_LAS __attribute__((address_space(3)))
typedef unsigned short bf16_t;
typedef short bf16x8 __attribute__((ext_vector_type(8)));
typedef float f32x4 __attribute__((ext_vector_type(4)));
typedef unsigned u32x4 __attribute__((ext_vector_type(4)));
constexpr int BM = 256, BK = 64, HALF = 128, HTB = HALF * BK * 2  , STAGE_BYTES = 8 * HTB, NXCD = 8, WGM = 8;

__host__ __device__ __forceinline__ int lds_byte(int r, int c) { const int st = (r >> 4) * 2 + (c >> 5), rr = r & 15, cc = c & 31, ob = rr * 64 + cc * 2; return st * 1024 + (ob ^ (((ob >> 9) & 1) << 5)); }
__host__ __device__ __forceinline__ void stage_rc(int b, int& R, int& C) { const int st = b / 1024, sb = b % 1024, swz = sb ^ (((sb >> 9) & 1) << 5); R = (st >> 1) * 16 + swz / 64; C = (st & 1) * 32 + (swz % 64) / 2; }
__host__ __device__ __forceinline__ int perm32(int rho) { const int n = rho >> 4, i = rho & 15; return 8 * (i >> 2) + 4 * n + (i & 3); }

struct Unit { int pm, pn; };
struct Gemm { const bf16_t* A; const bf16_t* Bt; int M, N, K; };

struct StaticOrder {
    int nM, nN, nwg, G, c;
    __host__ __device__ void init(int M, int N, int G_, int c_) { nM = M / BM; nN = N / BM; nwg = nM * nN; G = G_; c = c_; }
    __host__ __device__ bool next(int i, Unit& u) const {
        const long L = (long)i * G + c; if (L >= nwg) return false;
        int wgid = (int)L; { const int q = nwg / NXCD, r = nwg % NXCD, xcd = wgid % NXCD, off = wgid / NXCD; wgid = (xcd < r ? xcd * (q + 1) : r * (q + 1) + (xcd - r) * q) + off; }
        const int nig = WGM * nN, gid = wgid / nig, fm = gid * WGM, gsz = (nM - fm) < WGM ? (nM - fm) : WGM;
        u.pm = fm + ((wgid % nig) % gsz); u.pn = (wgid % nig) / gsz; return true;
    }
    __device__ __forceinline__ void a_ready(const Unit&) const {}
    __device__ __forceinline__ void done(const Unit&) const {}
};

typedef float f32x2 __attribute__((ext_vector_type(2)));
typedef __bf16 bf16x2_t __attribute__((ext_vector_type(2)));
__device__ __forceinline__ unsigned cvt_pk_bf16(float lo, float hi) { const f32x2 v = {lo, hi}; return __builtin_bit_cast(unsigned, __builtin_convertvector(v, bf16x2_t)); }
__device__ __forceinline__ int pg8_lane_id() { int l; asm volatile("v_mbcnt_lo_u32_b32 %0, -1, 0\n\tv_mbcnt_hi_u32_b32 %0, -1, %0" : "=v"(l)); return l; }
typedef unsigned u32x2 __attribute__((ext_vector_type(2)));
struct EpiPlainBf16 {
    static constexpr bool PERM = true, AFTER_DRAIN = false;
    bf16_t* O; int ldc;
    __device__ __forceinline__ void operator()(const f32x4 (&acc)[2][2][4][2], const Unit& u, int wr, int wc, int fr, int fq) const {
        asm volatile("" : "+v"(fr), "+v"(fq));
        const int row0 = u.pm * BM + wr * 64 + fr, col0 = u.pn * BM + wc * 32 + 8 * fq;
#pragma unroll
        for (int ai = 0; ai < 2; ++ai)
#pragma unroll
            for (int m = 0; m < 4; ++m) { bf16_t* rowp = O + (size_t)(row0 + ai * HALF + m * 16) * ldc + col0;
#pragma unroll
                for (int bj = 0; bj < 2; ++bj) { const f32x4 v0 = acc[ai][bj][m][0], v1 = acc[ai][bj][m][1];
                    u32x4 w; w.x = cvt_pk_bf16(v0[0], v0[1]); w.y = cvt_pk_bf16(v0[2], v0[3]); w.z = cvt_pk_bf16(v1[0], v1[1]); w.w = cvt_pk_bf16(v1[2], v1[3]);
                    *(u32x4*)(rowp + bj * HALF) = w; } }
    }
};
struct EpiKV {
    static constexpr bool PERM = true, AFTER_DRAIN = false;
    float* outK; float* outV; bf16_t* KB; bf16_t* VT; const float* ssq;
    __device__ __forceinline__ void operator()(const f32x4 (&acc)[2][2][4][2], const Unit& u, int wr, int wc, int fr, int fq) const {
        asm volatile("" : "+v"(fr), "+v"(fq));
        const bool isV = u.pn >= 4; const int h = u.pn & 3, b = u.pm;
        float* of = isV ? outV : outK;
        const int ct0 = wc * 32 + 8 * fq;
#pragma unroll
        for (int ai = 0; ai < 2; ++ai)
#pragma unroll
            for (int m = 0; m < 4; ++m) { const int key = ai * HALF + wr * 64 + m * 16 + fr; const float rs = rsqrtf(ssq[b * 256 + key] * (1.0f / 1024.0f) + 1e-6f);
#pragma unroll
                for (int bj = 0; bj < 2; ++bj) { const f32x4 v0 = acc[ai][bj][m][0] * rs, v1 = acc[ai][bj][m][1] * rs; const int ct = ct0 + bj * HALF;
                    float* fp = of + (size_t)(b * 256 + key) * 1024 + h * 256 + ct;
                    *(f32x4*)fp = v0; *(f32x4*)(fp + 4) = v1;
                    if (!isV) { u32x4 w; w.x = cvt_pk_bf16(v0[0], v0[1]); w.y = cvt_pk_bf16(v0[2], v0[3]); w.z = cvt_pk_bf16(v1[0], v1[1]); w.w = cvt_pk_bf16(v1[2], v1[3]);
                        *(u32x4*)(KB + ((size_t)(b * 4 + h) * 256 + key) * 256 + ct) = w; }
                    else { const int kp = (key & ~31) | (((key >> 2) & 3) << 3) | (((key >> 4) & 1) << 2) | (key & 3);
                        bf16_t* vp = VT + ((size_t)(b * 4 + h) * 256 + ct) * 256 + kp;
#pragma unroll
                        for (int e = 0; e < 4; ++e) { vp[(size_t)e * 256] = (bf16_t)(cvt_pk_bf16(v0[e], 0.f) & 0xffffu); vp[(size_t)(e + 4) * 256] = (bf16_t)(cvt_pk_bf16(v1[e], 0.f) & 0xffffu); } }
                } }
    }
};
template <bool XB, bool SSQ> struct EpiRes {
    static constexpr bool PERM = false, AFTER_DRAIN = false;
    const float* base; float* out; bf16_t* xb; float* ssq;
    __device__ __forceinline__ void operator()(const f32x4 (&acc)[2][2][4][2], const Unit& u, int wr, int wc, int fr, int fq) const {
        asm volatile("" : "+v"(fr), "+v"(fq));
        const int col0 = u.pn * BM + wc * 32 + 4 * fq;
#pragma unroll
        for (int ai = 0; ai < 2; ++ai)
#pragma unroll
            for (int m = 0; m < 4; ++m) { const int r = u.pm * BM + ai * HALF + wr * 64 + m * 16 + fr; const size_t off = (size_t)r * 1024 + col0; float s = 0.f;
#pragma unroll
                for (int bj = 0; bj < 2; ++bj)
#pragma unroll
                    for (int n = 0; n < 2; ++n) { const f32x4 bs = *(const f32x4*)(base + off + bj * HALF + n * 16); const f32x4 o = bs + acc[ai][bj][m][n];
                        *(f32x4*)(out + off + bj * HALF + n * 16) = o;
                        if (SSQ) s += (o[0] * o[0] + o[1] * o[1]) + (o[2] * o[2] + o[3] * o[3]);
                        if (XB) { u32x2 w; w.x = cvt_pk_bf16(o[0], o[1]); w.y = cvt_pk_bf16(o[2], o[3]); *(u32x2*)(xb + off + bj * HALF + n * 16) = w; } }
                if (SSQ) { s += __shfl_xor(s, 16); s += __shfl_xor(s, 32); if (fq == 0) ssq[(size_t)r * 16 + u.pn * 4 + wc] = s; }
            }
    }
};
template <int MODE, int NPART = 16> struct EpiScale {
    static constexpr bool PERM = true, AFTER_DRAIN = false;
    bf16_t* O; int ldc; const float* ssq; float scale;
    __device__ __forceinline__ void operator()(const f32x4 (&acc)[2][2][4][2], const Unit& u, int wr, int wc, int fr, int fq) const {
        asm volatile("" : "+v"(fr), "+v"(fq));
        const int row0 = u.pm * BM + wr * 64 + fr, col0 = u.pn * BM + wc * 32 + 8 * fq;
#pragma unroll
        for (int ai = 0; ai < 2; ++ai)
#pragma unroll
            for (int m = 0; m < 4; ++m) { const int r = row0 + ai * HALF + m * 16; bf16_t* rowp = O + (size_t)r * ldc + col0;
                float tot;
                if (NPART == 16) { const f32x4* sp = (const f32x4*)(ssq + (size_t)r * 16); const f32x4 s0 = sp[0], s1 = sp[1], s2 = sp[2], s3 = sp[3];
                    tot = ((s0[0] + s0[1]) + (s0[2] + s0[3])) + ((s1[0] + s1[1]) + (s1[2] + s1[3])) + ((s2[0] + s2[1]) + (s2[2] + s2[3])) + ((s3[0] + s3[1]) + (s3[2] + s3[3])); }
                else tot = ssq[r];
                const float rs = rsqrtf(tot * (1.0f / 1024.0f) + 1e-6f) * (MODE == 0 ? scale : 1.0f);
#pragma unroll
                for (int bj = 0; bj < 2; ++bj) { f32x4 v0 = acc[ai][bj][m][0] * rs, v1 = acc[ai][bj][m][1] * rs;
                    if (MODE == 1) {
#pragma unroll
                        for (int e = 0; e < 4; ++e) { const float a0 = fmaxf(v0[e], 0.f), a1 = fmaxf(v1[e], 0.f); v0[e] = a0 * a0; v1[e] = a1 * a1; } }
                    u32x4 w; w.x = cvt_pk_bf16(v0[0], v0[1]); w.y = cvt_pk_bf16(v0[2], v0[3]); w.z = cvt_pk_bf16(v1[0], v1[1]); w.w = cvt_pk_bf16(v1[2], v1[3]);
                    *(u32x4*)(rowp + bj * HALF) = w; } }
    }
};

template <class Epi, class Sched, bool ALIGN_EPI = false, bool SP2 = false>
__device__ __forceinline__ void gemm_phase(PG8_LAS unsigned char* lds, const int wave_in, const Gemm g, const Sched& S, const Epi& E) {
    const int wid = wave_in, lane = pg8_lane_id(), tid = wid * 64 + lane, wr = wid >> 2, wc = wid & 3, fr = lane & 15, fq = lane >> 4;
    const int K = g.K, nt = K / BK;
    unsigned voffA[2], voffB[2];
#pragma unroll
    for (int i = 0; i < 2; ++i) { int R, C; stage_rc(tid * 16 + i * 8192, R, C); const int Rb = Epi::PERM ? ((R & ~31) + perm32(R & 31)) : R;
        voffA[i] = (unsigned)(R * K + C) * 2u; voffB[i] = (unsigned)(Rb * K + C) * 2u; }
    const size_t kstep = (size_t)(BK * 2);
    const size_t hstep = (size_t)HALF * K * 2;
    const size_t tstep = 2 * hstep;
    const unsigned ldsw = (unsigned)wid * 1024u;
    const int aoff = lds_byte(wr * 64 + fr, fq * 8), boff = lds_byte(wc * 32 + fr, fq * 8);
#define PG8_SA(b, h) (((b) * 2 + (h)) * HTB)
#define PG8_SB(b, h) ((4 + (b) * 2 + (h)) * HTB)
#define PG8_STAGE(bufoff, gbase, voff) do { _Pragma("unroll") for (int _i = 0; _i < 2; ++_i) \
        __builtin_amdgcn_global_load_lds((const unsigned*)((const char*)(gbase) + (voff)[_i]), (PG8_LAS unsigned*)(lds + (bufoff) + ldsw + _i * 8192), 16, 0, 0); } while (0)
#define PG8_LDA(dst, b, h) do { _Pragma("unroll") for (int m = 0; m < 4; ++m) _Pragma("unroll") for (int k = 0; k < 2; ++k) dst[m][k] = *(const PG8_LAS bf16x8*)(lds + PG8_SA(b, h) + aoff + m * 2048 + k * 1024); } while (0)
#define PG8_LDB(dst, b, h) do { _Pragma("unroll") for (int n = 0; n < 2; ++n) _Pragma("unroll") for (int k = 0; k < 2; ++k) dst[n][k] = *(const PG8_LAS bf16x8*)(lds + PG8_SB(b, h) + boff + n * 2048 + k * 1024); } while (0)
#define PG8_MMA(ai, bj, At, Bt) do { __builtin_amdgcn_s_setprio(1); _Pragma("unroll") for (int m = 0; m < 4; ++m) _Pragma("unroll") for (int n = 0; n < 2; ++n) _Pragma("unroll") for (int k = 0; k < 2; ++k) \
        acc[ai][bj][m][n] = __builtin_amdgcn_mfma_f32_16x16x32_bf16(Bt[n][k], At[m][k], acc[ai][bj][m][n], 0, 0, 0); __builtin_amdgcn_s_setprio(0); } while (0)
#define PG8_WAIT_V(n) asm volatile("s_waitcnt vmcnt(" #n ")" ::: "memory")
#define PG8_WAIT_L(n) asm volatile("s_waitcnt lgkmcnt(" #n ")" ::: "memory")
#define PG8_BAR __builtin_amdgcn_s_barrier()
#define PG8_SCHED __builtin_amdgcn_sched_barrier(0)
    Unit cur, nxt; int ui = 0;
    if (!S.next(0, cur)) return;
    f32x4 acc[2][2][4][2];
#pragma unroll
    for (int a = 0; a < 2; ++a)
#pragma unroll
        for (int b = 0; b < 2; ++b)
#pragma unroll
            for (int m = 0; m < 4; ++m)
#pragma unroll
                for (int n = 0; n < 2; ++n) acc[a][b][m][n] = (f32x4){0.f, 0.f, 0.f, 0.f};
    bf16x8 At[4][2], B0[2][2], B1[2][2];
    const char* cA = (const char*)g.A + (size_t)cur.pm * tstep; const char* cB = (const char*)g.Bt + (size_t)cur.pn * tstep;
    S.a_ready(cur);
    if constexpr (SP2) {
        PG8_STAGE(PG8_SB(0, 0), cB, voffB); PG8_STAGE(PG8_SB(0, 1), cB + hstep, voffB); PG8_STAGE(PG8_SA(0, 0), cA, voffA); PG8_STAGE(PG8_SA(0, 1), cA + hstep, voffA);
        if (wr == 1) PG8_BAR;
        PG8_WAIT_V(2); PG8_BAR;
        PG8_STAGE(PG8_SB(1, 0), cB + kstep, voffB); PG8_STAGE(PG8_SA(1, 0), cA + kstep, voffA); PG8_STAGE(PG8_SB(1, 1), cB + hstep + kstep, voffB);
        PG8_WAIT_V(6); PG8_BAR;
    } else {
        PG8_STAGE(PG8_SB(0, 0), cB, voffB); PG8_STAGE(PG8_SA(0, 0), cA, voffA); PG8_STAGE(PG8_SB(0, 1), cB + hstep, voffB); PG8_STAGE(PG8_SA(0, 1), cA + hstep, voffA);
        if (wr == 1) PG8_BAR;
        PG8_WAIT_V(4); PG8_BAR;
        PG8_STAGE(PG8_SB(1, 0), cB + kstep, voffB); PG8_STAGE(PG8_SA(1, 0), cA + kstep, voffA); PG8_STAGE(PG8_SB(1, 1), cB + hstep + kstep, voffB);
        PG8_WAIT_V(6); PG8_BAR;
    }
    for (;;) {
        const bool has_next = S.next(ui + 1, nxt);
        const char* nA = has_next ? (const char*)g.A + (size_t)nxt.pm * tstep : cA; const char* nB = has_next ? (const char*)g.Bt + (size_t)nxt.pn * tstep : cB;
        for (int t = 0; t < nt; t += 2) {
            const bool last = (t == nt - 2);
            const char* a1 = cA + (size_t)(t + 1) * kstep;
            const char* a2 = last ? nA : cA + (size_t)(t + 2) * kstep; const char* b2 = last ? nB : cB + (size_t)(t + 2) * kstep;
            const char* a3 = a2 + kstep; const char* b3 = b2 + kstep;
            if (last && has_next) S.a_ready(nxt);
            if constexpr (SP2) {
            PG8_LDB(B0, 0, 0); PG8_LDB(B1, 0, 1); PG8_SCHED; PG8_LDA(At, 0, 0); PG8_STAGE(PG8_SA(1, 1), a1 + hstep, voffA);
            PG8_WAIT_V(8); PG8_WAIT_L(0); PG8_BAR; PG8_MMA(0, 0, At, B0); PG8_MMA(0, 1, At, B1); PG8_BAR; PG8_SCHED;
            PG8_LDA(At, 0, 1); PG8_STAGE(PG8_SB(0, 0), b2, voffB); PG8_STAGE(PG8_SB(0, 1), b2 + hstep, voffB); PG8_STAGE(PG8_SA(0, 0), a2, voffA);
            PG8_WAIT_V(8); PG8_WAIT_L(0); PG8_BAR; PG8_MMA(1, 0, At, B0); PG8_MMA(1, 1, At, B1); PG8_BAR; PG8_SCHED;
            PG8_LDB(B0, 1, 0); PG8_LDB(B1, 1, 1); PG8_SCHED; PG8_LDA(At, 1, 0); PG8_STAGE(PG8_SA(0, 1), a2 + hstep, voffA);
            PG8_WAIT_V(8); PG8_WAIT_L(0); PG8_BAR; PG8_MMA(0, 0, At, B0); PG8_MMA(0, 1, At, B1); PG8_BAR; PG8_SCHED;
            PG8_LDA(At, 1, 1); PG8_STAGE(PG8_SB(1, 0), b3, voffB); PG8_STAGE(PG8_SB(1, 1), b3 + hstep, voffB); PG8_STAGE(PG8_SA(1, 0), a3, voffA);
            PG8_WAIT_V(8); PG8_WAIT_L(0); PG8_BAR; PG8_MMA(1, 0, At, B0); PG8_MMA(1, 1, At, B1); PG8_BAR; PG8_SCHED;
            } else {
            PG8_LDB(B0, 0, 0); PG8_SCHED; PG8_LDA(At, 0, 0); PG8_STAGE(PG8_SA(1, 1), a1 + hstep, voffA);
            PG8_WAIT_L(8); PG8_BAR; PG8_WAIT_L(0); PG8_MMA(0, 0, At, B0); PG8_BAR; PG8_SCHED;
            PG8_LDB(B1, 0, 1); PG8_STAGE(PG8_SB(0, 0), b2, voffB);
            PG8_BAR; PG8_WAIT_L(0); PG8_MMA(0, 1, At, B1); PG8_BAR;
            PG8_LDA(At, 0, 1); PG8_STAGE(PG8_SA(0, 0), a2, voffA);
            PG8_BAR; PG8_WAIT_L(0); PG8_MMA(1, 0, At, B0); PG8_BAR; PG8_SCHED;
            PG8_STAGE(PG8_SB(0, 1), b2 + hstep, voffB);
            PG8_WAIT_V(6); PG8_BAR; PG8_MMA(1, 1, At, B1); PG8_BAR;
            PG8_LDB(B0, 1, 0); PG8_SCHED; PG8_LDA(At, 1, 0); PG8_STAGE(PG8_SA(0, 1), a2 + hstep, voffA);
            PG8_WAIT_L(8); PG8_BAR; PG8_WAIT_L(0); PG8_MMA(0, 0, At, B0); PG8_BAR; PG8_SCHED;
            PG8_LDB(B1, 1, 1); PG8_STAGE(PG8_SB(1, 0), b3, voffB);
            PG8_BAR; PG8_WAIT_L(0); PG8_MMA(0, 1, At, B1); PG8_BAR;
            PG8_LDA(At, 1, 1); PG8_STAGE(PG8_SA(1, 0), a3, voffA);
            PG8_BAR; PG8_WAIT_L(0); PG8_MMA(1, 0, At, B0); PG8_BAR; PG8_SCHED;
            PG8_STAGE(PG8_SB(1, 1), b3 + hstep, voffB);
            PG8_WAIT_V(6); PG8_BAR; PG8_MMA(1, 1, At, B1); PG8_BAR;
            }
        }
        if constexpr (ALIGN_EPI) { if (wr == 0) PG8_BAR; }
        if constexpr (!Epi::AFTER_DRAIN) { E(acc, cur, wr, wc, fr, fq); S.done(cur); }
        if (!has_next) break;
#pragma unroll
        for (int a = 0; a < 2; ++a)
#pragma unroll
            for (int b = 0; b < 2; ++b)
#pragma unroll
                for (int m = 0; m < 4; ++m)
#pragma unroll
                    for (int n = 0; n < 2; ++n) acc[a][b][m][n] = (f32x4){0.f, 0.f, 0.f, 0.f};
        cur = nxt; cA = nA; cB = nB; ++ui;
        if constexpr (ALIGN_EPI) { if (wr == 1) PG8_BAR; }
    }
    PG8_WAIT_V(0);
    if constexpr (!ALIGN_EPI) { if (wr == 0) PG8_BAR; }
    PG8_BAR;
    if constexpr (Epi::AFTER_DRAIN) { E.fused(acc, cur, wr, wc, fr, fq, lds, wid, lane); S.done(cur); }
#undef PG8_SA
#undef PG8_SB
#undef PG8_STAGE
#undef PG8_LDA
#undef PG8_LDB
#undef PG8_MMA
#undef PG8_WAIT_V
#undef PG8_WAIT_L
#undef PG8_BAR
#undef PG8_SCHED
}
}
constexpr int NWAVES = 8;
constexpr int DM = 1024, MP = 16384, SEQ = 2048, NB = 8, MS = 128;
constexpr int INC = 2064, INP = 2048;
constexpr int C_Q = 512, C_K = 768, C_V = 1024, C_G = 1536, C_F = 2048;
constexpr int FF = 4096;
constexpr float EPS = 1e-6f;
constexpr size_t O_YP = 0, O_YS = 16777216, O_SPP = O_YS + 131072, O_SGP = O_SPP + 61440, O_KP = O_SGP + 262144, O_VP = O_KP + 2097152, O_SPS = O_VP + 2097152, O_SGS = O_SPS + 983040;
constexpr size_t MiB = 1u << 20;
constexpr size_t WS_WIN = 2 * MiB, WS_WKV = 8 * MiB, WS_WOUT = 12 * MiB, WS_WQM = 14 * MiB, WS_WOM = 16 * MiB, WS_WUP = 18 * MiB, WS_WDN = 26 * MiB;
constexpr size_t WS_MN = 34 * MiB, WS_KB = 38 * MiB, WS_VT = 42 * MiB, WS_SSQ1 = 46 * MiB, WS_SSQ2 = 47 * MiB, WS_SSQ0 = 48 * MiB  , WS_FLOW = 58 * MiB  ;
constexpr size_t WS_PROJS = 49 * MiB  , WS_MIXS = 51 * MiB  , WS_QS = 52 * MiB, WS_CTXS = 53 * MiB, WS_HFFS = 54 * MiB  , WS_PARTS = 56 * MiB  ;
constexpr size_t WS_H = 64 * MiB  , WS_XB = 96 * MiB, WS_Q = 128 * MiB, WS_CTX = 160 * MiB;
constexpr size_t WS_PROJ = 192 * MiB  , WS_GL = 264 * MiB  , WS_CUM = 296 * MiB  , WS_ST = 312 * MiB  ;
constexpr size_t WS_HFF = 192 * MiB  ;
constexpr size_t WS_END = 328 * MiB;
constexpr int LDS_BYTES = 147456;

#define LAS __attribute__((address_space(3)))
typedef unsigned short bf16;
typedef unsigned u32x4 __attribute__((ext_vector_type(4)));
typedef unsigned u32x2 __attribute__((ext_vector_type(2)));
typedef float f32x4 __attribute__((ext_vector_type(4)));
typedef short bf16x8 __attribute__((ext_vector_type(8)));
typedef short bf16x4 __attribute__((ext_vector_type(4)));
#define LDS_WAIT() asm volatile("s_waitcnt lgkmcnt(0)" ::: "memory")
__device__ __forceinline__ unsigned pk2(float lo, float hi) { return pg8::cvt_pk_bf16(lo, hi); }
__device__ __forceinline__ float bf2f(unsigned short h) { return __uint_as_float((unsigned)h << 16); }
__device__ __forceinline__ float bflo(unsigned w) { return __uint_as_float(w << 16); }
__device__ __forceinline__ float bfhi(unsigned w) { return __uint_as_float(w & 0xffff0000u); }
__device__ __forceinline__ float wave_sum(float v) {
#pragma unroll
    for (int o = 1; o < 64; o <<= 1) v += __shfl_xor(v, o);
    return v;
}
__device__ __forceinline__ float wave_max(float v) {
#pragma unroll
    for (int o = 1; o < 64; o <<= 1) v = fmaxf(v, __shfl_xor(v, o));
    return v;
}
__device__ __forceinline__ float logsig(float x) { return fminf(x, 0.f) - log1pf(__expf(-fabsf(x))); }
__device__ __forceinline__ float silu(float x) { return x / (1.f + __expf(-x)); }
__device__ __forceinline__ f32x4 mfma16(bf16x8 a, bf16x8 b, f32x4 c) { return __builtin_amdgcn_mfma_f32_16x16x32_bf16(a, b, c, 0, 0, 0); }

struct Frame {
    LAS unsigned char* lds;
    int wave, G, blk;
    const float* in[25]; float* out; unsigned char* ws;
};
#define WSP(T, off) ((T*)(F.ws + (off)))

__device__ __forceinline__ void transpose_item(const float* W, int ldw, int nreal, bf16* WT, int ldt, int row_off, const float* gain, LAS float* scr, int k0, int n0, int lane) {
    const int n = n0 + (lane & 31);
    float tv[32];
#pragma unroll
    for (int i = 0; i < 32; ++i) { const int kk = 2 * i + (lane >> 5); tv[i] = (n < nreal) ? W[(size_t)(k0 + kk) * ldw + n] : 0.f; }
    if (gain) {
#pragma unroll
        for (int i = 0; i < 32; ++i) tv[i] *= gain[k0 + 2 * i + (lane >> 5)]; }
#pragma unroll
    for (int i = 0; i < 32; ++i) scr[(2 * i + (lane >> 5)) * 33 + (lane & 31)] = tv[i];
    LDS_WAIT(); asm volatile("" ::: "memory");
    const int c = lane & 7;
#pragma unroll
    for (int j = 0; j < 4; ++j) { const int nn = (lane >> 3) + 8 * j; const LAS float* s = scr + (8 * c) * 33 + nn;
        u32x4 o; o.x = pk2(s[0 * 33], s[1 * 33]); o.y = pk2(s[2 * 33], s[3 * 33]); o.z = pk2(s[4 * 33], s[5 * 33]); o.w = pk2(s[6 * 33], s[7 * 33]);
        *(u32x4*)(WT + (size_t)(row_off + n0 + nn) * ldt + k0 + 8 * c) = o; }
    LDS_WAIT(); asm volatile("" ::: "memory");
}
__device__ __forceinline__ void rows16_pass(const float* X, bf16* XB16, float* ssq, float* FL, const LAS bf16* Wf, int row0, int lane) {
    const int r = lane & 15, q = lane >> 4;
    const float* xp = X + (size_t)(row0 + r) * DM + q * 8; bf16* hp = XB16 + (size_t)(row0 + r) * DM + q * 8;
    f32x4 acc = {0.f, 0.f, 0.f, 0.f}; float ss = 0.f;
#pragma unroll 1
    for (int c0 = 0; c0 < 32; c0 += 8) { f32x4 a[16];
#pragma unroll
        for (int u = 0; u < 8; ++u) { a[2 * u] = *(const f32x4*)(xp + (c0 + u) * 32); a[2 * u + 1] = *(const f32x4*)(xp + (c0 + u) * 32 + 4); }
#pragma unroll
        for (int u = 0; u < 8; ++u) { const f32x4 a0 = a[2 * u], a1 = a[2 * u + 1];
            ss += ((a0[0] * a0[0] + a0[1] * a0[1]) + (a0[2] * a0[2] + a0[3] * a0[3])) + ((a1[0] * a1[0] + a1[1] * a1[1]) + (a1[2] * a1[2] + a1[3] * a1[3]));
            u32x4 aw; aw.x = pk2(a0[0], a0[1]); aw.y = pk2(a0[2], a0[3]); aw.z = pk2(a1[0], a1[1]); aw.w = pk2(a1[2], a1[3]);
            *(u32x4*)(hp + (c0 + u) * 32) = aw;
            if (FL) { const bf16x8 wfr = *(const LAS bf16x8*)(Wf + r * 1032 + (c0 + u) * 32 + q * 8); acc = mfma16(wfr, __builtin_bit_cast(bf16x8, aw), acc); } } }
    ss += __shfl_xor(ss, 16); ss += __shfl_xor(ss, 32);
    if (q == 0) ssq[row0 + r] = ss;
    if (FL) { acc = acc * rsqrtf(ss * (1.f / DM) + EPS); *(f32x4*)(FL + (size_t)(row0 + r) * 16 + q * 4) = acc; }
}
__device__ __forceinline__ void p0_prologue(const Frame& F) {
    const int lane = pg8::pg8_lane_id(), tid = F.wave * 64 + lane; (void)tid;
    LAS float* scr = (LAS float*)(F.lds + F.wave * 8704);
    LAS bf16* Wf = (LAS bf16*)(F.lds + 98304);
    { const float* win = F.in[8]; const float* gm = F.in[7];
#pragma unroll
      for (int kk = 0; kk < 2; ++kk) { const int k = tid * 2 + kk; const float g = gm[k]; const f32x4* wr = (const f32x4*)(win + (size_t)k * INC + 2048);
#pragma unroll
          for (int j4 = 0; j4 < 4; ++j4) { const f32x4 w = wr[j4];
#pragma unroll
              for (int e = 0; e < 4; ++e) Wf[(j4 * 4 + e) * 1032 + k] = (bf16)(pk2(w[e] * g, 0.f) & 0xffffu); } } }
    __syncthreads();
    { const float* wp = F.in[11]; const float* ps = F.in[12]; const float* wo = F.in[14]; bf16* wt = WSP(bf16, WS_WOUT);
      LAS float* Wp = (LAS float*)F.lds; LAS float* Wo = (LAS float*)(F.lds + 65536);
      for (int it = F.blk; it < 64; it += F.G) { const int g = it >> 4, n0 = (it & 15) * 64;
#pragma unroll
          for (int i = 0; i < 8; ++i) { const int i4 = (i * 512 + tid) * 4; *(LAS f32x4*)(Wp + i4) = *(const f32x4*)(wp + (size_t)g * 16384 + i4); }
#pragma unroll
          for (int i = 0; i < 16; ++i) { const int e = i * 512 + tid, d = e >> 6, nn = e & 63; Wo[e] = wo[(size_t)(g * 128 + d) * DM + n0 + nn] * ps[g * 128 + d]; }
          __syncthreads();
          const int n = tid & 63; float acc[16];
#pragma unroll
          for (int ci = 0; ci < 16; ++ci) acc[ci] = 0.f;
#pragma unroll 2
          for (int d4 = 0; d4 < 32; ++d4) { const float a0 = Wo[(d4 * 4 + 0) * 64 + n], a1 = Wo[(d4 * 4 + 1) * 64 + n], a2 = Wo[(d4 * 4 + 2) * 64 + n], a3 = Wo[(d4 * 4 + 3) * 64 + n];
#pragma unroll
              for (int ci = 0; ci < 16; ++ci) { const f32x4 w4 = *(const LAS f32x4*)(Wp + (F.wave * 16 + ci) * 128 + d4 * 4); acc[ci] += (w4[0] * a0 + w4[1] * a1) + (w4[2] * a2 + w4[3] * a3); } }
          u32x4* dst = (u32x4*)(wt + (size_t)(n0 + n) * DM + g * 128 + F.wave * 16);
          dst[0] = (u32x4){pk2(acc[0], acc[1]), pk2(acc[2], acc[3]), pk2(acc[4], acc[5]), pk2(acc[6], acc[7])};
          dst[1] = (u32x4){pk2(acc[8], acc[9]), pk2(acc[10], acc[11]), pk2(acc[12], acc[13]), pk2(acc[14], acc[15])};
          __syncthreads(); } }
    const int gw = F.blk * NWAVES + F.wave, NGW = F.G * NWAVES;
    constexpr int I_IN = 16 * 72, I_SQ = 16 * 32, I_OUT = 8 * 32, I_UP = 16 * 128, I_DN = 64 * 32;
    constexpr int NITEMS = I_IN + 2 * I_SQ + I_OUT + 2 * I_SQ + I_UP + I_DN;
    for (int it = gw; it < NITEMS; it += NGW) {
        int r = it; const float* W; const float* gain = nullptr; bf16* WT; int ldw, nreal, ldt = DM, row_off = 0, nb = 32, kofs = 0;
        if (r < I_IN) { W = F.in[8]; ldw = INC; nreal = INC; WT = WSP(bf16, WS_WIN); gain = F.in[7]; nb = 72; }
        else if ((r -= I_IN) < I_SQ) { W = F.in[16]; ldw = DM; nreal = DM; WT = WSP(bf16, WS_WKV); gain = F.in[15]; }
        else if ((r -= I_SQ) < I_SQ) { W = F.in[17]; ldw = DM; nreal = DM; WT = WSP(bf16, WS_WKV); gain = F.in[15]; row_off = DM; }
        else if ((r -= I_SQ) < I_OUT) { W = F.in[14]; ldw = DM; nreal = DM; WT = WSP(bf16, WS_WOUT); kofs = 512; }
        else if ((r -= I_OUT) < I_SQ) { W = F.in[19]; ldw = DM; nreal = DM; WT = WSP(bf16, WS_WQM); gain = F.in[18]; }
        else if ((r -= I_SQ) < I_SQ) { W = F.in[20]; ldw = DM; nreal = DM; WT = WSP(bf16, WS_WOM); }
        else if ((r -= I_SQ) < I_UP) { W = F.in[22]; ldw = FF; nreal = FF; WT = WSP(bf16, WS_WUP); gain = F.in[21]; nb = 128; }
        else { r -= I_UP; W = F.in[23]; ldw = DM; nreal = DM; WT = WSP(bf16, WS_WDN); ldt = FF; }
        transpose_item(W, ldw, nreal, WT, ldt, row_off, gain, scr, kofs + 64 * (r / nb), 32 * (r % nb), lane);
    }
    for (int it = gw; it < MP / 16 + (NB * 256) / 16; it += NGW) {
        if (it < MP / 16) rows16_pass(F.in[0], WSP(bf16, WS_H), WSP(float, WS_SSQ0), WSP(float, WS_FLOW), Wf, it * 16, lane);
        else rows16_pass(F.in[6], WSP(bf16, WS_MN), WSP(float, WS_SSQ0) + MP, nullptr, Wf, (it - MP / 16) * 16, lane); }
}

template <bool NORM, class Epi>
__device__ __forceinline__ void skinny_gemm(const Frame& F, const float* A, int lda, const bf16* Bt, int ldb, int K, int nslab, int ksplit, const Epi& E) {
    const int lane = pg8::pg8_lane_id(), tid = F.wave * 64 + lane; (void)tid;
    const int fr = lane & 15, fq = lane >> 4;
    for (int item = F.blk; item < nslab * ksplit; item += F.G) {
        const int slab = item % nslab, ks = item / nslab;
        const float* ap = A + (size_t)(F.wave * 16 + fr) * lda + (size_t)ks * K + fq * 8;
        const bf16* bp = Bt + (size_t)(slab * 16 + fr) * ldb + (size_t)ks * K + fq * 8;
        f32x4 acc = {0.f, 0.f, 0.f, 0.f}; float ss = 0.f;
#pragma unroll 1
        for (int k0 = 0; k0 < K; k0 += 256) {
            f32x4 a[16]; bf16x8 b[8];
#pragma unroll
            for (int u = 0; u < 8; ++u) { a[2 * u] = *(const f32x4*)(ap + k0 + u * 32); a[2 * u + 1] = *(const f32x4*)(ap + k0 + u * 32 + 4); b[u] = *(const bf16x8*)(bp + k0 + u * 32); }
#pragma unroll
            for (int u = 0; u < 8; ++u) { const f32x4 a0 = a[2 * u], a1 = a[2 * u + 1];
                if (NORM) ss += ((a0[0] * a0[0] + a0[1] * a0[1]) + (a0[2] * a0[2] + a0[3] * a0[3])) + ((a1[0] * a1[0] + a1[1] * a1[1]) + (a1[2] * a1[2] + a1[3] * a1[3]));
                u32x4 aw; aw.x = pk2(a0[0], a0[1]); aw.y = pk2(a0[2], a0[3]); aw.z = pk2(a1[0], a1[1]); aw.w = pk2(a1[2], a1[3]);
                acc = mfma16(b[u], __builtin_bit_cast(bf16x8, aw), acc); }
        }
        if (NORM) { ss += __shfl_xor(ss, 16); ss += __shfl_xor(ss, 32); acc = acc * rsqrtf(ss / (float)K + EPS); }
        E(F.wave * 16 + fr, slab * 16 + fq * 4, ks, acc);
    }
}
struct SEpiStore { float* O; int ldc; float scale; __device__ __forceinline__ void operator()(int row, int col, int, f32x4 v) const { *(f32x4*)(O + (size_t)row * ldc + col) = v * scale; } };
struct SEpiPart  { float* O; __device__ __forceinline__ void operator()(int row, int col, int ks, f32x4 v) const { *(f32x4*)(O + ((size_t)ks * MS + row) * DM + col) = v; } };
struct SEpiRes   { const float* base; float* O; __device__ __forceinline__ void operator()(int row, int col, int, f32x4 v) const { const f32x4 b = *(const f32x4*)(base + (size_t)row * DM + col); *(f32x4*)(O + (size_t)row * DM + col) = b + v; } };
struct SEpiRelu2 { float* O; __device__ __forceinline__ void operator()(int row, int col, int, f32x4 v) const { f32x4 o;
#pragma unroll
    for (int e = 0; e < 4; ++e) { const float a = fmaxf(v[e], 0.f); o[e] = a * a; } *(f32x4*)(O + (size_t)row * FF + col) = o; } };
__device__ __forceinline__ void p2_pool_prompt(const Frame& F) {
    const bf16* proj = WSP(const bf16, WS_PROJ); bf16* mixed = WSP(bf16, WS_H);
    const int lane = pg8::pg8_lane_id(), tid = F.wave * 64 + lane; (void)tid;
    const int c8 = (tid & 63) * 8, g = c8 >> 7, w = 2 << g;
    for (int it = F.blk; it < MP / 8; it += F.G) {
        const int row = it * 8 + F.wave, t = row & (SEQ - 1), b = row >> 11, cnt = (t + 1 < w) ? (t + 1) : w;
        const u32x4 u0 = *(const u32x4*)(proj + (size_t)row * INP + c8);
        float s[8]; s[0] = bflo(u0.x); s[1] = bfhi(u0.x); s[2] = bflo(u0.y); s[3] = bfhi(u0.y); s[4] = bflo(u0.z); s[5] = bfhi(u0.z); s[6] = bflo(u0.w); s[7] = bfhi(u0.w);
        float un[8];
#pragma unroll
        for (int e = 0; e < 8; ++e) un[e] = s[e];
        u32x4 uj[15];
#pragma unroll
        for (int j = 1; j < 16; ++j) { uj[j - 1] = (u32x4){0u, 0u, 0u, 0u}; if (j < cnt) uj[j - 1] = *(const u32x4*)(proj + (size_t)(row - j) * INP + c8); }
#pragma unroll
        for (int j = 0; j < 15; ++j) { s[0] += bflo(uj[j].x); s[1] += bfhi(uj[j].x); s[2] += bflo(uj[j].y); s[3] += bfhi(uj[j].y); s[4] += bflo(uj[j].z); s[5] += bfhi(uj[j].z); s[6] += bflo(uj[j].w); s[7] += bfhi(uj[j].w); }
        const float inv = 1.f / (float)cnt;
        u32x4 o; o.x = pk2(s[0] * inv - un[0], s[1] * inv - un[1]); o.y = pk2(s[2] * inv - un[2], s[3] * inv - un[3]); o.z = pk2(s[4] * inv - un[4], s[5] * inv - un[5]); o.w = pk2(s[6] * inv - un[6], s[7] * inv - un[7]);
        *(u32x4*)(mixed + (size_t)row * DM + c8) = o;
        if (t >= SEQ - 15) { float* sp = F.out + O_SPP + ((size_t)b * 15 + (t - (SEQ - 15))) * 512 + c8; *(f32x4*)sp = (f32x4){un[0], un[1], un[2], un[3]}; *(f32x4*)(sp + 4) = (f32x4){un[4], un[5], un[6], un[7]}; }
    }
}
__device__ __forceinline__ void p2_gla_local(const Frame& F) {
    const bf16* proj = WSP(const bf16, WS_PROJ); float* GL = WSP(float, WS_GL); float* CUM = WSP(float, WS_CUM);
    LAS float* fl = (LAS float*)(F.lds);
    LAS float* segt = (LAS float*)(F.lds + 4096);
    LAS bf16* Aop = (LAS bf16*)(F.lds + 8192);
    LAS bf16* Bop = (LAS bf16*)(F.lds + 8192 + 9216);
    const int lane = pg8::pg8_lane_id(), tid = F.wave * 64 + lane; const int wave = F.wave, fr = lane & 15, fq = lane >> 4;
    for (int unit = F.blk; unit < 1024; unit += F.G) {
        const int b = unit >> 7, n = (unit >> 2) & 31, h = unit & 3; const size_t r0 = (size_t)b * SEQ + n * 64;
        for (int e = tid; e < 1024; e += 512) fl[e] = WSP(const float, WS_FLOW)[r0 * 16 + e];
        const int d = tid & 63, seg = tid >> 6;
        float wf[16];
#pragma unroll
        for (int r = 0; r < 16; ++r) wf[r] = F.in[9][r * 256 + h * 64 + d];
        const float bias = F.in[10][h * 64 + d];
        __syncthreads();
        float cum[8]; float run = 0.f;
#pragma unroll
        for (int i = 0; i < 8; ++i) { const int t = seg * 8 + i; float pre = bias;
#pragma unroll
            for (int r = 0; r < 16; ++r) pre += fl[t * 16 + r] * wf[r];
            run += logsig(pre) * (1.f / 16.f); cum[i] = run; }
        segt[seg * 64 + d] = run;
        __syncthreads();
        float pre_s = 0.f, tot = 0.f;
#pragma unroll
        for (int s2 = 0; s2 < 8; ++s2) { const float v = segt[s2 * 64 + d]; tot += v; if (s2 < seg) pre_s += v; }
        float ke[8];
#pragma unroll
        for (int i = 0; i < 8; ++i) { const int t = seg * 8 + i; cum[i] += pre_s; CUM[(size_t)unit * 4096 + t * 64 + d] = cum[i];
            ke[i] = bf2f(proj[(r0 + t) * INP + C_K + h * 64 + d]) * __expf(tot - cum[i]); }
        { u32x4 o; o.x = pk2(ke[0], ke[1]); o.y = pk2(ke[2], ke[3]); o.z = pk2(ke[4], ke[5]); o.w = pk2(ke[6], ke[7]); *(LAS u32x4*)(Aop + d * 72 + seg * 8) = o; }
        { const int dv = tid & 127, ts = tid >> 7; unsigned short vv[16];
#pragma unroll
          for (int i = 0; i < 16; ++i) vv[i] = proj[(r0 + ts * 16 + i) * INP + C_V + h * 128 + dv];
          u32x4 o0, o1; o0.x = vv[0] | ((unsigned)vv[1] << 16); o0.y = vv[2] | ((unsigned)vv[3] << 16); o0.z = vv[4] | ((unsigned)vv[5] << 16); o0.w = vv[6] | ((unsigned)vv[7] << 16);
          o1.x = vv[8] | ((unsigned)vv[9] << 16); o1.y = vv[10] | ((unsigned)vv[11] << 16); o1.z = vv[12] | ((unsigned)vv[13] << 16); o1.w = vv[14] | ((unsigned)vv[15] << 16);
          *(LAS u32x4*)(Bop + dv * 72 + ts * 16) = o0; *(LAS u32x4*)(Bop + dv * 72 + ts * 16 + 8) = o1; }
        __syncthreads();
        const int mi = wave & 3;
#pragma unroll
        for (int jj = 0; jj < 4; ++jj) { const int nj = (wave >> 2) * 4 + jj; f32x4 acc = {0.f, 0.f, 0.f, 0.f};
#pragma unroll
            for (int ks = 0; ks < 2; ++ks) { const bf16x8 a = *(const LAS bf16x8*)(Aop + (mi * 16 + fr) * 72 + ks * 32 + fq * 8); const bf16x8 bb = *(const LAS bf16x8*)(Bop + (nj * 16 + fr) * 72 + ks * 32 + fq * 8);
                acc = mfma16(bb, a, acc); }
            *(f32x4*)(GL + (size_t)unit * 8192 + (mi * 16 + fr) * 128 + nj * 16 + fq * 4) = acc; }
        __syncthreads();
    }
}
__device__ __forceinline__ void p3_gla_scan(const Frame& F) {
    const float* GL = WSP(const float, WS_GL); const float* CUM = WSP(const float, WS_CUM); bf16* ST = WSP(bf16, WS_ST);
    const int lane = pg8::pg8_lane_id(), tid = F.wave * 64 + lane; (void)tid;
    for (int e = F.blk * 512 + tid; e < 65536; e += F.G * 512) {
        const int dv = e & 127, dg = (e >> 7) & 15, bh = e >> 11, b = bh >> 2, h = bh & 3;
        float S[4] = {0.f, 0.f, 0.f, 0.f};
#pragma unroll 8
        for (int n = 0; n < 32; ++n) { const size_t unit = (size_t)(b * 32 + n) * 4 + h;
            const f32x4 cl = *(const f32x4*)(CUM + unit * 4096 + 63 * 64 + dg * 4);
            float Lv[4];
#pragma unroll
            for (int i = 0; i < 4; ++i) Lv[i] = GL[unit * 8192 + (dg * 4 + i) * 128 + dv];
            u32x2 o; o.x = pk2(S[0], S[1]); o.y = pk2(S[2], S[3]); *(u32x2*)(ST + unit * 8192 + dv * 64 + dg * 4) = o;
#pragma unroll
            for (int i = 0; i < 4; ++i) S[i] = __expf(cl[i]) * S[i] + Lv[i]; }
#pragma unroll
        for (int i = 0; i < 4; ++i) F.out[O_SGP + ((size_t)(b * 4 + h) * 64 + dg * 4 + i) * 128 + dv] = S[i];
    }
}
__device__ __forceinline__ void p4_gla_out(const Frame& F) {
    const bf16* proj = WSP(const bf16, WS_PROJ); const float* CUM = WSP(const float, WS_CUM); const bf16* ST = WSP(const bf16, WS_ST); bf16* mixed = WSP(bf16, WS_H);
    LAS bf16* Aq = (LAS bf16*)(F.lds);
    LAS bf16* Bk = (LAS bf16*)(F.lds + 9216);
    LAS bf16* Bv = (LAS bf16*)(F.lds + 18432);
    LAS bf16* Bs = (LAS bf16*)(F.lds + 36864);
    LAS bf16* Ap = (LAS bf16*)(F.lds + 55296);
    LAS float* red = (LAS float*)(F.lds + 64512);
    const int lane = pg8::pg8_lane_id(), tid = F.wave * 64 + lane; const int wave = F.wave, fr = lane & 15, fq = lane >> 4;
    for (int unit = F.blk; unit < 1024; unit += F.G) {
        const int b = unit >> 7, n = (unit >> 2) & 31, h = unit & 3; const size_t r0 = (size_t)b * SEQ + n * 64;
        { const int t = tid >> 3, d8 = (tid & 7) * 8;
          const f32x4 c0 = *(const f32x4*)(CUM + (size_t)unit * 4096 + t * 64 + d8), c1 = *(const f32x4*)(CUM + (size_t)unit * 4096 + t * 64 + d8 + 4);
          const u32x4 qw = *(const u32x4*)(proj + (r0 + t) * INP + C_Q + h * 64 + d8), kw = *(const u32x4*)(proj + (r0 + t) * INP + C_K + h * 64 + d8);
          float cu[8] = {c0[0], c0[1], c0[2], c0[3], c1[0], c1[1], c1[2], c1[3]};
          float qv[8] = {bflo(qw.x), bfhi(qw.x), bflo(qw.y), bfhi(qw.y), bflo(qw.z), bfhi(qw.z), bflo(qw.w), bfhi(qw.w)};
          float kv[8] = {bflo(kw.x), bfhi(kw.x), bflo(kw.y), bfhi(kw.y), bflo(kw.z), bfhi(kw.z), bflo(kw.w), bfhi(kw.w)};
#pragma unroll
          for (int e = 0; e < 8; ++e) { const float ex = __expf(cu[e]); qv[e] = qv[e] * 0.125f * ex; kv[e] = kv[e] / ex; }
          u32x4 o; o.x = pk2(qv[0], qv[1]); o.y = pk2(qv[2], qv[3]); o.z = pk2(qv[4], qv[5]); o.w = pk2(qv[6], qv[7]); *(LAS u32x4*)(Aq + t * 72 + d8) = o;
          o.x = pk2(kv[0], kv[1]); o.y = pk2(kv[2], kv[3]); o.z = pk2(kv[4], kv[5]); o.w = pk2(kv[6], kv[7]); *(LAS u32x4*)(Bk + t * 72 + d8) = o; }
        { const int dv = tid & 127, ts = tid >> 7; unsigned short vv[16];
#pragma unroll
          for (int i = 0; i < 16; ++i) vv[i] = proj[(r0 + ts * 16 + i) * INP + C_V + h * 128 + dv];
          u32x4 o0, o1; o0.x = vv[0] | ((unsigned)vv[1] << 16); o0.y = vv[2] | ((unsigned)vv[3] << 16); o0.z = vv[4] | ((unsigned)vv[5] << 16); o0.w = vv[6] | ((unsigned)vv[7] << 16);
          o1.x = vv[8] | ((unsigned)vv[9] << 16); o1.y = vv[10] | ((unsigned)vv[11] << 16); o1.z = vv[12] | ((unsigned)vv[13] << 16); o1.w = vv[14] | ((unsigned)vv[15] << 16);
          *(LAS u32x4*)(Bv + dv * 72 + ts * 16) = o0; *(LAS u32x4*)(Bv + dv * 72 + ts * 16 + 8) = o1; }
#pragma unroll
        for (int p = 0; p < 2; ++p) { const int pc = tid + p * 512, dv = pc >> 3, part = pc & 7;
            *(LAS u32x4*)(Bs + dv * 72 + part * 8) = *(const u32x4*)(ST + (size_t)unit * 8192 + dv * 64 + part * 8); }
        __syncthreads();
        const int mi = wave & 3;
#pragma unroll
        for (int jj = 0; jj < 2; ++jj) { const int nj = (wave >> 2) * 2 + jj; f32x4 acc = {0.f, 0.f, 0.f, 0.f};
#pragma unroll
            for (int ks = 0; ks < 2; ++ks) { const bf16x8 a = *(const LAS bf16x8*)(Aq + (mi * 16 + fr) * 72 + ks * 32 + fq * 8); const bf16x8 bb = *(const LAS bf16x8*)(Bk + (nj * 16 + fr) * 72 + ks * 32 + fq * 8);
                acc = mfma16(bb, a, acc); }
            const int i = mi * 16 + fr, j0 = nj * 16 + fq * 4;
#pragma unroll
            for (int r = 0; r < 4; ++r) if (j0 + r > i) acc[r] = 0.f;
            u32x2 o; o.x = pk2(acc[0], acc[1]); o.y = pk2(acc[2], acc[3]); *(LAS u32x2*)(Ap + i * 72 + j0) = o; }
        __syncthreads();
        f32x4 oacc[4]; float ssq = 0.f;
#pragma unroll
        for (int jj = 0; jj < 4; ++jj) { const int nj = (wave >> 2) * 4 + jj; f32x4 acc = {0.f, 0.f, 0.f, 0.f};
#pragma unroll
            for (int ks = 0; ks < 2; ++ks) {
                const bf16x8 ap = *(const LAS bf16x8*)(Ap + (mi * 16 + fr) * 72 + ks * 32 + fq * 8), bv = *(const LAS bf16x8*)(Bv + (nj * 16 + fr) * 72 + ks * 32 + fq * 8);
                acc = mfma16(bv, ap, acc);
                const bf16x8 aq = *(const LAS bf16x8*)(Aq + (mi * 16 + fr) * 72 + ks * 32 + fq * 8), bs = *(const LAS bf16x8*)(Bs + (nj * 16 + fr) * 72 + ks * 32 + fq * 8);
                acc = mfma16(bs, aq, acc); }
            oacc[jj] = acc; ssq += (acc[0] * acc[0] + acc[1] * acc[1]) + (acc[2] * acc[2] + acc[3] * acc[3]); }
        ssq += __shfl_xor(ssq, 16); ssq += __shfl_xor(ssq, 32);
        if (fq == 0) red[(wave >> 2) * 64 + mi * 16 + fr] = ssq;
        __syncthreads();
        const float rstd = rsqrtf((red[mi * 16 + fr] + red[64 + mi * 16 + fr]) * (1.f / 128.f) + EPS);
        const size_t row = r0 + mi * 16 + fr;
#pragma unroll
        for (int jj = 0; jj < 4; ++jj) { const int dv0 = ((wave >> 2) * 4 + jj) * 16 + fq * 4;
            const f32x4 gn = *(const f32x4*)(F.in[13] + h * 128 + dv0); const u32x2 gw = *(const u32x2*)(proj + row * INP + C_G + h * 128 + dv0);
            const float g0 = silu(bflo(gw.x)), g1 = silu(bfhi(gw.x)), g2 = silu(bflo(gw.y)), g3 = silu(bfhi(gw.y));
            u32x2 o; o.x = pk2(oacc[jj][0] * rstd * gn[0] * g0, oacc[jj][1] * rstd * gn[1] * g1); o.y = pk2(oacc[jj][2] * rstd * gn[2] * g2, oacc[jj][3] * rstd * gn[3] * g3);
            *(u32x2*)(mixed + row * DM + 512 + h * 128 + dv0) = o; }
        __syncthreads();
    }
}

__device__ __forceinline__ void s_mixers(const Frame& F) {
    const float* projs = WSP(const float, WS_PROJS); float* mixs = WSP(float, WS_MIXS);
    const float* spool = F.in[2]; const float* sgla = F.in[3];
    const int lane = pg8::pg8_lane_id(), tid = F.wave * 64 + lane; (void)tid;
    for (int e = F.blk * 512 + tid; e < MS * 512; e += F.G * 512) { const int b = e >> 9, c = e & 511, g = c >> 7, w = 2 << g;
        const float u = projs[(size_t)b * INC + c]; float s = u;
        for (int j = 1; j < w; ++j) s += spool[((size_t)b * 15 + 15 - j) * 512 + c];
        mixs[(size_t)b * DM + c] = s / (float)w - u;
        float* so = F.out + O_SPS + (size_t)b * 15 * 512 + c;
#pragma unroll
        for (int i = 0; i < 14; ++i) so[(size_t)i * 512] = spool[((size_t)b * 15 + i + 1) * 512 + c];
        so[(size_t)14 * 512] = u; }
    LAS float* dec = (LAS float*)(F.lds); LAS float* qs = dec + 64; LAS float* ks = dec + 128; LAS float* vs = dec + 192;
    LAS float* red = dec + 320;
    LAS float* red2 = red + 2048;
    for (int it = F.blk; it < MS * 4; it += F.G) { const int b = it >> 2, h = it & 3; const float* pr = projs + (size_t)b * INC;
        if (tid < 64) { float pre = F.in[10][h * 64 + tid];
#pragma unroll
            for (int r = 0; r < 16; ++r) pre += pr[C_F + r] * F.in[9][r * 256 + h * 64 + tid];
            dec[tid] = __expf(logsig(pre) * (1.f / 16.f)); qs[tid] = pr[C_Q + h * 64 + tid] * 0.125f; ks[tid] = pr[C_K + h * 64 + tid]; }
        else if (tid < 192) vs[tid - 64] = pr[C_V + h * 128 + (tid - 64)];
        __syncthreads();
        { const int v4 = (tid & 31) * 4, dgp = tid >> 5; const f32x4 vv = *(const LAS f32x4*)(vs + v4); f32x4 po = {0.f, 0.f, 0.f, 0.f};
#pragma unroll
          for (int i = 0; i < 4; ++i) { const int d = dgp * 4 + i; const size_t off = ((size_t)(b * 4 + h) * 64 + d) * 128 + v4;
              const f32x4 s0 = *(const f32x4*)(sgla + off); const f32x4 sn = s0 * dec[d] + vv * ks[d]; *(f32x4*)(F.out + O_SGS + off) = sn; po += sn * qs[d]; }
          *(LAS f32x4*)(red + dgp * 128 + v4) = po; }
        __syncthreads();
        float o = 0.f;
        if (tid < 128) {
#pragma unroll
            for (int g = 0; g < 16; ++g) o += red[g * 128 + tid];
            const float s2 = wave_sum(o * o); if (lane == 0) red2[tid >> 6] = s2; }
        __syncthreads();
        if (tid < 128) { const float rstd = rsqrtf((red2[0] + red2[1]) * (1.f / 128.f) + EPS);
            mixs[(size_t)b * DM + 512 + h * 128 + tid] = o * rstd * F.in[13][h * 128 + tid] * silu(pr[C_G + h * 128 + tid]); }
        __syncthreads();
    }
}
constexpr int KST = 264;
__device__ __forceinline__ void p7_attn_prompt(const Frame& F) {
    const bf16* Q = WSP(const bf16, WS_Q); const bf16* KB = WSP(const bf16, WS_KB); const bf16* VT = WSP(const bf16, WS_VT); bf16* CTX = WSP(bf16, WS_CTX);
    LAS bf16* L = (LAS bf16*)F.lds;
    const int lane = pg8::pg8_lane_id(), tid = F.wave * 64 + lane; const int wave = F.wave, fr = lane & 15, fq = lane >> 4;
    for (int unit = F.blk; unit < 256; unit += F.G) {
        const int b = unit >> 5, h = (unit >> 3) & 3, qt = unit & 7; const size_t row0 = (size_t)b * SEQ + qt * 256 + wave * 32;
        const bf16* kg = KB + (size_t)(b * 4 + h) * 65536; const bf16* vg = VT + (size_t)(b * 4 + h) * 65536;
        bf16x8 qf[2][8];
#pragma unroll
        for (int mi = 0; mi < 2; ++mi)
#pragma unroll
            for (int ks = 0; ks < 8; ++ks) qf[mi][ks] = *(const bf16x8*)(Q + (row0 + mi * 16 + fr) * DM + h * 256 + ks * 32 + fq * 8);
#pragma unroll 1
        for (int i0 = 0; i0 < 16; i0 += 8) { u32x4 t[8];
#pragma unroll
          for (int i = 0; i < 8; ++i) { const int p = tid + (i0 + i) * 512; t[i] = *(const u32x4*)(kg + (p >> 5) * 256 + (p & 31) * 8); }
#pragma unroll
          for (int i = 0; i < 8; ++i) { const int p = tid + (i0 + i) * 512; *(LAS u32x4*)(L + (p >> 5) * KST + (p & 31) * 8) = t[i]; } }
        __syncthreads();
        f32x4 sacc[2][16];
        unsigned koff = (unsigned)(fr * KST + fq * 8) * 2u;
#pragma unroll
        for (int nj = 0; nj < 16; ++nj) { sacc[0][nj] = (f32x4){0.f, 0.f, 0.f, 0.f}; sacc[1][nj] = (f32x4){0.f, 0.f, 0.f, 0.f};
            const LAS unsigned char* kp = F.lds + koff; koff += 16u * KST * 2u; asm volatile("" : "+v"(koff));
            bf16x8 kf[8];
#pragma unroll
            for (int ks = 0; ks < 8; ++ks) kf[ks] = *(const LAS bf16x8*)(kp + ks * 64);
            __builtin_amdgcn_sched_barrier(0);
#pragma unroll
            for (int ks = 0; ks < 8; ++ks) { sacc[0][nj] = mfma16(kf[ks], qf[0][ks], sacc[0][nj]); sacc[1][nj] = mfma16(kf[ks], qf[1][ks], sacc[1][nj]); }
            __builtin_amdgcn_sched_barrier(0); }
        float inv[2]; bf16x8 pf[2][8];
#pragma unroll
        for (int mi = 0; mi < 2; ++mi) { float mx = -3.0e38f;
#pragma unroll
            for (int nj = 0; nj < 16; ++nj) mx = fmaxf(mx, fmaxf(fmaxf(sacc[mi][nj][0], sacc[mi][nj][1]), fmaxf(sacc[mi][nj][2], sacc[mi][nj][3])));
            mx = fmaxf(mx, __shfl_xor(mx, 16)); mx = fmaxf(mx, __shfl_xor(mx, 32));
            float sm = 0.f;
#pragma unroll
            for (int s = 0; s < 8; ++s) { float e[8];
#pragma unroll
                for (int r = 0; r < 4; ++r) { e[r] = __expf(sacc[mi][2 * s][r] - mx); e[4 + r] = __expf(sacc[mi][2 * s + 1][r] - mx); }
                sm += ((e[0] + e[1]) + (e[2] + e[3])) + ((e[4] + e[5]) + (e[6] + e[7]));
                u32x4 w; w.x = pk2(e[0], e[1]); w.y = pk2(e[2], e[3]); w.z = pk2(e[4], e[5]); w.w = pk2(e[6], e[7]); pf[mi][s] = __builtin_bit_cast(bf16x8, w); }
            sm += __shfl_xor(sm, 16); sm += __shfl_xor(sm, 32); inv[mi] = 1.f / sm; }
        __syncthreads();
#pragma unroll 1
        for (int i0 = 0; i0 < 16; i0 += 8) { u32x4 t[8];
#pragma unroll
          for (int i = 0; i < 8; ++i) { const int p = tid + (i0 + i) * 512; t[i] = *(const u32x4*)(vg + (p >> 5) * 256 + (p & 31) * 8); }
#pragma unroll
          for (int i = 0; i < 8; ++i) { const int p = tid + (i0 + i) * 512; *(LAS u32x4*)(L + (p >> 5) * KST + (p & 31) * 8) = t[i]; } }
        __syncthreads();
        unsigned voff = (unsigned)(fr * KST + fq * 8) * 2u;
        bf16* cp = CTX + (row0 + fr) * DM + h * 256 + fq * 4;
#pragma unroll
        for (int nj = 0; nj < 16; ++nj) { f32x4 o0 = {0.f, 0.f, 0.f, 0.f}, o1 = {0.f, 0.f, 0.f, 0.f};
            const LAS unsigned char* vp = F.lds + voff; voff += 16u * KST * 2u; asm volatile("" : "+v"(voff));
            bf16x8 vf[8];
#pragma unroll
            for (int s = 0; s < 8; ++s) vf[s] = *(const LAS bf16x8*)(vp + s * 64);
            __builtin_amdgcn_sched_barrier(0);
#pragma unroll
            for (int s = 0; s < 8; ++s) { o0 = mfma16(vf[s], pf[0][s], o0); o1 = mfma16(vf[s], pf[1][s], o1); }
            __builtin_amdgcn_sched_barrier(0);
            u32x2 w0; w0.x = pk2(o0[0] * inv[0], o0[1] * inv[0]); w0.y = pk2(o0[2] * inv[0], o0[3] * inv[0]); *(u32x2*)(cp + nj * 16) = w0;
            u32x2 w1; w1.x = pk2(o1[0] * inv[1], o1[1] * inv[1]); w1.y = pk2(o1[2] * inv[1], o1[3] * inv[1]); *(u32x2*)(cp + 16 * DM + nj * 16) = w1; }
        __syncthreads();
    }
}
__device__ __forceinline__ void s_attn(const Frame& F) {
    const float* qsb = WSP(const float, WS_QS); float* ctxs = WSP(float, WS_CTXS); const float* ck = F.in[4]; const float* cv = F.in[5];
    LAS float* part = (LAS float*)F.lds; LAS float* ml = part + 8 * 256;
    const int lane = pg8::pg8_lane_id(), tid = F.wave * 64 + lane; const int wave = F.wave;
    for (int it = F.blk; it < MS * 4; it += F.G) { const int b = it >> 2, h = it & 3;
        const f32x4 q4 = *(const f32x4*)(qsb + (size_t)b * DM + h * 256 + lane * 4);
        const float* kb = ck + ((size_t)b * 256 * 4 + h) * 256 + lane * 4 + (size_t)(wave * 32) * 1024;
        const float* vb = cv + ((size_t)b * 256 * 4 + h) * 256 + lane * 4 + (size_t)(wave * 32) * 1024;
        float mrun = -3.0e38f, l = 0.f; f32x4 acc = {0.f, 0.f, 0.f, 0.f};
#pragma unroll 1
        for (int i0 = 0; i0 < 32; i0 += 8) { f32x4 k4[8], v4[8]; float sc[8];
#pragma unroll
            for (int u = 0; u < 8; ++u) { k4[u] = *(const f32x4*)(kb + (size_t)(i0 + u) * 1024); v4[u] = *(const f32x4*)(vb + (size_t)(i0 + u) * 1024); }
            float mx = mrun;
#pragma unroll
            for (int u = 0; u < 8; ++u) { sc[u] = wave_sum((k4[u][0] * q4[0] + k4[u][1] * q4[1]) + (k4[u][2] * q4[2] + k4[u][3] * q4[3])); mx = fmaxf(mx, sc[u]); }
            const float rescale = __expf(mrun - mx); l *= rescale; acc = acc * rescale; mrun = mx;
#pragma unroll
            for (int u = 0; u < 8; ++u) { const float p = __expf(sc[u] - mx); l += p; acc += v4[u] * p; } }
        *(LAS f32x4*)(part + wave * 256 + lane * 4) = acc; if (lane == 0) { ml[wave * 2] = mrun; ml[wave * 2 + 1] = l; }
        __syncthreads();
        if (tid < 256) { float M = -3.0e38f;
#pragma unroll
            for (int w = 0; w < 8; ++w) M = fmaxf(M, ml[w * 2]);
            float o = 0.f, L = 0.f;
#pragma unroll
            for (int w = 0; w < 8; ++w) { const float e = __expf(ml[w * 2] - M); L += e * ml[w * 2 + 1]; o += e * part[w * 256 + tid]; }
            ctxs[(size_t)b * DM + h * 256 + tid] = o / L; }
        __syncthreads();
    }
}
__device__ __forceinline__ void final_norm_prompt(const Frame& F) {
    const int lane = pg8::pg8_lane_id(), tid = F.wave * 64 + lane; (void)tid;
    const int gw = F.blk * NWAVES + F.wave, NGW = F.G * NWAVES; const f32x4* g4 = (const f32x4*)F.in[24] + lane;
    for (int m = gw; m < MP; m += NGW) { f32x4* xr = (f32x4*)(F.out + O_YP + (size_t)m * DM) + lane; f32x4 v[4]; float s = 0.f;
#pragma unroll
        for (int j = 0; j < 4; ++j) { v[j] = xr[64 * j]; s += (v[j].x * v[j].x + v[j].y * v[j].y) + (v[j].z * v[j].z + v[j].w * v[j].w); }
        const float rstd = rsqrtf(wave_sum(s) * (1.f / DM) + EPS);
#pragma unroll
        for (int j = 0; j < 4; ++j) xr[64 * j] = v[j] * rstd * g4[64 * j]; }
}
__device__ __forceinline__ void final_norm_sample(const Frame& F) {
    const int lane = pg8::pg8_lane_id(), tid = F.wave * 64 + lane; (void)tid;
    const int gw = F.blk * NWAVES + F.wave, NGW = F.G * NWAVES; const f32x4* g4 = (const f32x4*)F.in[24] + lane; const float* parts = WSP(const float, WS_PARTS);
    for (int m = gw; m < MS; m += NGW) { f32x4* xr = (f32x4*)(F.out + O_YS + (size_t)m * DM) + lane; f32x4 v[4]; float s = 0.f;
#pragma unroll
        for (int j = 0; j < 4; ++j) { v[j] = xr[64 * j];
#pragma unroll
            for (int ks = 0; ks < 4; ++ks) v[j] += ((const f32x4*)(parts + ((size_t)ks * MS + m) * DM) + lane)[64 * j];
            s += (v[j].x * v[j].x + v[j].y * v[j].y) + (v[j].z * v[j].z + v[j].w * v[j].w); }
        const float rstd = rsqrtf(wave_sum(s) * (1.f / DM) + EPS);
#pragma unroll
        for (int j = 0; j < 4; ++j) xr[64 * j] = v[j] * rstd * g4[64 * j]; }
}
#define RLX_AGENT __ATOMIC_RELAXED, __HIP_MEMORY_SCOPE_AGENT
#define XB_TMO      128
#define XB_XCNT(j)  (256  + 64 * (j))
#define XB_XSUB(j)  (1280 + 64 * (j))
#define XB_XGEN(j)  (2304 + 64 * (j))
#define XB_TOP      3328
#define XB_TOPGEN   3392
#define XCD_BAR_WORDS 3456
#define XB_SPIN_CAP (1u << 18)

__device__ __forceinline__ unsigned xb_ld(unsigned* p)              { return __hip_atomic_load(p, __ATOMIC_RELAXED, __HIP_MEMORY_SCOPE_AGENT); }
__device__ __forceinline__ unsigned xb_add(unsigned* p, unsigned v) { return __hip_atomic_fetch_add(p, v, __ATOMIC_RELAXED, __HIP_MEMORY_SCOPE_AGENT); }
__device__ __forceinline__ unsigned xb_xcc_id() { return (unsigned)__builtin_amdgcn_s_getreg((3 << 11) | 20) & 0xFu; }
#define XB_SPIN(cond, bar) do { unsigned _sp = 0; while (cond) { __builtin_amdgcn_s_sleep(1); \
    if ((++_sp & 255u) == 0u) { if (xb_ld(&(bar)[XB_TMO])) break; if (_sp > XB_SPIN_CAP) { atomicAdd(&(bar)[XB_TMO], 1u); break; } } } } while (0)

struct XcdBarrier {
    unsigned* bar; unsigned x;
    volatile LAS unsigned* st;
};

__device__ __forceinline__ XcdBarrier xcd_barrier_post(unsigned* bar, volatile LAS unsigned* st, bool t0) {
    XcdBarrier b; b.bar = bar; b.x = xb_xcc_id(); b.st = st;
    if (t0) (void)xb_add(&bar[XB_XCNT(b.x)], 1u);
    return b;
}
__device__ __forceinline__ void xcd_barrier_complete(unsigned* bar, unsigned x, unsigned& nloc, unsigned& nx) {
    const unsigned G = gridDim.x * gridDim.y * gridDim.z;
    unsigned sum, cnt, mine, sp = 0u;
    for (;;) {
        sum = 0u; cnt = 0u; mine = 0u;
#pragma unroll
        for (unsigned j = 0; j < 16; ++j) { const unsigned c = xb_ld(&bar[XB_XCNT(j)]); sum += c; cnt += (c > 0u) ? 1u : 0u; mine = (j == x) ? c : mine; }
        if (sum == G) break;
        __builtin_amdgcn_s_sleep(1);
        if ((++sp & 255u) == 0u) { if (xb_ld(&bar[XB_TMO])) break; if (sp > XB_SPIN_CAP) { atomicAdd(&bar[XB_TMO], 1u); break; } }
    }
    nloc = mine > 0u ? mine : 1u; nx = cnt > 0u ? cnt : 1u;
}

__device__ __forceinline__ void xcd_barrier(const XcdBarrier& b, int wave) {
    asm volatile("s_waitcnt vmcnt(0)" ::: "memory");
    __syncthreads();
    if (wave == 0 && pg8::pg8_lane_id() == 0) {
        unsigned* bar = b.bar;
        __builtin_amdgcn_s_waitcnt(0);
        unsigned nloc = b.st[0], nx = b.st[1];
        if (nloc == 0u) { xcd_barrier_complete(bar, b.x, nloc, nx); b.st[0] = nloc; b.st[1] = nx; }
        const unsigned old = xb_add(&bar[XB_XSUB(b.x)], 1u);
        const unsigned gen = old / nloc;
        if (old + 1u == (gen + 1u) * nloc) {
            __builtin_amdgcn_fence(__ATOMIC_RELEASE, "agent");
            asm volatile("s_waitcnt vmcnt(0)" ::: "memory");
            const unsigned og = xb_add(&bar[XB_TOP], 1u);
            const unsigned tg = og / nx;
            if (og + 1u == (tg + 1u) * nx) xb_add(&bar[XB_TOPGEN], 1u);
            else XB_SPIN(xb_ld(&bar[XB_TOPGEN]) == tg, bar);
            __builtin_amdgcn_fence(__ATOMIC_ACQUIRE, "agent");
            xb_add(&bar[XB_XGEN(b.x)], 1u);
            asm volatile("s_waitcnt vmcnt(0)" ::: "memory");
        } else {
            XB_SPIN(xb_ld(&bar[XB_XGEN(b.x)]) == gen, bar);
            __builtin_amdgcn_fence(__ATOMIC_ACQUIRE, "agent");
            asm volatile("s_waitcnt vmcnt(0)" ::: "memory");
        }
    }
    __syncthreads();
}
#ifndef MK_N_LAUNCHES
#define MK_N_LAUNCHES 1
#endif
constexpr int N_PHASES = 12;
#ifndef REPX
#define REPX 0
#endif
#define AMP_WAIT() do { __syncthreads(); const unsigned long long t1_ = __builtin_amdgcn_s_memrealtime(); while (__builtin_amdgcn_s_memrealtime() < t1_ + (t1_ - t0_)) __builtin_amdgcn_s_sleep(8); __syncthreads(); } while (0)
#define RX(bit) for (int rx_ = 0; rx_ < 1 + ((REPX >> (bit)) & 1); ++rx_)
struct Args { const float* in[25]; float* out; unsigned char* ws; int ph_lo, ph_hi; };
struct RotOrder {
    pg8::StaticOrder S;
    __device__ void init(int M, int N, int G, int c, int rot) { S.init(M, N, G, (c + G - (rot % G)) % G); }
    __device__ bool next(int i, pg8::Unit& u) const { return S.next(i, u); }
    __device__ __forceinline__ void a_ready(const pg8::Unit&) const {}
    __device__ __forceinline__ void done(const pg8::Unit&) const {}
};
__global__ void __launch_bounds__(NWAVES * 64, 2) mk_fwd(Args args) {
    extern __shared__ __attribute__((aligned(16))) unsigned char lds_raw[];
    Frame F;
    F.lds = (LAS unsigned char*)lds_raw;
    F.wave = __builtin_amdgcn_readfirstlane((int)threadIdx.x >> 6);
    F.G = gridDim.x; F.blk = blockIdx.x;
#pragma unroll
    for (int i = 0; i < 25; ++i) F.in[i] = args.in[i];
    F.out = args.out; F.ws = args.ws;
    const int lo = args.ph_lo, hi = args.ph_hi;
#define IN(k) (lo <= (k) && (k) < hi)
    volatile LAS unsigned* bst = (volatile LAS unsigned*)(F.lds + 143360);
    { const int l0 = pg8::pg8_lane_id(); if (F.wave == 0 && l0 < 2) bst[l0] = 0u; }
    __syncthreads();
    XcdBarrier bar = xcd_barrier_post((unsigned*)args.ws, bst, F.wave == 0 && pg8::pg8_lane_id() == 0);
    if (lo < 0) cg::this_grid().sync();
#define GRID_BAR() xcd_barrier(bar, F.wave)
#define SEAM(k) do { if (IN(k) && IN((k) + 1)) GRID_BAR(); } while (0)
    typedef pg8::bf16_t pb;
    if (IN(0)) { constexpr int rep = 0; (void)rep; p0_prologue(F); __syncthreads(); }
    SEAM(0);
    if (IN(1)) { constexpr int rep = 0; (void)rep;
        RX(10) { SEpiStore E{WSP(float, WS_PROJS), INC, 1.f}; skinny_gemm<true>(F, F.in[1], DM, WSP(const bf16, WS_WIN), DM, DM, INC / 16, 1, E); }
        { pg8::Gemm g{WSP(const pb, WS_H), WSP(const pb, WS_WIN), MP, INP, DM}; pg8::StaticOrder S; S.init(MP, INP, F.G, F.blk);
          pg8::EpiScale<0, 1> E{WSP(pb, WS_PROJ), INP, WSP(const float, WS_SSQ0), 1.f}; pg8::gemm_phase<pg8::EpiScale<0, 1>, pg8::StaticOrder, true, true>(F.lds, F.wave, g, S, E); }
    }
    SEAM(1);
    if (IN(2)) { constexpr int rep = 0; (void)rep; RX(7) s_mixers(F); RX(6) p2_pool_prompt(F); RX(5) p2_gla_local(F); }
    SEAM(2);
    if (IN(3)) { constexpr int rep = 0; (void)rep;
        { SEpiRes E{F.in[1], F.out + O_YS}; skinny_gemm<false>(F, WSP(const float, WS_MIXS), DM, WSP(const bf16, WS_WOUT), DM, DM, DM / 16, 1, E); }
        RX(2) p3_gla_scan(F);
        { pg8::Gemm g{WSP(const pb, WS_MN), WSP(const pb, WS_WKV), NB * 256, 2048, DM}; RotOrder S; S.init(NB * 256, 2048, F.G, F.blk, 128);
          pg8::EpiKV E{F.out + O_KP, F.out + O_VP, WSP(pb, WS_KB), WSP(pb, WS_VT), WSP(const float, WS_SSQ0) + MP}; pg8::gemm_phase<pg8::EpiKV, RotOrder, true, true>(F.lds, F.wave, g, S, E); }
    }
    SEAM(3);
    if (IN(4)) { constexpr int rep = 0; (void)rep;
        RX(4) { SEpiStore E{WSP(float, WS_QS), DM, 0.0625f}; skinny_gemm<true>(F, F.out + O_YS, DM, WSP(const bf16, WS_WQM), DM, DM, DM / 16, 1, E); }
        RX(3) p4_gla_out(F);
    }
    SEAM(4);
    if (IN(5)) { constexpr int rep = 0; (void)rep;
        RX(9) s_attn(F);
        { pg8::Gemm g{WSP(const pb, WS_H), WSP(const pb, WS_WOUT), MP, DM, DM}; pg8::StaticOrder S; S.init(MP, DM, F.G, F.blk);
          pg8::EpiRes<true, true> E{F.in[0], F.out + O_YP, WSP(pb, WS_XB), WSP(float, WS_SSQ1)}; pg8::gemm_phase<pg8::EpiRes<true, true>, pg8::StaticOrder, true, true>(F.lds, F.wave, g, S, E); }
    }
    SEAM(5);
    if (IN(6)) { constexpr int rep = 0; (void)rep;
        if (rep == 0) { SEpiRes E{F.out + O_YS, F.out + O_YS}; skinny_gemm<false>(F, WSP(const float, WS_CTXS), DM, WSP(const bf16, WS_WOM), DM, DM, DM / 16, 1, E); }
        { pg8::Gemm g{WSP(const pb, WS_XB), WSP(const pb, WS_WQM), MP, DM, DM}; pg8::StaticOrder S; S.init(MP, DM, F.G, F.blk);
          pg8::EpiScale<0> E{WSP(pb, WS_Q), DM, WSP(const float, WS_SSQ1), 0.0625f}; pg8::gemm_phase<pg8::EpiScale<0>, pg8::StaticOrder, true, true>(F.lds, F.wave, g, S, E); }
    }
    SEAM(6);
    if (IN(7)) { constexpr int rep = 0; (void)rep;
        RX(0) { SEpiRelu2 E{WSP(float, WS_HFFS)}; skinny_gemm<true>(F, F.out + O_YS, DM, WSP(const bf16, WS_WUP), DM, DM, FF / 16, 1, E); }
        __syncthreads();
        RX(1) p7_attn_prompt(F);
    }
    SEAM(7);
    if (IN(8)) { constexpr int rep = 0; (void)rep;
        { SEpiPart E{WSP(float, WS_PARTS)}; skinny_gemm<false>(F, WSP(const float, WS_HFFS), FF, WSP(const bf16, WS_WDN), FF, DM, DM / 16, 4, E); }
        { pg8::Gemm g{WSP(const pb, WS_CTX), WSP(const pb, WS_WOM), MP, DM, DM}; pg8::StaticOrder S; S.init(MP, DM, F.G, F.blk);
          pg8::EpiRes<true, true> E{F.out + O_YP, F.out + O_YP, WSP(pb, WS_XB), WSP(float, WS_SSQ2)}; pg8::gemm_phase<pg8::EpiRes<true, true>, pg8::StaticOrder, true, true>(F.lds, F.wave, g, S, E); }
    }
    SEAM(8);
    if (IN(9)) { constexpr int rep = 0; (void)rep;
        if (rep == 0) final_norm_sample(F);
        { pg8::Gemm g{WSP(const pb, WS_XB), WSP(const pb, WS_WUP), MP, FF, DM}; pg8::StaticOrder S; S.init(MP, FF, F.G, F.blk);
          pg8::EpiScale<1> E{WSP(pb, WS_HFF), FF, WSP(const float, WS_SSQ2), 1.f}; pg8::gemm_phase<pg8::EpiScale<1>, pg8::StaticOrder, true, true>(F.lds, F.wave, g, S, E); }
    }
    SEAM(9);
    if (IN(10)) { constexpr int rep = 0; (void)rep;
        pg8::Gemm g{WSP(const pb, WS_HFF), WSP(const pb, WS_WDN), MP, DM, FF}; pg8::StaticOrder S; S.init(MP, DM, F.G, F.blk);
        pg8::EpiRes<false, false> E{F.out + O_YP, F.out + O_YP, nullptr, nullptr}; pg8::gemm_phase<pg8::EpiRes<false, false>, pg8::StaticOrder, true, true>(F.lds, F.wave, g, S, E);
    }
    SEAM(10);
    if (IN(11)) { constexpr int rep = 0; (void)rep; final_norm_prompt(F); }
    if ((REPX >> 8) & 1) { for (int q = 0; q < 4; ++q) { GRID_BAR(); } }
#undef IN
#undef SEAM
}

extern "C" void kernel_launch(void* const* d_in, const int* in_sizes, int n_in, void* d_out, int out_size, void* d_ws, size_t ws_size, hipStream_t stream) {
    static int grid = 0;
    if (grid == 0) {
        if (n_in != 25 || ws_size < WS_END) { fprintf(stderr, "kernel_launch: unexpected inputs (n_in %d, ws %zu)\n", n_in, ws_size); grid = -1; return; }
        int dev = 0, cus = 0, per_cu = 0;
        hipGetDevice(&dev); hipDeviceGetAttribute(&cus, hipDeviceAttributeMultiprocessorCount, dev);
        if (hipFuncSetAttribute((const void*)mk_fwd, hipFuncAttributeMaxDynamicSharedMemorySize, LDS_BYTES) != hipSuccess) { fprintf(stderr, "kernel_launch: hipFuncSetAttribute failed\n"); grid = -1; return; }
        if (hipOccupancyMaxActiveBlocksPerMultiprocessor(&per_cu, (const void*)mk_fwd, NWAVES * 64, LDS_BYTES) != hipSuccess || per_cu < 1) { fprintf(stderr, "kernel_launch: occupancy query says %d\n", per_cu); per_cu = 1; }
        (void)hipGetLastError();
        grid = cus * 1;
        fprintf(stderr, "kernel_launch: grid %d (cus %d, per_cu %d)\n", grid, cus, per_cu);
    }
    if (grid < 0) return;
    if (hipMemsetAsync(d_ws, 0, 16384, stream) != hipSuccess) { fprintf(stderr, "kernel_launch: memset failed\n"); return; }
    Args a{};
    for (int i = 0; i < 25; ++i) a.in[i] = (const float*)d_in[i];
    a.out = (float*)d_out; a.ws = (unsigned char*)d_ws;
#if MK_N_LAUNCHES == 1
    a.ph_lo = 0; a.ph_hi = N_PHASES;
    void* kargs[] = {&a};
    hipError_t e = hipLaunchCooperativeKernel((const void*)mk_fwd, dim3(grid), dim3(NWAVES * 64), kargs, LDS_BYTES, stream);
    if (e != hipSuccess) fprintf(stderr, "cooperative launch failed: %s (grid %d)\n", hipGetErrorString(e), grid);
#else
    for (int p = 0; p < N_PHASES; ++p) { a.ph_lo = p; a.ph_hi = p + 1; hipLaunchKernelGGL(mk_fwd, dim3(grid), dim3(NWAVES * 64), LDS_BYTES, stream, a); }
#endif
}
```

```cpp
#include <hip/hip_runtime.h>
#include <hip/hip_cooperative_groups.h>
#include <cstdio>
#include <cstdint>
namespace cg = cooperative_groups;
namespace pg8 {
#define PG8_LAS __attribute__((address_space(3)))
typedef unsigned short bf16_t;
typedef short bf16x8 __attribute__((ext_vector_type(8)));
typedef float f32x4 __attribute__((ext_vector_type(4)));
typedef unsigned u32x4 __attribute__((ext_vector_type(4)));
constexpr int BM = 256, BK = 64, HALF = 128, HTB = HALF * BK * 2  , STAGE_BYTES = 8 * HTB, NXCD = 8, WGM = 8;

__host__ __device__ __forceinline__ int lds_byte(int r, int c) { const int st = (r >> 4) * 2 + (c >> 5), rr = r & 15, cc = c & 31, ob = rr * 64 + cc * 2; return st * 1024 + (ob ^ (((ob >> 9) & 1) << 5)); }
__host__ __device__ __forceinline__ void stage_rc(int b, int& R, int& C) { const int st = b / 1024, sb = b % 1024, swz = sb ^ (((sb >> 9) & 1) << 5); R = (st >> 1) * 16 + swz / 64; C = (st & 1) * 32 + (swz % 64) / 2; }
__host__ __device__ __forceinline__ int perm32(int rho) { const int n = rho >> 4, i = rho & 15; return 8 * (i >> 2) + 4 * n + (i & 3); }

struct Unit { int pm, pn; };
struct Gemm { const bf16_t* A; const bf16_t* Bt; int M, N, K; };

struct StaticOrder {
    int nM, nN, nwg, G, c;
    __host__ __device__ void init(int M, int N, int G_, int c_) { nM = M / BM; nN = N / BM; nwg = nM * nN; G = G_; c = c_; }
    __host__ __device__ bool next(int i, Unit& u) const {
        const long L = (long)i * G + c; if (L >= nwg) return false;
        int wgid = (int)L; { const int q = nwg / NXCD, r = nwg % NXCD, xcd = wgid % NXCD, off = wgid / NXCD; wgid = (xcd < r ? xcd * (q + 1) : r * (q + 1) + (xcd - r) * q) + off; }
        const int nig = WGM * nN, gid = wgid / nig, fm = gid * WGM, gsz = (nM - fm) < WGM ? (nM - fm) : WGM;
        u.pm = fm + ((wgid % nig) % gsz); u.pn = (wgid % nig) / gsz; return true;
    }
    __device__ __forceinline__ void a_ready(const Unit&) const {}
    __device__ __forceinline__ void done(const Unit&) const {}
};

typedef float f32x2 __attribute__((ext_vector_type(2)));
typedef __bf16 bf16x2_t __attribute__((ext_vector_type(2)));
__device__ __forceinline__ unsigned cvt_pk_bf16(float lo, float hi) { const f32x2 v = {lo, hi}; return __builtin_bit_cast(unsigned, __builtin_convertvector(v, bf16x2_t)); }
__device__ __forceinline__ int pg8_lane_id() { int l; asm volatile("v_mbcnt_lo_u32_b32 %0, -1, 0\n\tv_mbcnt_hi_u32_b32 %0, -1, %0" : "=v"(l)); return l; }
typedef unsigned u32x2 __attribute__((ext_vector_type(2)));
struct EpiPlainBf16 {
    static constexpr bool PERM = true, AFTER_DRAIN = false;
    bf16_t* O; int ldc;
    __device__ __forceinline__ void operator()(const f32x4 (&acc)[2][2][4][2], const Unit& u, int wr, int wc, int fr, int fq) const {
        asm volatile("" : "+v"(fr), "+v"(fq));
        const int row0 = u.pm * BM + wr * 64 + fr, col0 = u.pn * BM + wc * 32 + 8 * fq;
#pragma unroll
        for (int ai = 0; ai < 2; ++ai)
#pragma unroll
            for (int m = 0; m < 4; ++m) { bf16_t* rowp = O + (size_t)(row0 + ai * HALF + m * 16) * ldc + col0;
#pragma unroll
                for (int bj = 0; bj < 2; ++bj) { const f32x4 v0 = acc[ai][bj][m][0], v1 = acc[ai][bj][m][1];
                    u32x4 w; w.x = cvt_pk_bf16(v0[0], v0[1]); w.y = cvt_pk_bf16(v0[2], v0[3]); w.z = cvt_pk_bf16(v1[0], v1[1]); w.w = cvt_pk_bf16(v1[2], v1[3]);
                    *(u32x4*)(rowp + bj * HALF) = w; } }
    }
};
struct EpiKV {
    static constexpr bool PERM = true, AFTER_DRAIN = false;
    float* outK; float* outV; bf16_t* KB; bf16_t* VT; const float* ssq;
    __device__ __forceinline__ void operator()(const f32x4 (&acc)[2][2][4][2], const Unit& u, int wr, int wc, int fr, int fq) const {
        asm volatile("" : "+v"(fr), "+v"(fq));
        const bool isV = u.pn >= 4; const int h = u.pn & 3, b = u.pm;
        float* of = isV ? outV : outK;
        const int ct0 = wc * 32 + 8 * fq;
#pragma unroll
        for (int ai = 0; ai < 2; ++ai)
#pragma unroll
            for (int m = 0; m < 4; ++m) { const int key = ai * HALF + wr * 64 + m * 16 + fr; const float rs = rsqrtf(ssq[b * 256 + key] * (1.0f / 1024.0f) + 1e-6f);
#pragma unroll
                for (int bj = 0; bj < 2; ++bj) { const f32x4 v0 = acc[ai][bj][m][0] * rs, v1 = acc[ai][bj][m][1] * rs; const int ct = ct0 + bj * HALF;
                    float* fp = of + (size_t)(b * 256 + key) * 1024 + h * 256 + ct;
                    __builtin_nontemporal_store(v0, (f32x4*)fp); __builtin_nontemporal_store(v1, (f32x4*)(fp + 4));
                    if (!isV) { u32x4 w; w.x = cvt_pk_bf16(v0[0], v0[1]); w.y = cvt_pk_bf16(v0[2], v0[3]); w.z = cvt_pk_bf16(v1[0], v1[1]); w.w = cvt_pk_bf16(v1[2], v1[3]);
                        *(u32x4*)(KB + ((size_t)(b * 4 + h) * 256 + key) * 256 + ct) = w; }
                    else { const int kp = (key & ~31) | (((key >> 2) & 3) << 3) | (((key >> 4) & 1) << 2) | (key & 3);
                        bf16_t* vp = VT + ((size_t)(b * 4 + h) * 256 + ct) * 256 + kp;
#pragma unroll
                        for (int e = 0; e < 4; ++e) { vp[(size_t)e * 256] = (bf16_t)(cvt_pk_bf16(v0[e], 0.f) & 0xffffu); vp[(size_t)(e + 4) * 256] = (bf16_t)(cvt_pk_bf16(v1[e], 0.f) & 0xffffu); } }
                } }
    }
};
template <bool XB, bool SSQ, bool NTB = false> struct EpiRes {
    static constexpr bool PERM = false, AFTER_DRAIN = false;
    const float* base; float* out; bf16_t* xb; float* ssq;
    __device__ __forceinline__ void operator()(const f32x4 (&acc)[2][2][4][2], const Unit& u, int wr, int wc, int fr, int fq) const {
        asm volatile("" : "+v"(fr), "+v"(fq));
        const int col0 = u.pn * BM + wc * 32 + 4 * fq;
#pragma unroll
        for (int ai = 0; ai < 2; ++ai)
#pragma unroll
            for (int m = 0; m < 4; ++m) { const int r = u.pm * BM + ai * HALF + wr * 64 + m * 16 + fr; const size_t off = (size_t)r * 1024 + col0; float s = 0.f;
#pragma unroll
                for (int bj = 0; bj < 2; ++bj)
#pragma unroll
                    for (int n = 0; n < 2; ++n) { const f32x4 bs = NTB ? __builtin_nontemporal_load((const f32x4*)(base + off + bj * HALF + n * 16)) : *(const f32x4*)(base + off + bj * HALF + n * 16); const f32x4 o = bs + acc[ai][bj][m][n];
                        *(f32x4*)(out + off + bj * HALF + n * 16) = o;
                        if (SSQ) s += (o[0] * o[0] + o[1] * o[1]) + (o[2] * o[2] + o[3] * o[3]);
                        if (XB) { u32x2 w; w.x = cvt_pk_bf16(o[0], o[1]); w.y = cvt_pk_bf16(o[2], o[3]); *(u32x2*)(xb + off + bj * HALF + n * 16) = w; } }
                if (SSQ) { s += __shfl_xor(s, 16); s += __shfl_xor(s, 32); if (fq == 0) ssq[(size_t)r * 16 + u.pn * 4 + wc] = s; }
            }
    }
};
template <int MODE, int NPART = 16> struct EpiScale {
    static constexpr bool PERM = true, AFTER_DRAIN = false;
    bf16_t* O; int ldc; const float* ssq; float scale;
    __device__ __forceinline__ void operator()(const f32x4 (&acc)[2][2][4][2], const Unit& u, int wr, int wc, int fr, int fq) const {
        asm volatile("" : "+v"(fr), "+v"(fq));
        const int row0 = u.pm * BM + wr * 64 + fr, col0 = u.pn * BM + wc * 32 + 8 * fq;
#pragma unroll
        for (int ai = 0; ai < 2; ++ai)
#pragma unroll
            for (int m = 0; m < 4; ++m) { const int r = row0 + ai * HALF + m * 16; bf16_t* rowp = O + (size_t)r * ldc + col0;
                float tot;
                if (NPART == 16) { const f32x4* sp = (const f32x4*)(ssq + (size_t)r * 16); const f32x4 s0 = sp[0], s1 = sp[1], s2 = sp[2], s3 = sp[3];
                    tot = ((s0[0] + s0[1]) + (s0[2] + s0[3])) + ((s1[0] + s1[1]) + (s1[2] + s1[3])) + ((s2[0] + s2[1]) + (s2[2] + s2[3])) + ((s3[0] + s3[1]) + (s3[2] + s3[3])); }
                else tot = ssq[r];
                const float rs = rsqrtf(tot * (1.0f / 1024.0f) + 1e-6f) * (MODE == 0 ? scale : 1.0f);
#pragma unroll
                for (int bj = 0; bj < 2; ++bj) { f32x4 v0 = acc[ai][bj][m][0] * rs, v1 = acc[ai][bj][m][1] * rs;
                    if (MODE == 1) {
#pragma unroll
                        for (int e = 0; e < 4; ++e) { const float a0 = fmaxf(v0[e], 0.f), a1 = fmaxf(v1[e], 0.f); v0[e] = a0 * a0; v1[e] = a1 * a1; } }
                    u32x4 w; w.x = cvt_pk_bf16(v0[0], v0[1]); w.y = cvt_pk_bf16(v0[2], v0[3]); w.z = cvt_pk_bf16(v1[0], v1[1]); w.w = cvt_pk_bf16(v1[2], v1[3]);
                    *(u32x4*)(rowp + bj * HALF) = w; } }
    }
};

struct EpiResRms {
    static constexpr bool PERM = false, AFTER_DRAIN = true;
    const float* base; float* out; const float* gain; unsigned* xs; unsigned* cnt;
    __device__ __forceinline__ void fused(f32x4 (&acc)[2][2][4][2], const Unit& u, int wr, int wc, int fr, int fq, PG8_LAS unsigned char* lds, int wid, int lane) const {
        asm volatile("" : "+v"(fr), "+v"(fq));
        PG8_LAS float* P = (PG8_LAS float*)lds;
        PG8_LAS float* S = (PG8_LAS float*)(lds + 4096);
        const int col0 = u.pn * BM + wc * 32 + 4 * fq;
#pragma unroll
        for (int ai = 0; ai < 2; ++ai)
#pragma unroll
            for (int m = 0; m < 4; ++m) { const int r = ai * HALF + wr * 64 + m * 16 + fr; const size_t off = (size_t)(u.pm * BM + r) * 1024 + col0; float s = 0.f;
#pragma unroll
                for (int bj = 0; bj < 2; ++bj)
#pragma unroll
                    for (int n = 0; n < 2; ++n) { const f32x4 bs = *(const f32x4*)(base + off + bj * HALF + n * 16); const f32x4 o = bs + acc[ai][bj][m][n]; acc[ai][bj][m][n] = o;
                        s += (o[0] * o[0] + o[1] * o[1]) + (o[2] * o[2] + o[3] * o[3]); }
                s += __shfl_xor(s, 16); s += __shfl_xor(s, 32); if (fq == 0) P[r * 4 + wc] = s;
                if (m & 1) asm volatile("" ::: "memory"); }
        asm volatile("s_waitcnt lgkmcnt(0)" ::: "memory"); __builtin_amdgcn_s_barrier(); asm volatile("" ::: "memory");
        const int row = wid * 32 + (lane & 31);
        if (lane < 32) { const float t = (P[row * 4 + 0] + P[row * 4 + 1]) + (P[row * 4 + 2] + P[row * 4 + 3]);
            __hip_atomic_store(xs + (size_t)(u.pm * BM + row) * 4 + u.pn, __float_as_uint(t), __ATOMIC_RELAXED, __HIP_MEMORY_SCOPE_AGENT); }
        asm volatile("s_waitcnt vmcnt(0)" ::: "memory");
        if (lane == 0) __hip_atomic_fetch_add(cnt + 64 * u.pm, 1u, __ATOMIC_RELAXED, __HIP_MEMORY_SCOPE_AGENT);
        if (wid == 0) { unsigned spins = 0;
            while ((unsigned)__builtin_amdgcn_readfirstlane(__hip_atomic_load(cnt + 64 * u.pm, __ATOMIC_RELAXED, __HIP_MEMORY_SCOPE_AGENT)) < 32u) { __builtin_amdgcn_s_sleep(2); if (++spins > (1u << 22)) break; }
            __builtin_amdgcn_fence(__ATOMIC_ACQUIRE, "agent"); }
        asm volatile("s_waitcnt vmcnt(0) lgkmcnt(0)" ::: "memory"); __builtin_amdgcn_s_barrier(); asm volatile("" ::: "memory");
        if (lane < 32) { const unsigned* sl = xs + (size_t)(u.pm * BM + row) * 4; float t = 0.f;
#pragma unroll
            for (int q = 0; q < 4; ++q) t += __uint_as_float(__hip_atomic_load(sl + q, __ATOMIC_RELAXED, __HIP_MEMORY_SCOPE_AGENT));
            S[row] = rsqrtf(t * (1.0f / 1024.0f) + 1e-6f); }
        asm volatile("s_waitcnt lgkmcnt(0)" ::: "memory"); __builtin_amdgcn_s_barrier(); asm volatile("" ::: "memory");
        f32x4 gv[2][2];
#pragma unroll
        for (int bj = 0; bj < 2; ++bj)
#pragma unroll
            for (int n = 0; n < 2; ++n) gv[bj][n] = *(const f32x4*)(gain + col0 + bj * HALF + n * 16);
#pragma unroll
        for (int ai = 0; ai < 2; ++ai)
#pragma unroll
            for (int m = 0; m < 4; ++m) { const int r = ai * HALF + wr * 64 + m * 16 + fr; const float rs = S[r]; const size_t off = (size_t)(u.pm * BM + r) * 1024 + col0;
#pragma unroll
                for (int bj = 0; bj < 2; ++bj)
#pragma unroll
                    for (int n = 0; n < 2; ++n) __builtin_nontemporal_store(acc[ai][bj][m][n] * rs * gv[bj][n], (f32x4*)(out + off + bj * HALF + n * 16)); }
    }
};

template <class Epi, class Sched, bool ALIGN_EPI = false, bool SP2 = false>
__device__ __forceinline__ void gemm_phase(PG8_LAS unsigned char* lds, const int wave_in, const Gemm g, const Sched& S, const Epi& E) {
    const int wid = wave_in, lane = pg8_lane_id(), tid = wid * 64 + lane, wr = wid >> 2, wc = wid & 3, fr = lane & 15, fq = lane >> 4;
    const int K = g.K, nt = K / BK;
    unsigned voffA[2], voffB[2];
#pragma unroll
    for (int i = 0; i < 2; ++i) { int R, C; stage_rc(tid * 16 + i * 8192, R, C); const int Rb = Epi::PERM ? ((R & ~31) + perm32(R & 31)) : R;
        voffA[i] = (unsigned)(R * K + C) * 2u; voffB[i] = (unsigned)(Rb * K + C) * 2u; }
    const size_t kstep = (size_t)(BK * 2);
    const size_t hstep = (size_t)HALF * K * 2;
    const size_t tstep = 2 * hstep;
    const unsigned ldsw = (unsigned)wid * 1024u;
    const int aoff = lds_byte(wr * 64 + fr, fq * 8), boff = lds_byte(wc * 32 + fr, fq * 8);
#define PG8_SA(b, h) (((b) * 2 + (h)) * HTB)
#define PG8_SB(b, h) ((4 + (b) * 2 + (h)) * HTB)
#define PG8_STAGE(bufoff, gbase, voff) do { _Pragma("unroll") for (int _i = 0; _i < 2; ++_i) \
        __builtin_amdgcn_global_load_lds((const unsigned*)((const char*)(gbase) + (voff)[_i]), (PG8_LAS unsigned*)(lds + (bufoff) + ldsw + _i * 8192), 16, 0, 0); } while (0)
#define PG8_LDA(dst, b, h) do { _Pragma("unroll") for (int m = 0; m < 4; ++m) _Pragma("unroll") for (int k = 0; k < 2; ++k) dst[m][k] = *(const PG8_LAS bf16x8*)(lds + PG8_SA(b, h) + aoff + m * 2048 + k * 1024); } while (0)
#define PG8_LDB(dst, b, h) do { _Pragma("unroll") for (int n = 0; n < 2; ++n) _Pragma("unroll") for (int k = 0; k < 2; ++k) dst[n][k] = *(const PG8_LAS bf16x8*)(lds + PG8_SB(b, h) + boff + n * 2048 + k * 1024); } while (0)
#define PG8_MMA(ai, bj, At, Bt) do { __builtin_amdgcn_s_setprio(1); _Pragma("unroll") for (int m = 0; m < 4; ++m) _Pragma("unroll") for (int n = 0; n < 2; ++n) _Pragma("unroll") for (int k = 0; k < 2; ++k) \
        acc[ai][bj][m][n] = __builtin_amdgcn_mfma_f32_16x16x32_bf16(Bt[n][k], At[m][k], acc[ai][bj][m][n], 0, 0, 0); __builtin_amdgcn_s_setprio(0); } while (0)
#define PG8_WAIT_V(n) asm volatile("s_waitcnt vmcnt(" #n ")" ::: "memory")
#define PG8_WAIT_L(n) asm volatile("s_waitcnt lgkmcnt(" #n ")" ::: "memory")
#define PG8_BAR __builtin_amdgcn_s_barrier()
#define PG8_SCHED __builtin_amdgcn_sched_barrier(0)
    Unit cur, nxt; int ui = 0;
    if (!S.next(0, cur)) return;
    f32x4 acc[2][2][4][2];
#pragma unroll
    for (int a = 0; a < 2; ++a)
#pragma unroll
        for (int b = 0; b < 2; ++b)
#pragma unroll
            for (int m = 0; m < 4; ++m)
#pragma unroll
                for (int n = 0; n < 2; ++n) acc[a][b][m][n] = (f32x4){0.f, 0.f, 0.f, 0.f};
    bf16x8 At[4][2], B0[2][2], B1[2][2];
    const char* cA = (const char*)g.A + (size_t)cur.pm * tstep; const char* cB = (const char*)g.Bt + (size_t)cur.pn * tstep;
    S.a_ready(cur);
    if constexpr (SP2) {
        PG8_STAGE(PG8_SB(0, 0), cB, voffB); PG8_STAGE(PG8_SB(0, 1), cB + hstep, voffB); PG8_STAGE(PG8_SA(0, 0), cA, voffA); PG8_STAGE(PG8_SA(0, 1), cA + hstep, voffA);
        if (wr == 1) PG8_BAR;
        PG8_WAIT_V(2); PG8_BAR;
        PG8_STAGE(PG8_SB(1, 0), cB + kstep, voffB); PG8_STAGE(PG8_SA(1, 0), cA + kstep, voffA); PG8_STAGE(PG8_SB(1, 1), cB + hstep + kstep, voffB);
        PG8_WAIT_V(6); PG8_BAR;
    } else {
        PG8_STAGE(PG8_SB(0, 0), cB, voffB); PG8_STAGE(PG8_SA(0, 0), cA, voffA); PG8_STAGE(PG8_SB(0, 1), cB + hstep, voffB); PG8_STAGE(PG8_SA(0, 1), cA + hstep, voffA);
        if (wr == 1) PG8_BAR;
        PG8_WAIT_V(4); PG8_BAR;
        PG8_STAGE(PG8_SB(1, 0), cB + kstep, voffB); PG8_STAGE(PG8_SA(1, 0), cA + kstep, voffA); PG8_STAGE(PG8_SB(1, 1), cB + hstep + kstep, voffB);
        PG8_WAIT_V(6); PG8_BAR;
    }
    for (;;) {
        const bool has_next = S.next(ui + 1, nxt);
        const char* nA = has_next ? (const char*)g.A + (size_t)nxt.pm * tstep : cA; const char* nB = has_next ? (const char*)g.Bt + (size_t)nxt.pn * tstep : cB;
        for (int t = 0; t < nt; t += 2) {
            const bool last = (t == nt - 2);
            const char* a1 = cA + (size_t)(t + 1) * kstep;
            const char* a2 = last ? nA : cA + (size_t)(t + 2) * kstep; const char* b2 = last ? nB : cB + (size_t)(t + 2) * kstep;
            const char* a3 = a2 + kstep; const char* b3 = b2 + kstep;
            if (last && has_next) S.a_ready(nxt);
            if constexpr (SP2) {
            PG8_LDB(B0, 0, 0); PG8_LDB(B1, 0, 1); PG8_SCHED; PG8_LDA(At, 0, 0); PG8_STAGE(PG8_SA(1, 1), a1 + hstep, voffA);
            PG8_WAIT_V(8); PG8_WAIT_L(0); PG8_BAR; PG8_MMA(0, 0, At, B0); PG8_MMA(0, 1, At, B1); PG8_BAR; PG8_SCHED;
            PG8_LDA(At, 0, 1); PG8_STAGE(PG8_SB(0, 0), b2, voffB); PG8_STAGE(PG8_SB(0, 1), b2 + hstep, voffB); PG8_STAGE(PG8_SA(0, 0), a2, voffA);
            PG8_WAIT_V(8); PG8_WAIT_L(0); PG8_BAR; PG8_MMA(1, 0, At, B0); PG8_MMA(1, 1, At, B1); PG8_BAR; PG8_SCHED;
            PG8_LDB(B0, 1, 0); PG8_LDB(B1, 1, 1); PG8_SCHED; PG8_LDA(At, 1, 0); PG8_STAGE(PG8_SA(0, 1), a2 + hstep, voffA);
            PG8_WAIT_V(8); PG8_WAIT_L(0); PG8_BAR; PG8_MMA(0, 0, At, B0); PG8_MMA(0, 1, At, B1); PG8_BAR; PG8_SCHED;
            PG8_LDA(At, 1, 1); PG8_STAGE(PG8_SB(1, 0), b3, voffB); PG8_STAGE(PG8_SB(1, 1), b3 + hstep, voffB); PG8_STAGE(PG8_SA(1, 0), a3, voffA);
            PG8_WAIT_V(8); PG8_WAIT_L(0); PG8_BAR; PG8_MMA(1, 0, At, B0); PG8_MMA(1, 1, At, B1); PG8_BAR; PG8_SCHED;
            } else {
            PG8_LDB(B0, 0, 0); PG8_SCHED; PG8_LDA(At, 0, 0); PG8_STAGE(PG8_SA(1, 1), a1 + hstep, voffA);
            PG8_WAIT_L(8); PG8_BAR; PG8_WAIT_L(0); PG8_MMA(0, 0, At, B0); PG8_BAR; PG8_SCHED;
            PG8_LDB(B1, 0, 1); PG8_STAGE(PG8_SB(0, 0), b2, voffB);
            PG8_BAR; PG8_WAIT_L(0); PG8_MMA(0, 1, At, B1); PG8_BAR;
            PG8_LDA(At, 0, 1); PG8_STAGE(PG8_SA(0, 0), a2, voffA);
            PG8_BAR; PG8_WAIT_L(0); PG8_MMA(1, 0, At, B0); PG8_BAR; PG8_SCHED;
            PG8_STAGE(PG8_SB(0, 1), b2 + hstep, voffB);
            PG8_WAIT_V(6); PG8_BAR; PG8_MMA(1, 1, At, B1); PG8_BAR;
            PG8_LDB(B0, 1, 0); PG8_SCHED; PG8_LDA(At, 1, 0); PG8_STAGE(PG8_SA(0, 1), a2 + hstep, voffA);
            PG8_WAIT_L(8); PG8_BAR; PG8_WAIT_L(0); PG8_MMA(0, 0, At, B0); PG8_BAR; PG8_SCHED;
            PG8_LDB(B1, 1, 1); PG8_STAGE(PG8_SB(1, 0), b3, voffB);
            PG8_BAR; PG8_WAIT_L(0); PG8_MMA(0, 1, At, B1); PG8_BAR;
            PG8_LDA(At, 1, 1); PG8_STAGE(PG8_SA(1, 0), a3, voffA);
            PG8_BAR; PG8_WAIT_L(0); PG8_MMA(1, 0, At, B0); PG8_BAR; PG8_SCHED;
            PG8_STAGE(PG8_SB(1, 1), b3 + hstep, voffB);
            PG8_WAIT_V(6); PG8_BAR; PG8_MMA(1, 1, At, B1); PG8_BAR;
            }
        }
        if constexpr (ALIGN_EPI) { if (wr == 0) PG8_BAR; }
        if constexpr (!Epi::AFTER_DRAIN) { E(acc, cur, wr, wc, fr, fq); S.done(cur); }
        if (!has_next) break;
#pragma unroll
        for (int a = 0; a < 2; ++a)
#pragma unroll
            for (int b = 0; b < 2; ++b)
#pragma unroll
                for (int m = 0; m < 4; ++m)
#pragma unroll
                    for (int n = 0; n < 2; ++n) acc[a][b][m][n] = (f32x4){0.f, 0.f, 0.f, 0.f};
        cur = nxt; cA = nA; cB = nB; ++ui;
        if constexpr (ALIGN_EPI) { if (wr == 1) PG8_BAR; }
    }
    PG8_WAIT_V(0);
    if constexpr (!ALIGN_EPI) { if (wr == 0) PG8_BAR; }
    PG8_BAR;
    if constexpr (Epi::AFTER_DRAIN) { E.fused(acc, cur, wr, wc, fr, fq, lds, wid, lane); S.done(cur); }
#undef PG8_SA
#undef PG8_SB
#undef PG8_STAGE
#undef PG8_LDA
#undef PG8_LDB
#undef PG8_MMA
#undef PG8_WAIT_V
#undef PG8_WAIT_L
#undef PG8_BAR
#undef PG8_SCHED
}
}
constexpr int NWAVES = 8;
constexpr int DM = 1024, MP = 16384, SEQ = 2048, NB = 8, MS = 128;
constexpr int INC = 2064, INP = 2048;
constexpr int C_Q = 512, C_K = 768, C_V = 1024, C_G = 1536, C_F = 2048;
constexpr int FF = 4096;
constexpr float EPS = 1e-6f;
constexpr size_t O_YP = 0, O_YS = 16777216, O_SPP = O_YS + 131072, O_SGP = O_SPP + 61440, O_KP = O_SGP + 262144, O_VP = O_KP + 2097152, O_SPS = O_VP + 2097152, O_SGS = O_SPS + 983040;
constexpr size_t MiB = 1u << 20;
constexpr size_t WS_WIN = 2 * MiB, WS_WKV = 8 * MiB, WS_WOUT = 12 * MiB, WS_WQM = 14 * MiB, WS_WOM = 16 * MiB, WS_WUP = 18 * MiB, WS_WDN = 26 * MiB;
constexpr size_t WS_MN = 34 * MiB, WS_KB = 38 * MiB, WS_VT = 42 * MiB, WS_SSQ1 = 46 * MiB, WS_SSQ2 = 47 * MiB, WS_SSQ0 = 48 * MiB  , WS_FLOW = 58 * MiB  ;
constexpr size_t WS_PROJS = 49 * MiB  , WS_MIXS = 51 * MiB  , WS_QS = 52 * MiB, WS_CTXS = 53 * MiB, WS_HFFS = 54 * MiB  , WS_PARTS = 56 * MiB  ;
constexpr size_t WS_H = 64 * MiB  , WS_XB = 96 * MiB, WS_Q = 128 * MiB, WS_CTX = 160 * MiB;
constexpr size_t WS_PROJ = 192 * MiB  , WS_GL = 264 * MiB  , WS_CUM = 296 * MiB  , WS_ST = 312 * MiB  ;
constexpr size_t WS_HFF = 192 * MiB  ;
constexpr size_t WS_END = 328 * MiB;
constexpr int LDS_BYTES = 147456;

#define LAS __attribute__((address_space(3)))
typedef unsigned short bf16;
typedef unsigned u32x4 __attribute__((ext_vector_type(4)));
typedef unsigned u32x2 __attribute__((ext_vector_type(2)));
typedef float f32x4 __attribute__((ext_vector_type(4)));
typedef short bf16x8 __attribute__((ext_vector_type(8)));
typedef short bf16x4 __attribute__((ext_vector_type(4)));
#define LDS_WAIT() asm volatile("s_waitcnt lgkmcnt(0)" ::: "memory")
__device__ __forceinline__ unsigned pk2(float lo, float hi) { return pg8::cvt_pk_bf16(lo, hi); }
__device__ __forceinline__ float bf2f(unsigned short h) { return __uint_as_float((unsigned)h << 16); }
__device__ __forceinline__ float bflo(unsigned w) { return __uint_as_float(w << 16); }
__device__ __forceinline__ float bfhi(unsigned w) { return __uint_as_float(w & 0xffff0000u); }
__device__ __forceinline__ float wave_sum(float v) {
#pragma unroll
    for (int o = 1; o < 64; o <<= 1) v += __shfl_xor(v, o);
    return v;
}
__device__ __forceinline__ float wave_max(float v) {
#pragma unroll
    for (int o = 1; o < 64; o <<= 1) v = fmaxf(v, __shfl_xor(v, o));
    return v;
}
__device__ __forceinline__ float logsig(float x) { return fminf(x, 0.f) - log1pf(__expf(-fabsf(x))); }
__device__ __forceinline__ float silu(float x) { return x / (1.f + __expf(-x)); }
__device__ __forceinline__ f32x4 mfma16(bf16x8 a, bf16x8 b, f32x4 c) { return __builtin_amdgcn_mfma_f32_16x16x32_bf16(a, b, c, 0, 0, 0); }

struct Frame {
    LAS unsigned char* lds;
    int wave, G, blk;
    const float* in[25]; float* out; unsigned char* ws;
};
#define WSP(T, off) ((T*)(F.ws + (off)))

__device__ __forceinline__ void rows16_pass(const float* X, bf16* XB16, float* ssq, float* FL, const LAS bf16* Wf, int row0, int lane) {
    const int r = lane & 15, q = lane >> 4;
    const float* xp = X + (size_t)(row0 + r) * DM + q * 8; bf16* hp = XB16 + (size_t)(row0 + r) * DM + q * 8;
    f32x4 acc = {0.f, 0.f, 0.f, 0.f}; float ss = 0.f;
#pragma unroll 1
    for (int c0 = 0; c0 < 32; c0 += 8) { f32x4 a[16];
#pragma unroll
        for (int u = 0; u < 8; ++u) { a[2 * u] = __builtin_nontemporal_load((const f32x4*)(xp + (c0 + u) * 32)); a[2 * u + 1] = __builtin_nontemporal_load((const f32x4*)(xp + (c0 + u) * 32 + 4)); }
#pragma unroll
        for (int u = 0; u < 8; ++u) { const f32x4 a0 = a[2 * u], a1 = a[2 * u + 1];
            ss += ((a0[0] * a0[0] + a0[1] * a0[1]) + (a0[2] * a0[2] + a0[3] * a0[3])) + ((a1[0] * a1[0] + a1[1] * a1[1]) + (a1[2] * a1[2] + a1[3] * a1[3]));
            u32x4 aw; aw.x = pk2(a0[0], a0[1]); aw.y = pk2(a0[2], a0[3]); aw.z = pk2(a1[0], a1[1]); aw.w = pk2(a1[2], a1[3]);
            *(u32x4*)(hp + (c0 + u) * 32) = aw;
            if (FL) { const bf16x8 wfr = *(const LAS bf16x8*)(Wf + r * 1032 + (c0 + u) * 32 + q * 8); acc = mfma16(wfr, __builtin_bit_cast(bf16x8, aw), acc); } } }
    ss += __shfl_xor(ss, 16); ss += __shfl_xor(ss, 32);
    if (q == 0) ssq[row0 + r] = ss;
    if (FL) { acc = acc * rsqrtf(ss * (1.f / DM) + EPS); *(f32x4*)(FL + (size_t)(row0 + r) * 16 + q * 4) = acc; }
}
__device__ __forceinline__ void p0_prologue(const Frame& F) {
    const int lane = pg8::pg8_lane_id(), tid = F.wave * 64 + lane; (void)tid;
    LAS bf16* Wf = (LAS bf16*)(F.lds + 98304);
    { const float* win = F.in[8]; const float* gm = F.in[7];
#pragma unroll
      for (int kk = 0; kk < 2; ++kk) { const int k = tid * 2 + kk; const float g = gm[k]; const f32x4* wr = (const f32x4*)(win + (size_t)k * INC + 2048);
#pragma unroll
          for (int j4 = 0; j4 < 4; ++j4) { const f32x4 w = wr[j4];
#pragma unroll
              for (int e = 0; e < 4; ++e) Wf[(j4 * 4 + e) * 1032 + k] = (bf16)(pk2(w[e] * g, 0.f) & 0xffffu); } } }
    __syncthreads();
    { const float* wp = F.in[11]; const float* ps = F.in[12]; const float* wo = F.in[14]; bf16* wt = WSP(bf16, WS_WOUT);
      LAS float* Wp = (LAS float*)F.lds; LAS float* Wo = (LAS float*)(F.lds + 65536);
      for (int it = F.blk; it < 64; it += F.G) { const int g = it >> 4, n0 = (it & 15) * 64;
#pragma unroll
          for (int i = 0; i < 8; ++i) { const int i4 = (i * 512 + tid) * 4; *(LAS f32x4*)(Wp + i4) = *(const f32x4*)(wp + (size_t)g * 16384 + i4); }
#pragma unroll
          for (int i = 0; i < 16; ++i) { const int e = i * 512 + tid, d = e >> 6, nn = e & 63; Wo[e] = wo[(size_t)(g * 128 + d) * DM + n0 + nn] * ps[g * 128 + d]; }
          __syncthreads();
          const int n = tid & 63; float acc[16];
#pragma unroll
          for (int ci = 0; ci < 16; ++ci) acc[ci] = 0.f;
#pragma unroll 2
          for (int d4 = 0; d4 < 32; ++d4) { const float a0 = Wo[(d4 * 4 + 0) * 64 + n], a1 = Wo[(d4 * 4 + 1) * 64 + n], a2 = Wo[(d4 * 4 + 2) * 64 + n], a3 = Wo[(d4 * 4 + 3) * 64 + n];
#pragma unroll
              for (int ci = 0; ci < 16; ++ci) { const f32x4 w4 = *(const LAS f32x4*)(Wp + (F.wave * 16 + ci) * 128 + d4 * 4); acc[ci] += (w4[0] * a0 + w4[1] * a1) + (w4[2] * a2 + w4[3] * a3); } }
          u32x4* dst = (u32x4*)(wt + (size_t)(n0 + n) * DM + g * 128 + F.wave * 16);
          dst[0] = (u32x4){pk2(acc[0], acc[1]), pk2(acc[2], acc[3]), pk2(acc[4], acc[5]), pk2(acc[6], acc[7])};
          dst[1] = (u32x4){pk2(acc[8], acc[9]), pk2(acc[10], acc[11]), pk2(acc[12], acc[13]), pk2(acc[14], acc[15])};
          __syncthreads(); } }
    const int gw = F.blk * NWAVES + F.wave, NGW = F.G * NWAVES;
    { constexpr int I_IN = 8 * 9, I_SQ = 8 * 4, I_OUT = 4 * 4, I_UP = 8 * 16, I_DN = 32 * 4;
      constexpr int NITEMS = I_IN + 2 * I_SQ + I_OUT + 2 * I_SQ + I_UP + I_DN;
      LAS bf16* T = (LAS bf16*)F.lds;
      for (int it = (F.blk + 192) % F.G; it < NITEMS; it += F.G) {
        int r = it; const float* W; const float* gain = nullptr; bf16* WT; int ldw, nreal, ldt = DM, row_off = 0, nb = 4, kofs = 0;
        if (r < I_IN) { W = F.in[8]; ldw = INC; nreal = INC; WT = WSP(bf16, WS_WIN); gain = F.in[7]; nb = 9; }
        else if ((r -= I_IN) < I_SQ) { W = F.in[16]; ldw = DM; nreal = DM; WT = WSP(bf16, WS_WKV); gain = F.in[15]; }
        else if ((r -= I_SQ) < I_SQ) { W = F.in[17]; ldw = DM; nreal = DM; WT = WSP(bf16, WS_WKV); gain = F.in[15]; row_off = DM; }
        else if ((r -= I_SQ) < I_OUT) { W = F.in[14]; ldw = DM; nreal = DM; WT = WSP(bf16, WS_WOUT); kofs = 512; }
        else if ((r -= I_OUT) < I_SQ) { W = F.in[19]; ldw = DM; nreal = DM; WT = WSP(bf16, WS_WQM); gain = F.in[18]; }
        else if ((r -= I_SQ) < I_SQ) { W = F.in[20]; ldw = DM; nreal = DM; WT = WSP(bf16, WS_WOM); }
        else if ((r -= I_SQ) < I_UP) { W = F.in[22]; ldw = FF; nreal = FF; WT = WSP(bf16, WS_WUP); gain = F.in[21]; nb = 16; }
        else { r -= I_UP; W = F.in[23]; ldw = DM; nreal = DM; WT = WSP(bf16, WS_WDN); ldt = FF; }
        const int k0 = kofs + 128 * (r / nb), n0 = 256 * (r % nb);
        f32x4 tv[16];
#pragma unroll
        for (int i = 0; i < 16; ++i) { const int idx = i * 512 + tid, kk = idx >> 6, n = n0 + (idx & 63) * 4;
            tv[i] = (f32x4){0.f, 0.f, 0.f, 0.f}; if (n < nreal) tv[i] = __builtin_nontemporal_load((const f32x4*)(W + (size_t)(k0 + kk) * ldw + n)); }
#pragma unroll
        for (int i = 0; i < 16; ++i) { const int idx = i * 512 + tid, kk = idx >> 6; const float g = gain ? gain[k0 + kk] : 1.f; const f32x4 v = tv[i] * g;
            u32x2 o; o.x = pk2(v[0], v[1]); o.y = pk2(v[2], v[3]); *(LAS u32x2*)(T + kk * 256 + (idx & 63) * 4) = o; }
        __syncthreads();
        { const int n = tid & 255;
#pragma unroll
          for (int i = 0; i < 8; ++i) { const int kg = (tid >> 8) + 2 * i; const LAS bf16* tp = T + (kg * 8) * 256 + n;
              u32x4 o; o.x = tp[0] | ((unsigned)tp[256] << 16); o.y = tp[512] | ((unsigned)tp[768] << 16); o.z = tp[1024] | ((unsigned)tp[1280] << 16); o.w = tp[1536] | ((unsigned)tp[1792] << 16);
              *(u32x4*)(WT + (size_t)(row_off + n0 + n) * ldt + k0 + kg * 8) = o; } }
        __syncthreads();
      } }
    for (int it = gw; it < MP / 16 + (NB * 256) / 16; it += NGW) {
        if (it < MP / 16) rows16_pass(F.in[0], WSP(bf16, WS_H), WSP(float, WS_SSQ0), WSP(float, WS_FLOW), Wf, it * 16, lane);
        else rows16_pass(F.in[6], WSP(bf16, WS_MN), WSP(float, WS_SSQ0) + MP, nullptr, Wf, (it - MP / 16) * 16, lane); }
}

template <bool NORM, class Epi>
__device__ __forceinline__ void skinny_gemm(const Frame& F, const float* A, int lda, const bf16* Bt, int ldb, int K, int nslab, int ksplit, const Epi& E) {
    const int lane = pg8::pg8_lane_id(), tid = F.wave * 64 + lane; (void)tid;
    const int fr = lane & 15, fq = lane >> 4;
    for (int item = F.blk; item < nslab * ksplit; item += F.G) {
        const int slab = item % nslab, ks = item / nslab;
        const float* ap = A + (size_t)(F.wave * 16 + fr) * lda + (size_t)ks * K + fq * 8;
        const bf16* bp = Bt + (size_t)(slab * 16 + fr) * ldb + (size_t)ks * K + fq * 8;
        f32x4 acc = {0.f, 0.f, 0.f, 0.f}; float ss = 0.f;
#pragma unroll 1
        for (int k0 = 0; k0 < K; k0 += 256) {
            f32x4 a[16]; bf16x8 b[8];
#pragma unroll
            for (int u = 0; u < 8; ++u) { a[2 * u] = *(const f32x4*)(ap + k0 + u * 32); a[2 * u + 1] = *(const f32x4*)(ap + k0 + u * 32 + 4); b[u] = *(const bf16x8*)(bp + k0 + u * 32); }
#pragma unroll
            for (int u = 0; u < 8; ++u) { const f32x4 a0 = a[2 * u], a1 = a[2 * u + 1];
                if (NORM) ss += ((a0[0] * a0[0] + a0[1] * a0[1]) + (a0[2] * a0[2] + a0[3] * a0[3])) + ((a1[0] * a1[0] + a1[1] * a1[1]) + (a1[2] * a1[2] + a1[3] * a1[3]));
                u32x4 aw; aw.x = pk2(a0[0], a0[1]); aw.y = pk2(a0[2], a0[3]); aw.z = pk2(a1[0], a1[1]); aw.w = pk2(a1[2], a1[3]);
                acc = mfma16(b[u], __builtin_bit_cast(bf16x8, aw), acc); }
        }
        if (NORM) { ss += __shfl_xor(ss, 16); ss += __shfl_xor(ss, 32); acc = acc * rsqrtf(ss / (float)K + EPS); }
        E(F.wave * 16 + fr, slab * 16 + fq * 4, ks, acc);
    }
}
struct SEpiStore { float* O; int ldc; float scale; __device__ __forceinline__ void operator()(int row, int col, int, f32x4 v) const { *(f32x4*)(O + (size_t)row * ldc + col) = v * scale; } };
struct SEpiPart  { float* O; __device__ __forceinline__ void operator()(int row, int col, int ks, f32x4 v) const { *(f32x4*)(O + ((size_t)ks * MS + row) * DM + col) = v; } };
struct SEpiRes   { const float* base; float* O; __device__ __forceinline__ void operator()(int row, int col, int, f32x4 v) const { const f32x4 b = *(const f32x4*)(base + (size_t)row * DM + col); *(f32x4*)(O + (size_t)row * DM + col) = b + v; } };
struct SEpiRelu2 { float* O; __device__ __forceinline__ void operator()(int row, int col, int, f32x4 v) const { f32x4 o;
#pragma unroll
    for (int e = 0; e < 4; ++e) { const float a = fmaxf(v[e], 0.f); o[e] = a * a; } *(f32x4*)(O + (size_t)row * FF + col) = o; } };
__device__ __forceinline__ void p2_pool_prompt(const Frame& F) {
    const bf16* proj = WSP(const bf16, WS_PROJ); bf16* mixed = WSP(bf16, WS_H);
    const int lane = pg8::pg8_lane_id(), tid = F.wave * 64 + lane; (void)tid;
    const int c8 = lane * 8, g = lane >> 4, w = 2 << g;
    for (int it = F.blk; it < MP / 64; it += F.G) {
        const int row0 = it * 64 + F.wave * 8, t0 = row0 & (SEQ - 1), b = row0 >> 11;
        u32x4 rw[23];
#pragma unroll
        for (int i = 0; i < 23; ++i) { rw[i] = (u32x4){0u, 0u, 0u, 0u}; if (t0 + i - 15 >= 0) rw[i] = *(const u32x4*)(proj + (size_t)(row0 + i - 15) * INP + c8); }
        float cs[23][8];
#pragma unroll
        for (int i = 0; i < 23; ++i) { const float u[8] = {bflo(rw[i].x), bfhi(rw[i].x), bflo(rw[i].y), bfhi(rw[i].y), bflo(rw[i].z), bfhi(rw[i].z), bflo(rw[i].w), bfhi(rw[i].w)};
#pragma unroll
            for (int e2 = 0; e2 < 8; ++e2) cs[i][e2] = (i ? cs[i - 1][e2] : 0.f) + u[e2]; }
#pragma unroll
        for (int i = 0; i < 8; ++i) { const int t = t0 + i, cnt = (t + 1 < w) ? (t + 1) : w; const float inv = 1.f / (float)cnt; float o[8]; const u32x4 ur = rw[15 + i]; const float un[8] = {bflo(ur.x), bfhi(ur.x), bflo(ur.y), bfhi(ur.y), bflo(ur.z), bfhi(ur.z), bflo(ur.w), bfhi(ur.w)};
#pragma unroll
            for (int e2 = 0; e2 < 8; ++e2) { const float lo2 = cs[15 + i - 2][e2], lo4 = cs[15 + i - 4][e2], lo8 = cs[15 + i - 8][e2], lo16 = (i ? cs[i - 1][e2] : 0.f);
                const float lo = (g == 0) ? lo2 : (g == 1) ? lo4 : (g == 2) ? lo8 : lo16;
                o[e2] = (cs[15 + i][e2] - lo) * inv - un[e2]; }
            u32x4 ov; ov.x = pk2(o[0], o[1]); ov.y = pk2(o[2], o[3]); ov.z = pk2(o[4], o[5]); ov.w = pk2(o[6], o[7]);
            *(u32x4*)(mixed + (size_t)(row0 + i) * DM + c8) = ov;
            if (t >= SEQ - 15) { float* sp = F.out + O_SPP + ((size_t)b * 15 + (t - (SEQ - 15))) * 512 + c8; *(f32x4*)sp = (f32x4){un[0], un[1], un[2], un[3]}; *(f32x4*)(sp + 4) = (f32x4){un[4], un[5], un[6], un[7]}; } }
    }
}
__device__ __forceinline__ void p2_gla_local(const Frame& F) {
    const bf16* proj = WSP(const bf16, WS_PROJ); float* GL = WSP(float, WS_GL); float* CUM = WSP(float, WS_CUM);
    LAS float* fl = (LAS float*)(F.lds);
    LAS float* segt = (LAS float*)(F.lds + 4096);
    LAS bf16* Aop = (LAS bf16*)(F.lds + 8192);
    LAS bf16* Bop = (LAS bf16*)(F.lds + 8192 + 9216);
    const int lane = pg8::pg8_lane_id(), tid = F.wave * 64 + lane; const int wave = F.wave, fr = lane & 15, fq = lane >> 4;
    for (int unit = F.blk; unit < 1024; unit += F.G) {
        const int b = unit >> 7, n = (unit >> 2) & 31, h = unit & 3; const size_t r0 = (size_t)b * SEQ + n * 64;
        for (int e = tid; e < 1024; e += 512) fl[e] = WSP(const float, WS_FLOW)[r0 * 16 + e];
        const int d = tid & 63, seg = tid >> 6;
        float wf[16];
#pragma unroll
        for (int r = 0; r < 16; ++r) wf[r] = F.in[9][r * 256 + h * 64 + d];
        const float bias = F.in[10][h * 64 + d];
        __syncthreads();
        float cum[8]; float run = 0.f;
#pragma unroll
        for (int i = 0; i < 8; ++i) { const int t = seg * 8 + i; float pre = bias;
#pragma unroll
            for (int r = 0; r < 16; ++r) pre += fl[t * 16 + r] * wf[r];
            run += logsig(pre) * (1.f / 16.f); cum[i] = run; }
        segt[seg * 64 + d] = run;
        __syncthreads();
        float pre_s = 0.f, tot = 0.f;
#pragma unroll
        for (int s2 = 0; s2 < 8; ++s2) { const float v = segt[s2 * 64 + d]; tot += v; if (s2 < seg) pre_s += v; }
        float ke[8];
#pragma unroll
        for (int i = 0; i < 8; ++i) { const int t = seg * 8 + i; cum[i] += pre_s; CUM[(size_t)unit * 4096 + t * 64 + d] = cum[i];
            ke[i] = bf2f(proj[(r0 + t) * INP + C_K + h * 64 + d]) * __expf(tot - cum[i]); }
        { u32x4 o; o.x = pk2(ke[0], ke[1]); o.y = pk2(ke[2], ke[3]); o.z = pk2(ke[4], ke[5]); o.w = pk2(ke[6], ke[7]); *(LAS u32x4*)(Aop + d * 72 + seg * 8) = o; }
        { const int dv = tid & 127, ts = tid >> 7; unsigned short vv[16];
#pragma unroll
          for (int i = 0; i < 16; ++i) vv[i] = proj[(r0 + ts * 16 + i) * INP + C_V + h * 128 + dv];
          u32x4 o0, o1; o0.x = vv[0] | ((unsigned)vv[1] << 16); o0.y = vv[2] | ((unsigned)vv[3] << 16); o0.z = vv[4] | ((unsigned)vv[5] << 16); o0.w = vv[6] | ((unsigned)vv[7] << 16);
          o1.x = vv[8] | ((unsigned)vv[9] << 16); o1.y = vv[10] | ((unsigned)vv[11] << 16); o1.z = vv[12] | ((unsigned)vv[13] << 16); o1.w = vv[14] | ((unsigned)vv[15] << 16);
          *(LAS u32x4*)(Bop + dv * 72 + ts * 16) = o0; *(LAS u32x4*)(Bop + dv * 72 + ts * 16 + 8) = o1; }
        __syncthreads();
        const int mi = wave & 3;
#pragma unroll
        for (int jj = 0; jj < 4; ++jj) { const int nj = (wave >> 2) * 4 + jj; f32x4 acc = {0.f, 0.f, 0.f, 0.f};
#pragma unroll
            for (int ks = 0; ks < 2; ++ks) { const bf16x8 a = *(const LAS bf16x8*)(Aop + (mi * 16 + fr) * 72 + ks * 32 + fq * 8); const bf16x8 bb = *(const LAS bf16x8*)(Bop + (nj * 16 + fr) * 72 + ks * 32 + fq * 8);
                acc = mfma16(bb, a, acc); }
            *(f32x4*)(GL + (size_t)unit * 8192 + (mi * 16 + fr) * 128 + nj * 16 + fq * 4) = acc; }
        __syncthreads();
    }
}
__device__ __forceinline__ void p3_gla_scan(const Frame& F) {
    const float* GL = WSP(const float, WS_GL); const float* CUM = WSP(const float, WS_CUM); bf16* ST = WSP(bf16, WS_ST);
    const int lane = pg8::pg8_lane_id(), tid = F.wave * 64 + lane; (void)tid;
    for (int e = F.blk * 512 + tid; e < 65536; e += F.G * 512) {
        const int dv = e & 127, dg = (e >> 7) & 15, bh = e >> 11, b = bh >> 2, h = bh & 3;
        float S[4] = {0.f, 0.f, 0.f, 0.f};
#pragma unroll 8
        for (int n = 0; n < 32; ++n) { const size_t unit = (size_t)(b * 32 + n) * 4 + h;
            const f32x4 cl = *(const f32x4*)(CUM + unit * 4096 + 63 * 64 + dg * 4);
            float Lv[4];
#pragma unroll
            for (int i = 0; i < 4; ++i) Lv[i] = __builtin_nontemporal_load(GL + unit * 8192 + (dg * 4 + i) * 128 + dv);
            u32x2 o; o.x = pk2(S[0], S[1]); o.y = pk2(S[2], S[3]); *(u32x2*)(ST + unit * 8192 + dv * 64 + dg * 4) = o;
#pragma unroll
            for (int i = 0; i < 4; ++i) S[i] = __expf(cl[i]) * S[i] + Lv[i]; }
#pragma unroll
        for (int i = 0; i < 4; ++i) F.out[O_SGP + ((size_t)(b * 4 + h) * 64 + dg * 4 + i) * 128 + dv] = S[i];
    }
}
__device__ __forceinline__ void p4_gla_out(const Frame& F) {
    const bf16* proj = WSP(const bf16, WS_PROJ); const float* CUM = WSP(const float, WS_CUM); const bf16* ST = WSP(const bf16, WS_ST); bf16* mixed = WSP(bf16, WS_H);
    LAS bf16* Aq = (LAS bf16*)(F.lds);
    LAS bf16* Bk = (LAS bf16*)(F.lds + 9216);
    LAS bf16* Bv = (LAS bf16*)(F.lds + 18432);
    LAS bf16* Bs = (LAS bf16*)(F.lds + 36864);
    LAS bf16* Ap = (LAS bf16*)(F.lds + 55296);
    LAS float* red = (LAS float*)(F.lds + 64512);
    const int lane = pg8::pg8_lane_id(), tid = F.wave * 64 + lane; const int wave = F.wave, fr = lane & 15, fq = lane >> 4;
    for (int unit = F.blk; unit < 1024; unit += F.G) {
        const int b = unit >> 7, n = (unit >> 2) & 31, h = unit & 3; const size_t r0 = (size_t)b * SEQ + n * 64;
        { const int t = tid >> 3, d8 = (tid & 7) * 8;
          const f32x4 c0 = *(const f32x4*)(CUM + (size_t)unit * 4096 + t * 64 + d8), c1 = *(const f32x4*)(CUM + (size_t)unit * 4096 + t * 64 + d8 + 4);
          const u32x4 qw = *(const u32x4*)(proj + (r0 + t) * INP + C_Q + h * 64 + d8), kw = *(const u32x4*)(proj + (r0 + t) * INP + C_K + h * 64 + d8);
          float cu[8] = {c0[0], c0[1], c0[2], c0[3], c1[0], c1[1], c1[2], c1[3]};
          float qv[8] = {bflo(qw.x), bfhi(qw.x), bflo(qw.y), bfhi(qw.y), bflo(qw.z), bfhi(qw.z), bflo(qw.w), bfhi(qw.w)};
          float kv[8] = {bflo(kw.x), bfhi(kw.x), bflo(kw.y), bfhi(kw.y), bflo(kw.z), bfhi(kw.z), bflo(kw.w), bfhi(kw.w)};
#pragma unroll
          for (int e = 0; e < 8; ++e) { const float ex = __expf(cu[e]); qv[e] = qv[e] * 0.125f * ex; kv[e] = kv[e] / ex; }
          u32x4 o; o.x = pk2(qv[0], qv[1]); o.y = pk2(qv[2], qv[3]); o.z = pk2(qv[4], qv[5]); o.w = pk2(qv[6], qv[7]); *(LAS u32x4*)(Aq + t * 72 + d8) = o;
          o.x = pk2(kv[0], kv[1]); o.y = pk2(kv[2], kv[3]); o.z = pk2(kv[4], kv[5]); o.w = pk2(kv[6], kv[7]); *(LAS u32x4*)(Bk + t * 72 + d8) = o; }
        { const int dv = tid & 127, ts = tid >> 7; unsigned short vv[16];
#pragma unroll
          for (int i = 0; i < 16; ++i) vv[i] = proj[(r0 + ts * 16 + i) * INP + C_V + h * 128 + dv];
          u32x4 o0, o1; o0.x = vv[0] | ((unsigned)vv[1] << 16); o0.y = vv[2] | ((unsigned)vv[3] << 16); o0.z = vv[4] | ((unsigned)vv[5] << 16); o0.w = vv[6] | ((unsigned)vv[7] << 16);
          o1.x = vv[8] | ((unsigned)vv[9] << 16); o1.y = vv[10] | ((unsigned)vv[11] << 16); o1.z = vv[12] | ((unsigned)vv[13] << 16); o1.w = vv[14] | ((unsigned)vv[15] << 16);
          *(LAS u32x4*)(Bv + dv * 72 + ts * 16) = o0; *(LAS u32x4*)(Bv + dv * 72 + ts * 16 + 8) = o1; }
#pragma unroll
        for (int p = 0; p < 2; ++p) { const int pc = tid + p * 512, dv = pc >> 3, part = pc & 7;
            *(LAS u32x4*)(Bs + dv * 72 + part * 8) = *(const u32x4*)(ST + (size_t)unit * 8192 + dv * 64 + part * 8); }
        __syncthreads();
        const int mi = wave & 3;
#pragma unroll
        for (int jj = 0; jj < 2; ++jj) { const int nj = (wave >> 2) * 2 + jj; f32x4 acc = {0.f, 0.f, 0.f, 0.f};
#pragma unroll
            for (int ks = 0; ks < 2; ++ks) { const bf16x8 a = *(const LAS bf16x8*)(Aq + (mi * 16 + fr) * 72 + ks * 32 + fq * 8); const bf16x8 bb = *(const LAS bf16x8*)(Bk + (nj * 16 + fr) * 72 + ks * 32 + fq * 8);
                acc = mfma16(bb, a, acc); }
            const int i = mi * 16 + fr, j0 = nj * 16 + fq * 4;
#pragma unroll
            for (int r = 0; r < 4; ++r) if (j0 + r > i) acc[r] = 0.f;
            u32x2 o; o.x = pk2(acc[0], acc[1]); o.y = pk2(acc[2], acc[3]); *(LAS u32x2*)(Ap + i * 72 + j0) = o; }
        __syncthreads();
        f32x4 oacc[4]; float ssq = 0.f;
#pragma unroll
        for (int jj = 0; jj < 4; ++jj) { const int nj = (wave >> 2) * 4 + jj; f32x4 acc = {0.f, 0.f, 0.f, 0.f};
#pragma unroll
            for (int ks = 0; ks < 2; ++ks) {
                const bf16x8 ap = *(const LAS bf16x8*)(Ap + (mi * 16 + fr) * 72 + ks * 32 + fq * 8), bv = *(const LAS bf16x8*)(Bv + (nj * 16 + fr) * 72 + ks * 32 + fq * 8);
                acc = mfma16(bv, ap, acc);
                const bf16x8 aq = *(const LAS bf16x8*)(Aq + (mi * 16 + fr) * 72 + ks * 32 + fq * 8), bs = *(const LAS bf16x8*)(Bs + (nj * 16 + fr) * 72 + ks * 32 + fq * 8);
                acc = mfma16(bs, aq, acc); }
            oacc[jj] = acc; ssq += (acc[0] * acc[0] + acc[1] * acc[1]) + (acc[2] * acc[2] + acc[3] * acc[3]); }
        ssq += __shfl_xor(ssq, 16); ssq += __shfl_xor(ssq, 32);
        if (fq == 0) red[(wave >> 2) * 64 + mi * 16 + fr] = ssq;
        __syncthreads();
        const float rstd = rsqrtf((red[mi * 16 + fr] + red[64 + mi * 16 + fr]) * (1.f / 128.f) + EPS);
        const size_t row = r0 + mi * 16 + fr;
#pragma unroll
        for (int jj = 0; jj < 4; ++jj) { const int dv0 = ((wave >> 2) * 4 + jj) * 16 + fq * 4;
            const f32x4 gn = *(const f32x4*)(F.in[13] + h * 128 + dv0); const u32x2 gw = *(const u32x2*)(proj + row * INP + C_G + h * 128 + dv0);
            const float g0 = silu(bflo(gw.x)), g1 = silu(bfhi(gw.x)), g2 = silu(bflo(gw.y)), g3 = silu(bfhi(gw.y));
            u32x2 o; o.x = pk2(oacc[jj][0] * rstd * gn[0] * g0, oacc[jj][1] * rstd * gn[1] * g1); o.y = pk2(oacc[jj][2] * rstd * gn[2] * g2, oacc[jj][3] * rstd * gn[3] * g3);
            *(u32x2*)(mixed + row * DM + 512 + h * 128 + dv0) = o; }
        __syncthreads();
    }
}

__device__ __forceinline__ void s_mixers(const Frame& F) {
    const float* projs = WSP(const float, WS_PROJS); float* mixs = WSP(float, WS_MIXS);
    const float* spool = F.in[2]; const float* sgla = F.in[3];
    const int lane = pg8::pg8_lane_id(), tid = F.wave * 64 + lane; (void)tid;
    for (int e = F.blk * 512 + tid; e < MS * 512; e += F.G * 512) { const int b = e >> 9, c = e & 511, g = c >> 7, w = 2 << g;
        const float u = projs[(size_t)b * INC + c]; float s = u;
        for (int j = 1; j < w; ++j) s += spool[((size_t)b * 15 + 15 - j) * 512 + c];
        mixs[(size_t)b * DM + c] = s / (float)w - u;
        float* so = F.out + O_SPS + (size_t)b * 15 * 512 + c;
#pragma unroll
        for (int i = 0; i < 14; ++i) so[(size_t)i * 512] = spool[((size_t)b * 15 + i + 1) * 512 + c];
        so[(size_t)14 * 512] = u; }
    LAS float* dec = (LAS float*)(F.lds); LAS float* qs = dec + 64; LAS float* ks = dec + 128; LAS float* vs = dec + 192;
    LAS float* red = dec + 320;
    LAS float* red2 = red + 2048;
    for (int it = F.blk; it < MS * 4; it += F.G) { const int b = it >> 2, h = it & 3; const float* pr = projs + (size_t)b * INC;
        if (tid < 64) { float pre = F.in[10][h * 64 + tid];
#pragma unroll
            for (int r = 0; r < 16; ++r) pre += pr[C_F + r] * F.in[9][r * 256 + h * 64 + tid];
            dec[tid] = __expf(logsig(pre) * (1.f / 16.f)); qs[tid] = pr[C_Q + h * 64 + tid] * 0.125f; ks[tid] = pr[C_K + h * 64 + tid]; }
        else if (tid < 192) vs[tid - 64] = pr[C_V + h * 128 + (tid - 64)];
        __syncthreads();
        { const int v4 = (tid & 31) * 4, dgp = tid >> 5; const f32x4 vv = *(const LAS f32x4*)(vs + v4); f32x4 po = {0.f, 0.f, 0.f, 0.f};
#pragma unroll
          for (int i = 0; i < 4; ++i) { const int d = dgp * 4 + i; const size_t off = ((size_t)(b * 4 + h) * 64 + d) * 128 + v4;
              const f32x4 s0 = __builtin_nontemporal_load((const f32x4*)(sgla + off)); const f32x4 sn = s0 * dec[d] + vv * ks[d]; __builtin_nontemporal_store(sn, (f32x4*)(F.out + O_SGS + off)); po += sn * qs[d]; }
          *(LAS f32x4*)(red + dgp * 128 + v4) = po; }
        __syncthreads();
        float o = 0.f;
        if (tid < 128) {
#pragma unroll
            for (int g = 0; g < 16; ++g) o += red[g * 128 + tid];
            const float s2 = wave_sum(o * o); if (lane == 0) red2[tid >> 6] = s2; }
        __syncthreads();
        if (tid < 128) { const float rstd = rsqrtf((red2[0] + red2[1]) * (1.f / 128.f) + EPS);
            mixs[(size_t)b * DM + 512 + h * 128 + tid] = o * rstd * F.in[13][h * 128 + tid] * silu(pr[C_G + h * 128 + tid]); }
        __syncthreads();
    }
}
constexpr int KST = 264;
__device__ __forceinline__ void p7_attn_prompt(const Frame& F) {
    const bf16* Q = WSP(const bf16, WS_Q); const bf16* KB = WSP(const bf16, WS_KB); const bf16* VT = WSP(const bf16, WS_VT); bf16* CTX = WSP(bf16, WS_CTX);
    LAS bf16* L = (LAS bf16*)F.lds;
    const int lane = pg8::pg8_lane_id(), tid = F.wave * 64 + lane; const int wave = F.wave, fr = lane & 15, fq = lane >> 4;
    for (int unit = F.blk; unit < 256; unit += F.G) {
        const int b = unit >> 5, h = (unit >> 3) & 3, qt = unit & 7; const size_t row0 = (size_t)b * SEQ + qt * 256 + wave * 32;
        const bf16* kg = KB + (size_t)(b * 4 + h) * 65536; const bf16* vg = VT + (size_t)(b * 4 + h) * 65536;
        bf16x8 qf[2][8];
#pragma unroll
        for (int mi = 0; mi < 2; ++mi)
#pragma unroll
            for (int ks = 0; ks < 8; ++ks) qf[mi][ks] = *(const bf16x8*)(Q + (row0 + mi * 16 + fr) * DM + h * 256 + ks * 32 + fq * 8);
#pragma unroll 1
        for (int i0 = 0; i0 < 16; i0 += 8) { u32x4 t[8];
#pragma unroll
          for (int i = 0; i < 8; ++i) { const int p = tid + (i0 + i) * 512; t[i] = *(const u32x4*)(kg + (p >> 5) * 256 + (p & 31) * 8); }
#pragma unroll
          for (int i = 0; i < 8; ++i) { const int p = tid + (i0 + i) * 512; *(LAS u32x4*)(L + (p >> 5) * KST + (p & 31) * 8) = t[i]; } }
        __syncthreads();
        f32x4 sacc[2][16];
        unsigned koff = (unsigned)(fr * KST + fq * 8) * 2u;
#pragma unroll
        for (int nj = 0; nj < 16; ++nj) { sacc[0][nj] = (f32x4){0.f, 0.f, 0.f, 0.f}; sacc[1][nj] = (f32x4){0.f, 0.f, 0.f, 0.f};
            const LAS unsigned char* kp = F.lds + koff; koff += 16u * KST * 2u; asm volatile("" : "+v"(koff));
            bf16x8 kf[8];
#pragma unroll
            for (int ks = 0; ks < 8; ++ks) kf[ks] = *(const LAS bf16x8*)(kp + ks * 64);
            __builtin_amdgcn_sched_barrier(0);
#pragma unroll
            for (int ks = 0; ks < 8; ++ks) { sacc[0][nj] = mfma16(kf[ks], qf[0][ks], sacc[0][nj]); sacc[1][nj] = mfma16(kf[ks], qf[1][ks], sacc[1][nj]); }
            __builtin_amdgcn_sched_barrier(0); }
        float inv[2]; bf16x8 pf[2][8];
#pragma unroll
        for (int mi = 0; mi < 2; ++mi) { float mx = -3.0e38f;
#pragma unroll
            for (int nj = 0; nj < 16; ++nj) mx = fmaxf(mx, fmaxf(fmaxf(sacc[mi][nj][0], sacc[mi][nj][1]), fmaxf(sacc[mi][nj][2], sacc[mi][nj][3])));
            mx = fmaxf(mx, __shfl_xor(mx, 16)); mx = fmaxf(mx, __shfl_xor(mx, 32));
            float sm = 0.f;
#pragma unroll
            for (int s = 0; s < 8; ++s) { float e[8];
#pragma unroll
                for (int r = 0; r < 4; ++r) { e[r] = __expf(sacc[mi][2 * s][r] - mx); e[4 + r] = __expf(sacc[mi][2 * s + 1][r] - mx); }
                sm += ((e[0] + e[1]) + (e[2] + e[3])) + ((e[4] + e[5]) + (e[6] + e[7]));
                u32x4 w; w.x = pk2(e[0], e[1]); w.y = pk2(e[2], e[3]); w.z = pk2(e[4], e[5]); w.w = pk2(e[6], e[7]); pf[mi][s] = __builtin_bit_cast(bf16x8, w); }
            sm += __shfl_xor(sm, 16); sm += __shfl_xor(sm, 32); inv[mi] = 1.f / sm; }
        __syncthreads();
#pragma unroll 1
        for (int i0 = 0; i0 < 16; i0 += 8) { u32x4 t[8];
#pragma unroll
          for (int i = 0; i < 8; ++i) { const int p = tid + (i0 + i) * 512; t[i] = *(const u32x4*)(vg + (p >> 5) * 256 + (p & 31) * 8); }
#pragma unroll
          for (int i = 0; i < 8; ++i) { const int p = tid + (i0 + i) * 512; *(LAS u32x4*)(L + (p >> 5) * KST + (p & 31) * 8) = t[i]; } }
        __syncthreads();
        unsigned voff = (unsigned)(fr * KST + fq * 8) * 2u;
        bf16* cp = CTX + (row0 + fr) * DM + h * 256 + fq * 4;
#pragma unroll
        for (int nj = 0; nj < 16; ++nj) { f32x4 o0 = {0.f, 0.f, 0.f, 0.f}, o1 = {0.f, 0.f, 0.f, 0.f};
            const LAS unsigned char* vp = F.lds + voff; voff += 16u * KST * 2u; asm volatile("" : "+v"(voff));
            bf16x8 vf[8];
#pragma unroll
            for (int s = 0; s < 8; ++s) vf[s] = *(const LAS bf16x8*)(vp + s * 64);
            __builtin_amdgcn_sched_barrier(0);
#pragma unroll
            for (int s = 0; s < 8; ++s) { o0 = mfma16(vf[s], pf[0][s], o0); o1 = mfma16(vf[s], pf[1][s], o1); }
            __builtin_amdgcn_sched_barrier(0);
            u32x2 w0; w0.x = pk2(o0[0] * inv[0], o0[1] * inv[0]); w0.y = pk2(o0[2] * inv[0], o0[3] * inv[0]); *(u32x2*)(cp + nj * 16) = w0;
            u32x2 w1; w1.x = pk2(o1[0] * inv[1], o1[1] * inv[1]); w1.y = pk2(o1[2] * inv[1], o1[3] * inv[1]); *(u32x2*)(cp + 16 * DM + nj * 16) = w1; }
        __syncthreads();
    }
}
__device__ __forceinline__ void s_attn(const Frame& F) {
    const float* qsb = WSP(const float, WS_QS); float* ctxs = WSP(float, WS_CTXS); const float* ck = F.in[4]; const float* cv = F.in[5];
    LAS float* part = (LAS float*)F.lds; LAS float* ml = part + 8 * 256;
    const int lane = pg8::pg8_lane_id(), tid = F.wave * 64 + lane; const int wave = F.wave;
    for (int it = F.blk; it < MS * 4; it += F.G) { const int b = it >> 2, h = it & 3;
        const f32x4 q4 = *(const f32x4*)(qsb + (size_t)b * DM + h * 256 + lane * 4);
        const float* kb = ck + ((size_t)b * 256 * 4 + h) * 256 + lane * 4 + (size_t)(wave * 32) * 1024;
        const float* vb = cv + ((size_t)b * 256 * 4 + h) * 256 + lane * 4 + (size_t)(wave * 32) * 1024;
        float mrun = -3.0e38f, l = 0.f; f32x4 acc = {0.f, 0.f, 0.f, 0.f};
#pragma unroll 1
        for (int i0 = 0; i0 < 32; i0 += 8) { f32x4 k4[8], v4[8]; float sc[8];
#pragma unroll
            for (int u = 0; u < 8; ++u) { k4[u] = __builtin_nontemporal_load((const f32x4*)(kb + (size_t)(i0 + u) * 1024)); v4[u] = __builtin_nontemporal_load((const f32x4*)(vb + (size_t)(i0 + u) * 1024)); }
            float mx = mrun;
#pragma unroll
            for (int u = 0; u < 8; ++u) { sc[u] = wave_sum((k4[u][0] * q4[0] + k4[u][1] * q4[1]) + (k4[u][2] * q4[2] + k4[u][3] * q4[3])); mx = fmaxf(mx, sc[u]); }
            const float rescale = __expf(mrun - mx); l *= rescale; acc = acc * rescale; mrun = mx;
#pragma unroll
            for (int u = 0; u < 8; ++u) { const float p = __expf(sc[u] - mx); l += p; acc += v4[u] * p; } }
        *(LAS f32x4*)(part + wave * 256 + lane * 4) = acc; if (lane == 0) { ml[wave * 2] = mrun; ml[wave * 2 + 1] = l; }
        __syncthreads();
        if (tid < 256) { float M = -3.0e38f;
#pragma unroll
            for (int w = 0; w < 8; ++w) M = fmaxf(M, ml[w * 2]);
            float o = 0.f, L = 0.f;
#pragma unroll
            for (int w = 0; w < 8; ++w) { const float e = __expf(ml[w * 2] - M); L += e * ml[w * 2 + 1]; o += e * part[w * 256 + tid]; }
            ctxs[(size_t)b * DM + h * 256 + tid] = o / L; }
        __syncthreads();
    }
}
__device__ __forceinline__ void final_norm_prompt(const Frame& F) {
    const int lane = pg8::pg8_lane_id(), tid = F.wave * 64 + lane; (void)tid;
    const int gw = F.blk * NWAVES + F.wave, NGW = F.G * NWAVES; const f32x4* g4 = (const f32x4*)F.in[24] + lane;
    for (int m = gw; m < MP; m += NGW) { f32x4* xr = (f32x4*)(F.out + O_YP + (size_t)m * DM) + lane; f32x4 v[4]; float s = 0.f;
#pragma unroll
        for (int j = 0; j < 4; ++j) { v[j] = xr[64 * j]; s += (v[j].x * v[j].x + v[j].y * v[j].y) + (v[j].z * v[j].z + v[j].w * v[j].w); }
        const float rstd = rsqrtf(wave_sum(s) * (1.f / DM) + EPS);
#pragma unroll
        for (int j = 0; j < 4; ++j) xr[64 * j] = v[j] * rstd * g4[64 * j]; }
}
__device__ __forceinline__ void final_norm_sample(const Frame& F) {
    const int lane = pg8::pg8_lane_id(), tid = F.wave * 64 + lane; (void)tid;
    const int gw = F.blk * NWAVES + F.wave, NGW = F.G * NWAVES; const f32x4* g4 = (const f32x4*)F.in[24] + lane; const float* parts = WSP(const float, WS_PARTS);
    for (int m = gw; m < MS; m += NGW) { f32x4* xr = (f32x4*)(F.out + O_YS + (size_t)m * DM) + lane; f32x4 v[4]; float s = 0.f;
#pragma unroll
        for (int j = 0; j < 4; ++j) { v[j] = xr[64 * j];
#pragma unroll
            for (int ks = 0; ks < 4; ++ks) v[j] += ((const f32x4*)(parts + ((size_t)ks * MS + m) * DM) + lane)[64 * j];
            s += (v[j].x * v[j].x + v[j].y * v[j].y) + (v[j].z * v[j].z + v[j].w * v[j].w); }
        const float rstd = rsqrtf(wave_sum(s) * (1.f / DM) + EPS);
#pragma unroll
        for (int j = 0; j < 4; ++j) xr[64 * j] = v[j] * rstd * g4[64 * j]; }
}
#define RLX_AGENT __ATOMIC_RELAXED, __HIP_MEMORY_SCOPE_AGENT
#define XB_TMO      128
#define XB_XCNT(j)  (256  + 64 * (j))
#define XB_XSUB(j)  (1280 + 64 * (j))
#define XB_XGEN(j)  (2304 + 64 * (j))
#define XB_TOP      3328
#define XB_TOPGEN   3392
#define XCD_BAR_WORDS 3456
#define XB_SPIN_CAP (1u << 18)

__device__ __forceinline__ unsigned xb_ld(unsigned* p)              { return __hip_atomic_load(p, __ATOMIC_RELAXED, __HIP_MEMORY_SCOPE_AGENT); }
__device__ __forceinline__ unsigned xb_add(unsigned* p, unsigned v) { return __hip_atomic_fetch_add(p, v, __ATOMIC_RELAXED, __HIP_MEMORY_SCOPE_AGENT); }
__device__ __forceinline__ unsigned xb_xcc_id() { return (unsigned)__builtin_amdgcn_s_getreg((3 << 11) | 20) & 0xFu; }
#define XB_SPIN(cond, bar) do { unsigned _sp = 0; while (cond) { __builtin_amdgcn_s_sleep(1); \
    if ((++_sp & 255u) == 0u) { if (xb_ld(&(bar)[XB_TMO])) break; if (_sp > XB_SPIN_CAP) { atomicAdd(&(bar)[XB_TMO], 1u); break; } } } } while (0)

struct XcdBarrier {
    unsigned* bar; unsigned x;
    volatile LAS unsigned* st;
};

__device__ __forceinline__ XcdBarrier xcd_barrier_post(unsigned* bar, volatile LAS unsigned* st, bool t0) {
    XcdBarrier b; b.bar = bar; b.x = xb_xcc_id(); b.st = st;
    if (t0) (void)xb_add(&bar[XB_XCNT(b.x)], 1u);
    return b;
}
__device__ __forceinline__ void xcd_barrier_complete(unsigned* bar, unsigned x, unsigned& nloc, unsigned& nx) {
    const unsigned G = gridDim.x * gridDim.y * gridDim.z;
    unsigned sum, cnt, mine, sp = 0u;
    for (;;) {
        sum = 0u; cnt = 0u; mine = 0u;
#pragma unroll
        for (unsigned j = 0; j < 16; ++j) { const unsigned c = xb_ld(&bar[XB_XCNT(j)]); sum += c; cnt += (c > 0u) ? 1u : 0u; mine = (j == x) ? c : mine; }
        if (sum == G) break;
        __builtin_amdgcn_s_sleep(1);
        if ((++sp & 255u) == 0u) { if (xb_ld(&bar[XB_TMO])) break; if (sp > XB_SPIN_CAP) { atomicAdd(&bar[XB_TMO], 1u); break; } }
    }
    nloc = mine > 0u ? mine : 1u; nx = cnt > 0u ? cnt : 1u;
}

__device__ __forceinline__ void xcd_barrier(const XcdBarrier& b, int wave) {
    asm volatile("s_waitcnt vmcnt(0)" ::: "memory");
    __syncthreads();
    if (wave == 0 && pg8::pg8_lane_id() == 0) {
        unsigned* bar = b.bar;
        __builtin_amdgcn_s_waitcnt(0);
        unsigned nloc = b.st[0], nx = b.st[1];
        if (nloc == 0u) { xcd_barrier_complete(bar, b.x, nloc, nx); b.st[0] = nloc; b.st[1] = nx; }
        const unsigned old = xb_add(&bar[XB_XSUB(b.x)], 1u);
        const unsigned gen = old / nloc;
        if (old + 1u == (gen + 1u) * nloc) {
            __builtin_amdgcn_fence(__ATOMIC_RELEASE, "agent");
            asm volatile("s_waitcnt vmcnt(0)" ::: "memory");
            const unsigned og = xb_add(&bar[XB_TOP], 1u);
            const unsigned tg = og / nx;
            if (og + 1u == (tg + 1u) * nx) xb_add(&bar[XB_TOPGEN], 1u);
            else XB_SPIN(xb_ld(&bar[XB_TOPGEN]) == tg, bar);
            __builtin_amdgcn_fence(__ATOMIC_ACQUIRE, "agent");
            xb_add(&bar[XB_XGEN(b.x)], 1u);
            asm volatile("s_waitcnt vmcnt(0)" ::: "memory");
        } else {
            XB_SPIN(xb_ld(&bar[XB_XGEN(b.x)]) == gen, bar);
            __builtin_amdgcn_fence(__ATOMIC_ACQUIRE, "agent");
            asm volatile("s_waitcnt vmcnt(0)" ::: "memory");
        }
    }
    __syncthreads();
}
#ifndef MK_N_LAUNCHES
#define MK_N_LAUNCHES 1
#endif
constexpr int N_PHASES = 12;
#ifndef REPX
#define REPX 0
#endif
#define AMP_WAIT() do { __syncthreads(); const unsigned long long t1_ = __builtin_amdgcn_s_memrealtime(); while (__builtin_amdgcn_s_memrealtime() < t1_ + (t1_ - t0_)) __builtin_amdgcn_s_sleep(8); __syncthreads(); } while (0)
#define RX(bit) for (int rx_ = 0; rx_ < 1 + ((REPX >> (bit)) & 1); ++rx_)
struct Args { const float* in[25]; float* out; unsigned char* ws; int ph_lo, ph_hi; };
struct RotOrder {
    pg8::StaticOrder S;
    __device__ void init(int M, int N, int G, int c, int rot) { S.init(M, N, G, (c + G - (rot % G)) % G); }
    __device__ bool next(int i, pg8::Unit& u) const { return S.next(i, u); }
    __device__ __forceinline__ void a_ready(const pg8::Unit&) const {}
    __device__ __forceinline__ void done(const pg8::Unit&) const {}
};
__global__ void __launch_bounds__(NWAVES * 64, 2) mk_fwd(Args args) {
    extern __shared__ __attribute__((aligned(16))) unsigned char lds_raw[];
    Frame F;
    F.lds = (LAS unsigned char*)lds_raw;
    F.wave = __builtin_amdgcn_readfirstlane((int)threadIdx.x >> 6);
    F.G = gridDim.x; F.blk = blockIdx.x;
#pragma unroll
    for (int i = 0; i < 25; ++i) F.in[i] = args.in[i];
    F.out = args.out; F.ws = args.ws;
    const int lo = args.ph_lo, hi = args.ph_hi;
#define IN(k) (lo <= (k) && (k) < hi)
    volatile LAS unsigned* bst = (volatile LAS unsigned*)(F.lds + 143360);
    { const int l0 = pg8::pg8_lane_id(); if (F.wave == 0 && l0 < 2) bst[l0] = 0u; }
    __syncthreads();
    XcdBarrier bar = xcd_barrier_post((unsigned*)args.ws, bst, F.wave == 0 && pg8::pg8_lane_id() == 0);
    if (lo < 0) cg::this_grid().sync();
#define GRID_BAR() xcd_barrier(bar, F.wave)
#define SEAM(k) do { if (IN(k) && IN((k) + 1)) GRID_BAR(); } while (0)
    typedef pg8::bf16_t pb;
    if (IN(0)) { constexpr int rep = 0; (void)rep; p0_prologue(F); __syncthreads(); }
    SEAM(0);
    if (IN(1)) { constexpr int rep = 0; (void)rep;
        RX(10) { SEpiStore E{WSP(float, WS_PROJS), INC, 1.f}; skinny_gemm<true>(F, F.in[1], DM, WSP(const bf16, WS_WIN), DM, DM, INC / 16, 1, E); }
        { pg8::Gemm g{WSP(const pb, WS_H), WSP(const pb, WS_WIN), MP, INP, DM}; pg8::StaticOrder S; S.init(MP, INP, F.G, F.blk);
          pg8::EpiScale<0, 1> E{WSP(pb, WS_PROJ), INP, WSP(const float, WS_SSQ0), 1.f}; pg8::gemm_phase<pg8::EpiScale<0, 1>, pg8::StaticOrder, true, true>(F.lds, F.wave, g, S, E); }
    }
    SEAM(1);
    if (IN(2)) { constexpr int rep = 0; (void)rep; RX(7) s_mixers(F); RX(6) p2_pool_prompt(F); RX(5) p2_gla_local(F); }
    SEAM(2);
    if (IN(3)) { constexpr int rep = 0; (void)rep;
        { SEpiRes E{F.in[1], F.out + O_YS}; skinny_gemm<false>(F, WSP(const float, WS_MIXS), DM, WSP(const bf16, WS_WOUT), DM, DM, DM / 16, 1, E); }
        RX(2) p3_gla_scan(F);
        { pg8::Gemm g{WSP(const pb, WS_MN), WSP(const pb, WS_WKV), NB * 256, 2048, DM}; RotOrder S; S.init(NB * 256, 2048, F.G, F.blk, 128);
          pg8::EpiKV E{F.out + O_KP, F.out + O_VP, WSP(pb, WS_KB), WSP(pb, WS_VT), WSP(const float, WS_SSQ0) + MP}; pg8::gemm_phase<pg8::EpiKV, RotOrder, true, true>(F.lds, F.wave, g, S, E); }
    }
    SEAM(3);
    if (IN(4)) { constexpr int rep = 0; (void)rep;
        RX(4) { SEpiStore E{WSP(float, WS_QS), DM, 0.0625f}; skinny_gemm<true>(F, F.out + O_YS, DM, WSP(const bf16, WS_WQM), DM, DM, DM / 16, 1, E); }
        RX(3) p4_gla_out(F);
    }
    SEAM(4);
    if (IN(5)) { constexpr int rep = 0; (void)rep;
        RX(9) s_attn(F);
        { pg8::Gemm g{WSP(const pb, WS_H), WSP(const pb, WS_WOUT), MP, DM, DM}; pg8::StaticOrder S; S.init(MP, DM, F.G, F.blk);
          pg8::EpiRes<true, true, true> E{F.in[0], F.out + O_YP, WSP(pb, WS_XB), WSP(float, WS_SSQ1)}; pg8::gemm_phase<pg8::EpiRes<true, true, true>, pg8::StaticOrder, true, true>(F.lds, F.wave, g, S, E); }
    }
    SEAM(5);
    if (IN(6)) { constexpr int rep = 0; (void)rep;
        if (rep == 0) { SEpiRes E{F.out + O_YS, F.out + O_YS}; skinny_gemm<false>(F, WSP(const float, WS_CTXS), DM, WSP(const bf16, WS_WOM), DM, DM, DM / 16, 1, E); }
        { pg8::Gemm g{WSP(const pb, WS_XB), WSP(const pb, WS_WQM), MP, DM, DM}; pg8::StaticOrder S; S.init(MP, DM, F.G, F.blk);
          pg8::EpiScale<0> E{WSP(pb, WS_Q), DM, WSP(const float, WS_SSQ1), 0.0625f}; pg8::gemm_phase<pg8::EpiScale<0>, pg8::StaticOrder, true, true>(F.lds, F.wave, g, S, E); }
    }
    SEAM(6);
    if (IN(7)) { constexpr int rep = 0; (void)rep;
        RX(0) { SEpiRelu2 E{WSP(float, WS_HFFS)}; skinny_gemm<true>(F, F.out + O_YS, DM, WSP(const bf16, WS_WUP), DM, DM, FF / 16, 1, E); }
        __syncthreads();
        RX(1) p7_attn_prompt(F);
    }
    SEAM(7);
    if (IN(8)) { constexpr int rep = 0; (void)rep;
        { SEpiPart E{WSP(float, WS_PARTS)}; skinny_gemm<false>(F, WSP(const float, WS_HFFS), FF, WSP(const bf16, WS_WDN), FF, DM, DM / 16, 4, E); }
        { pg8::Gemm g{WSP(const pb, WS_CTX), WSP(const pb, WS_WOM), MP, DM, DM}; pg8::StaticOrder S; S.init(MP, DM, F.G, F.blk);
          pg8::EpiRes<true, true> E{F.out + O_YP, F.out + O_YP, WSP(pb, WS_XB), WSP(float, WS_SSQ2)}; pg8::gemm_phase<pg8::EpiRes<true, true>, pg8::StaticOrder, true, true>(F.lds, F.wave, g, S, E); }
    }
    SEAM(8);
    if (IN(9)) { constexpr int rep = 0; (void)rep;
        if (rep == 0) final_norm_sample(F);
        { pg8::Gemm g{WSP(const pb, WS_XB), WSP(const pb, WS_WUP), MP, FF, DM}; pg8::StaticOrder S; S.init(MP, FF, F.G, F.blk);
          pg8::EpiScale<1> E{WSP(pb, WS_HFF), FF, WSP(const float, WS_SSQ2), 1.f}; pg8::gemm_phase<pg8::EpiScale<1>, pg8::StaticOrder, true, true>(F.lds, F.wave, g, S, E); }
    }
    SEAM(9);
    if (IN(10)) { constexpr int rep = 0; (void)rep;
        pg8::Gemm g{WSP(const pb, WS_HFF), WSP(const pb, WS_WDN), MP, DM, FF}; pg8::StaticOrder S; S.init(MP, DM, F.G, F.blk);
        if (F.G == 256) {
            pg8::EpiResRms E{F.out + O_YP, F.out + O_YP, F.in[24], WSP(unsigned, WS_SSQ1), (unsigned*)(args.ws + 32768)};
            pg8::gemm_phase<pg8::EpiResRms, pg8::StaticOrder, false, true>(F.lds, F.wave, g, S, E);
        } else { pg8::EpiRes<false, false> E{F.out + O_YP, F.out + O_YP, nullptr, nullptr}; pg8::gemm_phase<pg8::EpiRes<false, false>, pg8::StaticOrder, true, true>(F.lds, F.wave, g, S, E); }
    }
    if (F.G != 256) SEAM(10);
    if (IN(11) && F.G != 256) { constexpr int rep = 0; (void)rep; final_norm_prompt(F); }
    if ((REPX >> 8) & 1) { for (int q = 0; q < 4; ++q) { GRID_BAR(); } }
#undef IN
#undef SEAM
}

extern "C" void kernel_launch(void* const* d_in, const int* in_sizes, int n_in, void* d_out, int out_size, void* d_ws, size_t ws_size, hipStream_t stream) {
    static int grid = 0;
    if (grid == 0) {
        if (n_in != 25 || ws_size < WS_END) { fprintf(stderr, "kernel_launch: unexpected inputs (n_in %d, ws %zu)\n", n_in, ws_size); grid = -1; return; }
        int dev = 0, cus = 0, per_cu = 0;
        hipGetDevice(&dev); hipDeviceGetAttribute(&cus, hipDeviceAttributeMultiprocessorCount, dev);
        if (hipFuncSetAttribute((const void*)mk_fwd, hipFuncAttributeMaxDynamicSharedMemorySize, LDS_BYTES) != hipSuccess) { fprintf(stderr, "kernel_launch: hipFuncSetAttribute failed\n"); grid = -1; return; }
        if (hipOccupancyMaxActiveBlocksPerMultiprocessor(&per_cu, (const void*)mk_fwd, NWAVES * 64, LDS_BYTES) != hipSuccess || per_cu < 1) { fprintf(stderr, "kernel_launch: occupancy query says %d\n", per_cu); per_cu = 1; }
        (void)hipGetLastError();
        grid = cus * 1;
        fprintf(stderr, "kernel_launch: grid %d (cus %d, per_cu %d)\n", grid, cus, per_cu);
    }
    if (grid < 0) return;
    if (hipMemsetAsync(d_ws, 0, 65536, stream) != hipSuccess) { fprintf(stderr, "kernel_launch: memset failed\n"); return; }
    Args a{};
    for (int i = 0; i < 25; ++i) a.in[i] = (const float*)d_in[i];
    a.out = (float*)d_out; a.ws = (unsigned char*)d_ws;
#if MK_N_LAUNCHES == 1
    a.ph_lo = 0; a.ph_hi = N_PHASES;
    void* kargs[] = {&a};
    hipError_t e = hipLaunchCooperativeKernel((const void*)mk_fwd, dim3(grid), dim3(NWAVES * 64), kargs, LDS_BYTES, stream);
    if (e != hipSuccess) fprintf(stderr, "cooperative launch failed: %s (grid %d)\n", hipGetErrorString(e), grid);
#else
    for (int p = 0; p < N_PHASES; ++p) { a.ph_lo = p; a.ph_hi = p + 1; hipLaunchKernelGGL(mk_fwd, dim3(grid), dim3(NWAVES * 64), LDS_BYTES, stream, a); }
#endif
}
```

```cpp
#include <hip/hip_runtime.h>
#include <hip/hip_cooperative_groups.h>
#include <cstdio>
#include <cstdint>
namespace cg = cooperative_groups;
namespace pg8 {
#define PG8_LAS __attribute__((address_space(3)))
typedef unsigned short bf16_t;
typedef short bf16x8 __attribute__((ext_vector_type(8)));
typedef float f32x4 __attribute__((ext_vector_type(4)));
typedef unsigned u32x4 __attribute__((ext_vector_type(4)));
constexpr int BM = 256, BK = 64, HALF = 128, HTB = HALF * BK * 2  , STAGE_BYTES = 8 * HTB, NXCD = 8, WGM = 8;

__host__ __device__ __forceinline__ int lds_byte(int r, int c) { const int st = (r >> 4) * 2 + (c >> 5), rr = r & 15, cc = c & 31, ob = rr * 64 + cc * 2; return st * 1024 + (ob ^ (((ob >> 9) & 1) << 5)); }
__host__ __device__ __forceinline__ void stage_rc(int b, int& R, int& C) { const int st = b / 1024, sb = b % 1024, swz = sb ^ (((sb >> 9) & 1) << 5); R = (st >> 1) * 16 + swz / 64; C = (st & 1) * 32 + (swz % 64) / 2; }
__host__ __device__ __forceinline__ int perm32(int rho) { const int n = rho >> 4, i = rho & 15; return 8 * (i >> 2) + 4 * n + (i & 3); }

struct Unit { int pm, pn; };
struct Gemm { const bf16_t* A; const bf16_t* Bt; int M, N, K; };

struct StaticOrder {
    int nM, nN, nwg, G, c;
    __host__ __device__ void init(int M, int N, int G_, int c_) { nM = M / BM; nN = N / BM; nwg = nM * nN; G = G_; c = c_; }
    __host__ __device__ bool next(int i, Unit& u) const {
        const long L = (long)i * G + c; if (L >= nwg) return false;
        int wgid = (int)L; { const int q = nwg / NXCD, r = nwg % NXCD, xcd = wgid % NXCD, off = wgid / NXCD; wgid = (xcd < r ? xcd * (q + 1) : r * (q + 1) + (xcd - r) * q) + off; }
        const int nig = WGM * nN, gid = wgid / nig, fm = gid * WGM, gsz = (nM - fm) < WGM ? (nM - fm) : WGM;
        u.pm = fm + ((wgid % nig) % gsz); u.pn = (wgid % nig) / gsz; return true;
    }
    __device__ __forceinline__ void a_ready(const Unit&) const {}
    __device__ __forceinline__ void done(const Unit&) const {}
};

typedef float f32x2 __attribute__((ext_vector_type(2)));
typedef __bf16 bf16x2_t __attribute__((ext_vector_type(2)));
__device__ __forceinline__ unsigned cvt_pk_bf16(float lo, float hi) { const f32x2 v = {lo, hi}; return __builtin_bit_cast(unsigned, __builtin_convertvector(v, bf16x2_t)); }
__device__ __forceinline__ int pg8_lane_id() { int l; asm volatile("v_mbcnt_lo_u32_b32 %0, -1, 0\n\tv_mbcnt_hi_u32_b32 %0, -1, %0" : "=v"(l)); return l; }
typedef unsigned u32x2 __attribute__((ext_vector_type(2)));
struct EpiPlainBf16 {
    static constexpr bool PERM = true, AFTER_DRAIN = false;
    bf16_t* O; int ldc;
    __device__ __forceinline__ void operator()(const f32x4 (&acc)[2][2][4][2], const Unit& u, int wr, int wc, int fr, int fq) const {
        asm volatile("" : "+v"(fr), "+v"(fq));
        const int row0 = u.pm * BM + wr * 64 + fr, col0 = u.pn * BM + wc * 32 + 8 * fq;
#pragma unroll
        for (int ai = 0; ai < 2; ++ai)
#pragma unroll
            for (int m = 0; m < 4; ++m) { bf16_t* rowp = O + (size_t)(row0 + ai * HALF + m * 16) * ldc + col0;
#pragma unroll
                for (int bj = 0; bj < 2; ++bj) { const f32x4 v0 = acc[ai][bj][m][0], v1 = acc[ai][bj][m][1];
                    u32x4 w; w.x = cvt_pk_bf16(v0[0], v0[1]); w.y = cvt_pk_bf16(v0[2], v0[3]); w.z = cvt_pk_bf16(v1[0], v1[1]); w.w = cvt_pk_bf16(v1[2], v1[3]);
                    *(u32x4*)(rowp + bj * HALF) = w; } }
    }
};
struct EpiKV {
    static constexpr bool PERM = true, AFTER_DRAIN = false;
    float* outK; float* outV; bf16_t* KB; bf16_t* VT; const float* ssq;
    __device__ __forceinline__ void operator()(const f32x4 (&acc)[2][2][4][2], const Unit& u, int wr, int wc, int fr, int fq) const {
        asm volatile("" : "+v"(fr), "+v"(fq));
        const bool isV = u.pn >= 4; const int h = u.pn & 3, b = u.pm;
        float* of = isV ? outV : outK;
        const int ct0 = wc * 32 + 8 * fq;
#pragma unroll
        for (int ai = 0; ai < 2; ++ai)
#pragma unroll
            for (int m = 0; m < 4; ++m) { const int key = ai * HALF + wr * 64 + m * 16 + fr; const float rs = rsqrtf(ssq[b * 256 + key] * (1.0f / 1024.0f) + 1e-6f);
#pragma unroll
                for (int bj = 0; bj < 2; ++bj) { const f32x4 v0 = acc[ai][bj][m][0] * rs, v1 = acc[ai][bj][m][1] * rs; const int ct = ct0 + bj * HALF;
                    float* fp = of + (size_t)(b * 256 + key) * 1024 + h * 256 + ct;
                    __builtin_nontemporal_store(v0, (f32x4*)fp); __builtin_nontemporal_store(v1, (f32x4*)(fp + 4));
                    if (!isV) { u32x4 w; w.x = cvt_pk_bf16(v0[0], v0[1]); w.y = cvt_pk_bf16(v0[2], v0[3]); w.z = cvt_pk_bf16(v1[0], v1[1]); w.w = cvt_pk_bf16(v1[2], v1[3]);
                        *(u32x4*)(KB + ((size_t)(b * 4 + h) * 256 + key) * 256 + ct) = w; }
                    else { const int kp = (key & ~31) | (((key >> 2) & 3) << 3) | (((key >> 4) & 1) << 2) | (key & 3);
                        bf16_t* vp = VT + ((size_t)(b * 4 + h) * 256 + ct) * 256 + kp;
#pragma unroll
                        for (int e = 0; e < 4; ++e) { vp[(size_t)e * 256] = (bf16_t)(cvt_pk_bf16(v0[e], 0.f) & 0xffffu); vp[(size_t)(e + 4) * 256] = (bf16_t)(cvt_pk_bf16(v1[e], 0.f) & 0xffffu); } }
                } }
    }
};
template <bool XB, bool SSQ, bool NTB = false, bool BASEBF = false, bool OUTF = true> struct EpiRes {
    static constexpr bool PERM = false, AFTER_DRAIN = false;
    const float* base; float* out; bf16_t* xb; float* ssq;
    __device__ __forceinline__ void operator()(const f32x4 (&acc)[2][2][4][2], const Unit& u, int wr, int wc, int fr, int fq) const {
        asm volatile("" : "+v"(fr), "+v"(fq));
        const int col0 = u.pn * BM + wc * 32 + 4 * fq;
#pragma unroll
        for (int ai = 0; ai < 2; ++ai)
#pragma unroll
            for (int m = 0; m < 4; ++m) { const int r = u.pm * BM + ai * HALF + wr * 64 + m * 16 + fr; const size_t off = (size_t)r * 1024 + col0; float s = 0.f;
#pragma unroll
                for (int bj = 0; bj < 2; ++bj)
#pragma unroll
                    for (int n = 0; n < 2; ++n) { f32x4 bs;
                        if (BASEBF) { const u32x2 w = *(const u32x2*)(xb + off + bj * HALF + n * 16); bs = (f32x4){__uint_as_float(w.x << 16), __uint_as_float(w.x & 0xffff0000u), __uint_as_float(w.y << 16), __uint_as_float(w.y & 0xffff0000u)}; }
                        else bs = NTB ? __builtin_nontemporal_load((const f32x4*)(base + off + bj * HALF + n * 16)) : *(const f32x4*)(base + off + bj * HALF + n * 16);
                        const f32x4 o = bs + acc[ai][bj][m][n];
                        if (OUTF) *(f32x4*)(out + off + bj * HALF + n * 16) = o;
                        if (SSQ) s += (o[0] * o[0] + o[1] * o[1]) + (o[2] * o[2] + o[3] * o[3]);
                        if (XB) { u32x2 w; w.x = cvt_pk_bf16(o[0], o[1]); w.y = cvt_pk_bf16(o[2], o[3]); *(u32x2*)(xb + off + bj * HALF + n * 16) = w; } }
                if (SSQ) { s += __shfl_xor(s, 16); s += __shfl_xor(s, 32); if (fq == 0) ssq[(size_t)r * 16 + u.pn * 4 + wc] = s; }
            }
    }
};
template <int MODE, int NPART = 16> struct EpiScale {
    static constexpr bool PERM = true, AFTER_DRAIN = false;
    bf16_t* O; int ldc; const float* ssq; float scale;
    __device__ __forceinline__ void operator()(const f32x4 (&acc)[2][2][4][2], const Unit& u, int wr, int wc, int fr, int fq) const {
        asm volatile("" : "+v"(fr), "+v"(fq));
        const int row0 = u.pm * BM + wr * 64 + fr, col0 = u.pn * BM + wc * 32 + 8 * fq;
#pragma unroll
        for (int ai = 0; ai < 2; ++ai)
#pragma unroll
            for (int m = 0; m < 4; ++m) { const int r = row0 + ai * HALF + m * 16; bf16_t* rowp = O + (size_t)r * ldc + col0;
                float tot;
                if (NPART == 16) { const f32x4* sp = (const f32x4*)(ssq + (size_t)r * 16); const f32x4 s0 = sp[0], s1 = sp[1], s2 = sp[2], s3 = sp[3];
                    tot = ((s0[0] + s0[1]) + (s0[2] + s0[3])) + ((s1[0] + s1[1]) + (s1[2] + s1[3])) + ((s2[0] + s2[1]) + (s2[2] + s2[3])) + ((s3[0] + s3[1]) + (s3[2] + s3[3])); }
                else tot = ssq[r];
                const float rs = rsqrtf(tot * (1.0f / 1024.0f) + 1e-6f) * (MODE == 0 ? scale : 1.0f);
#pragma unroll
                for (int bj = 0; bj < 2; ++bj) { f32x4 v0 = acc[ai][bj][m][0] * rs, v1 = acc[ai][bj][m][1] * rs;
                    if (MODE == 1) {
#pragma unroll
                        for (int e = 0; e < 4; ++e) { const float a0 = fmaxf(v0[e], 0.f), a1 = fmaxf(v1[e], 0.f); v0[e] = a0 * a0; v1[e] = a1 * a1; } }
                    u32x4 w; w.x = cvt_pk_bf16(v0[0], v0[1]); w.y = cvt_pk_bf16(v0[2], v0[3]); w.z = cvt_pk_bf16(v1[0], v1[1]); w.w = cvt_pk_bf16(v1[2], v1[3]);
                    *(u32x4*)(rowp + bj * HALF) = w; } }
    }
};

struct EpiResRms {
    static constexpr bool PERM = false, AFTER_DRAIN = true;
    const bf16_t* xbase; float* out; const float* gain; unsigned* xs; unsigned* cnt;
    __device__ __forceinline__ void fused(f32x4 (&acc)[2][2][4][2], const Unit& u, int wr, int wc, int fr, int fq, PG8_LAS unsigned char* lds, int wid, int lane) const {
        asm volatile("" : "+v"(fr), "+v"(fq));
        PG8_LAS float* P = (PG8_LAS float*)lds;
        PG8_LAS float* S = (PG8_LAS float*)(lds + 4096);
        const int col0 = u.pn * BM + wc * 32 + 4 * fq;
#pragma unroll
        for (int ai = 0; ai < 2; ++ai)
#pragma unroll
            for (int m = 0; m < 4; ++m) { const int r = ai * HALF + wr * 64 + m * 16 + fr; const size_t off = (size_t)(u.pm * BM + r) * 1024 + col0; float s = 0.f;
#pragma unroll
                for (int bj = 0; bj < 2; ++bj)
#pragma unroll
                    for (int n = 0; n < 2; ++n) { const u32x2 w = *(const u32x2*)(xbase + off + bj * HALF + n * 16); const f32x4 bs = {__uint_as_float(w.x << 16), __uint_as_float(w.x & 0xffff0000u), __uint_as_float(w.y << 16), __uint_as_float(w.y & 0xffff0000u)}; const f32x4 o = bs + acc[ai][bj][m][n]; acc[ai][bj][m][n] = o;
                        s += (o[0] * o[0] + o[1] * o[1]) + (o[2] * o[2] + o[3] * o[3]); }
                s += __shfl_xor(s, 16); s += __shfl_xor(s, 32); if (fq == 0) P[r * 4 + wc] = s;
                if (m & 1) asm volatile("" ::: "memory"); }
        asm volatile("s_waitcnt lgkmcnt(0)" ::: "memory"); __builtin_amdgcn_s_barrier(); asm volatile("" ::: "memory");
        const int row = wid * 32 + (lane & 31);
        if (lane < 32) { const float t = (P[row * 4 + 0] + P[row * 4 + 1]) + (P[row * 4 + 2] + P[row * 4 + 3]);
            __hip_atomic_store(xs + (size_t)(u.pm * BM + row) * 4 + u.pn, __float_as_uint(t), __ATOMIC_RELAXED, __HIP_MEMORY_SCOPE_AGENT); }
        asm volatile("s_waitcnt vmcnt(0)" ::: "memory");
        if (lane == 0) __hip_atomic_fetch_add(cnt + 64 * u.pm, 1u, __ATOMIC_RELAXED, __HIP_MEMORY_SCOPE_AGENT);
        if (wid == 0) { unsigned spins = 0;
            while ((unsigned)__builtin_amdgcn_readfirstlane(__hip_atomic_load(cnt + 64 * u.pm, __ATOMIC_RELAXED, __HIP_MEMORY_SCOPE_AGENT)) < 32u) { __builtin_amdgcn_s_sleep(2); if (++spins > (1u << 22)) break; }
            __builtin_amdgcn_fence(__ATOMIC_ACQUIRE, "agent"); }
        asm volatile("s_waitcnt vmcnt(0) lgkmcnt(0)" ::: "memory"); __builtin_amdgcn_s_barrier(); asm volatile("" ::: "memory");
        if (lane < 32) { const unsigned* sl = xs + (size_t)(u.pm * BM + row) * 4; float t = 0.f;
#pragma unroll
            for (int q = 0; q < 4; ++q) t += __uint_as_float(__hip_atomic_load(sl + q, __ATOMIC_RELAXED, __HIP_MEMORY_SCOPE_AGENT));
            S[row] = rsqrtf(t * (1.0f / 1024.0f) + 1e-6f); }
        asm volatile("s_waitcnt lgkmcnt(0)" ::: "memory"); __builtin_amdgcn_s_barrier(); asm volatile("" ::: "memory");
        f32x4 gv[2][2];
#pragma unroll
        for (int bj = 0; bj < 2; ++bj)
#pragma unroll
            for (int n = 0; n < 2; ++n) gv[bj][n] = *(const f32x4*)(gain + col0 + bj * HALF + n * 16);
#pragma unroll
        for (int ai = 0; ai < 2; ++ai)
#pragma unroll
            for (int m = 0; m < 4; ++m) { const int r = ai * HALF + wr * 64 + m * 16 + fr; const float rs = S[r]; const size_t off = (size_t)(u.pm * BM + r) * 1024 + col0;
#pragma unroll
                for (int bj = 0; bj < 2; ++bj)
#pragma unroll
                    for (int n = 0; n < 2; ++n) __builtin_nontemporal_store(acc[ai][bj][m][n] * rs * gv[bj][n], (f32x4*)(out + off + bj * HALF + n * 16)); }
    }
};

template <class Epi, class Sched, bool ALIGN_EPI = false, bool SP2 = false>
__device__ __forceinline__ void gemm_phase(PG8_LAS unsigned char* lds, const int wave_in, const Gemm g, const Sched& S, const Epi& E) {
    const int wid = wave_in, lane = pg8_lane_id(), tid = wid * 64 + lane, wr = wid >> 2, wc = wid & 3, fr = lane & 15, fq = lane >> 4;
    const int K = g.K, nt = K / BK;
    unsigned voffA[2], voffB[2];
#pragma unroll
    for (int i = 0; i < 2; ++i) { int R, C; stage_rc(tid * 16 + i * 8192, R, C); const int Rb = Epi::PERM ? ((R & ~31) + perm32(R & 31)) : R;
        voffA[i] = (unsigned)(R * K + C) * 2u; voffB[i] = (unsigned)(Rb * K + C) * 2u; }
    const size_t kstep = (size_t)(BK * 2);
    const size_t hstep = (size_t)HALF * K * 2;
    const size_t tstep = 2 * hstep;
    const unsigned ldsw = (unsigned)wid * 1024u;
    const int aoff = lds_byte(wr * 64 + fr, fq * 8), boff = lds_byte(wc * 32 + fr, fq * 8);
#define PG8_SA(b, h) (((b) * 2 + (h)) * HTB)
#define PG8_SB(b, h) ((4 + (b) * 2 + (h)) * HTB)
#define PG8_STAGE(bufoff, gbase, voff) do { _Pragma("unroll") for (int _i = 0; _i < 2; ++_i) \
        __builtin_amdgcn_global_load_lds((const unsigned*)((const char*)(gbase) + (voff)[_i]), (PG8_LAS unsigned*)(lds + (bufoff) + ldsw + _i * 8192), 16, 0, 0); } while (0)
#define PG8_LDA(dst, b, h) do { _Pragma("unroll") for (int m = 0; m < 4; ++m) _Pragma("unroll") for (int k = 0; k < 2; ++k) dst[m][k] = *(const PG8_LAS bf16x8*)(lds + PG8_SA(b, h) + aoff + m * 2048 + k * 1024); } while (0)
#define PG8_LDB(dst, b, h) do { _Pragma("unroll") for (int n = 0; n < 2; ++n) _Pragma("unroll") for (int k = 0; k < 2; ++k) dst[n][k] = *(const PG8_LAS bf16x8*)(lds + PG8_SB(b, h) + boff + n * 2048 + k * 1024); } while (0)
#define PG8_MMA(ai, bj, At, Bt) do { __builtin_amdgcn_s_setprio(1); _Pragma("unroll") for (int m = 0; m < 4; ++m) _Pragma("unroll") for (int n = 0; n < 2; ++n) _Pragma("unroll") for (int k = 0; k < 2; ++k) \
        acc[ai][bj][m][n] = __builtin_amdgcn_mfma_f32_16x16x32_bf16(Bt[n][k], At[m][k], acc[ai][bj][m][n], 0, 0, 0); __builtin_amdgcn_s_setprio(0); } while (0)
#define PG8_WAIT_V(n) asm volatile("s_waitcnt vmcnt(" #n ")" ::: "memory")
#define PG8_WAIT_L(n) asm volatile("s_waitcnt lgkmcnt(" #n ")" ::: "memory")
#define PG8_BAR __builtin_amdgcn_s_barrier()
#define PG8_SCHED __builtin_amdgcn_sched_barrier(0)
    Unit cur, nxt; int ui = 0;
    if (!S.next(0, cur)) return;
    f32x4 acc[2][2][4][2];
#pragma unroll
    for (int a = 0; a < 2; ++a)
#pragma unroll
        for (int b = 0; b < 2; ++b)
#pragma unroll
            for (int m = 0; m < 4; ++m)
#pragma unroll
                for (int n = 0; n < 2; ++n) acc[a][b][m][n] = (f32x4){0.f, 0.f, 0.f, 0.f};
    bf16x8 At[4][2], B0[2][2], B1[2][2];
    const char* cA = (const char*)g.A + (size_t)cur.pm * tstep; const char* cB = (const char*)g.Bt + (size_t)cur.pn * tstep;
    S.a_ready(cur);
    if constexpr (SP2) {
        PG8_STAGE(PG8_SB(0, 0), cB, voffB); PG8_STAGE(PG8_SB(0, 1), cB + hstep, voffB); PG8_STAGE(PG8_SA(0, 0), cA, voffA); PG8_STAGE(PG8_SA(0, 1), cA + hstep, voffA);
        if (wr == 1) PG8_BAR;
        PG8_WAIT_V(2); PG8_BAR;
        PG8_STAGE(PG8_SB(1, 0), cB + kstep, voffB); PG8_STAGE(PG8_SA(1, 0), cA + kstep, voffA); PG8_STAGE(PG8_SB(1, 1), cB + hstep + kstep, voffB);
        PG8_WAIT_V(6); PG8_BAR;
    } else {
        PG8_STAGE(PG8_SB(0, 0), cB, voffB); PG8_STAGE(PG8_SA(0, 0), cA, voffA); PG8_STAGE(PG8_SB(0, 1), cB + hstep, voffB); PG8_STAGE(PG8_SA(0, 1), cA + hstep, voffA);
        if (wr == 1) PG8_BAR;
        PG8_WAIT_V(4); PG8_BAR;
        PG8_STAGE(PG8_SB(1, 0), cB + kstep, voffB); PG8_STAGE(PG8_SA(1, 0), cA + kstep, voffA); PG8_STAGE(PG8_SB(1, 1), cB + hstep + kstep, voffB);
        PG8_WAIT_V(6); PG8_BAR;
    }
    for (;;) {
        const bool has_next = S.next(ui + 1, nxt);
        const char* nA = has_next ? (const char*)g.A + (size_t)nxt.pm * tstep : cA; const char* nB = has_next ? (const char*)g.Bt + (size_t)nxt.pn * tstep : cB;
        for (int t = 0; t < nt; t += 2) {
            const bool last = (t == nt - 2);
            const char* a1 = cA + (size_t)(t + 1) * kstep;
            const char* a2 = last ? nA : cA + (size_t)(t + 2) * kstep; const char* b2 = last ? nB : cB + (size_t)(t + 2) * kstep;
            const char* a3 = a2 + kstep; const char* b3 = b2 + kstep;
            if (last && has_next) S.a_ready(nxt);
            if constexpr (SP2) {
            PG8_LDB(B0, 0, 0); PG8_LDB(B1, 0, 1); PG8_SCHED; PG8_LDA(At, 0, 0); PG8_STAGE(PG8_SA(1, 1), a1 + hstep, voffA);
            PG8_WAIT_V(8); PG8_WAIT_L(0); PG8_BAR; PG8_MMA(0, 0, At, B0); PG8_MMA(0, 1, At, B1); PG8_BAR; PG8_SCHED;
            PG8_LDA(At, 0, 1); PG8_STAGE(PG8_SB(0, 0), b2, voffB); PG8_STAGE(PG8_SB(0, 1), b2 + hstep, voffB); PG8_STAGE(PG8_SA(0, 0), a2, voffA);
            PG8_WAIT_V(8); PG8_WAIT_L(0); PG8_BAR; PG8_MMA(1, 0, At, B0); PG8_MMA(1, 1, At, B1); PG8_BAR; PG8_SCHED;
            PG8_LDB(B0, 1, 0); PG8_LDB(B1, 1, 1); PG8_SCHED; PG8_LDA(At, 1, 0); PG8_STAGE(PG8_SA(0, 1), a2 + hstep, voffA);
            PG8_WAIT_V(8); PG8_WAIT_L(0); PG8_BAR; PG8_MMA(0, 0, At, B0); PG8_MMA(0, 1, At, B1); PG8_BAR; PG8_SCHED;
            PG8_LDA(At, 1, 1); PG8_STAGE(PG8_SB(1, 0), b3, voffB); PG8_STAGE(PG8_SB(1, 1), b3 + hstep, voffB); PG8_STAGE(PG8_SA(1, 0), a3, voffA);
            PG8_WAIT_V(8); PG8_WAIT_L(0); PG8_BAR; PG8_MMA(1, 0, At, B0); PG8_MMA(1, 1, At, B1); PG8_BAR; PG8_SCHED;
            } else {
            PG8_LDB(B0, 0, 0); PG8_SCHED; PG8_LDA(At, 0, 0); PG8_STAGE(PG8_SA(1, 1), a1 + hstep, voffA);
            PG8_WAIT_L(8); PG8_BAR; PG8_WAIT_L(0); PG8_MMA(0, 0, At, B0); PG8_BAR; PG8_SCHED;
            PG8_LDB(B1, 0, 1); PG8_STAGE(PG8_SB(0, 0), b2, voffB);
            PG8_BAR; PG8_WAIT_L(0); PG8_MMA(0, 1, At, B1); PG8_BAR;
            PG8_LDA(At, 0, 1); PG8_STAGE(PG8_SA(0, 0), a2, voffA);
            PG8_BAR; PG8_WAIT_L(0); PG8_MMA(1, 0, At, B0); PG8_BAR; PG8_SCHED;
            PG8_STAGE(PG8_SB(0, 1), b2 + hstep, voffB);
            PG8_WAIT_V(6); PG8_BAR; PG8_MMA(1, 1, At, B1); PG8_BAR;
            PG8_LDB(B0, 1, 0); PG8_SCHED; PG8_LDA(At, 1, 0); PG8_STAGE(PG8_SA(0, 1), a2 + hstep, voffA);
            PG8_WAIT_L(8); PG8_BAR; PG8_WAIT_L(0); PG8_MMA(0, 0, At, B0); PG8_BAR; PG8_SCHED;
            PG8_LDB(B1, 1, 1); PG8_STAGE(PG8_SB(1, 0), b3, voffB);
            PG8_BAR; PG8_WAIT_L(0); PG8_MMA(0, 1, At, B1); PG8_BAR;
            PG8_LDA(At, 1, 1); PG8_STAGE(PG8_SA(1, 0), a3, voffA);
            PG8_BAR; PG8_WAIT_L(0); PG8_MMA(1, 0, At, B0); PG8_BAR; PG8_SCHED;
            PG8_STAGE(PG8_SB(1, 1), b3 + hstep, voffB);
            PG8_WAIT_V(6); PG8_BAR; PG8_MMA(1, 1, At, B1); PG8_BAR;
            }
        }
        if constexpr (ALIGN_EPI) { if (wr == 0) PG8_BAR; }
        if constexpr (!Epi::AFTER_DRAIN) { E(acc, cur, wr, wc, fr, fq); S.done(cur); }
        if (!has_next) break;
#pragma unroll
        for (int a = 0; a < 2; ++a)
#pragma unroll
            for (int b = 0; b < 2; ++b)
#pragma unroll
                for (int m = 0; m < 4; ++m)
#pragma unroll
                    for (int n = 0; n < 2; ++n) acc[a][b][m][n] = (f32x4){0.f, 0.f, 0.f, 0.f};
        cur = nxt; cA = nA; cB = nB; ++ui;
        if constexpr (ALIGN_EPI) { if (wr == 1) PG8_BAR; }
    }
    PG8_WAIT_V(0);
    if constexpr (!ALIGN_EPI) { if (wr == 0) PG8_BAR; }
    PG8_BAR;
    if constexpr (Epi::AFTER_DRAIN) { E.fused(acc, cur, wr, wc, fr, fq, lds, wid, lane); S.done(cur); }
#undef PG8_SA
#undef PG8_SB
#undef PG8_STAGE
#undef PG8_LDA
#undef PG8_LDB
#undef PG8_MMA
#undef PG8_WAIT_V
#undef PG8_WAIT_L
#undef PG8_BAR
#undef PG8_SCHED
}
}
constexpr int NWAVES = 8;
constexpr int DM = 1024, MP = 16384, SEQ = 2048, NB = 8, MS = 128;
constexpr int INC = 2064, INP = 2048;
constexpr int C_Q = 512, C_K = 768, C_V = 1024, C_G = 1536, C_F = 2048;
constexpr int FF = 4096;
constexpr float EPS = 1e-6f;
constexpr size_t O_YP = 0, O_YS = 16777216, O_SPP = O_YS + 131072, O_SGP = O_SPP + 61440, O_KP = O_SGP + 262144, O_VP = O_KP + 2097152, O_SPS = O_VP + 2097152, O_SGS = O_SPS + 983040;
constexpr size_t MiB = 1u << 20;
constexpr size_t WS_WIN = 2 * MiB, WS_WKV = 8 * MiB, WS_WOUT = 12 * MiB, WS_WQM = 14 * MiB, WS_WOM = 16 * MiB, WS_WUP = 18 * MiB, WS_WDN = 26 * MiB;
constexpr size_t WS_MN = 34 * MiB, WS_KB = 38 * MiB, WS_VT = 42 * MiB, WS_SSQ1 = 46 * MiB, WS_SSQ2 = 47 * MiB, WS_SSQ0 = 48 * MiB  , WS_FLOW = 58 * MiB  ;
constexpr size_t WS_PROJS = 49 * MiB  , WS_MIXS = 51 * MiB  , WS_QS = 52 * MiB, WS_CTXS = 53 * MiB, WS_HFFS = 54 * MiB  , WS_PARTS = 56 * MiB  ;
constexpr size_t WS_H = 64 * MiB  , WS_XB = 96 * MiB, WS_Q = 128 * MiB, WS_CTX = 160 * MiB;
constexpr size_t WS_PROJ = 192 * MiB  , WS_GL = 264 * MiB  , WS_CUM = 296 * MiB  , WS_ST = 312 * MiB  ;
constexpr size_t WS_HFF = 192 * MiB  ;
constexpr size_t WS_END = 328 * MiB;
constexpr int LDS_BYTES = 147456;

#define LAS __attribute__((address_space(3)))
typedef unsigned short bf16;
typedef unsigned u32x4 __attribute__((ext_vector_type(4)));
typedef unsigned u32x2 __attribute__((ext_vector_type(2)));
typedef float f32x4 __attribute__((ext_vector_type(4)));
typedef short bf16x8 __attribute__((ext_vector_type(8)));
typedef short bf16x4 __attribute__((ext_vector_type(4)));
#define LDS_WAIT() asm volatile("s_waitcnt lgkmcnt(0)" ::: "memory")
__device__ __forceinline__ unsigned pk2(float lo, float hi) { return pg8::cvt_pk_bf16(lo, hi); }
__device__ __forceinline__ float bf2f(unsigned short h) { return __uint_as_float((unsigned)h << 16); }
__device__ __forceinline__ float bflo(unsigned w) { return __uint_as_float(w << 16); }
__device__ __forceinline__ float bfhi(unsigned w) { return __uint_as_float(w & 0xffff0000u); }
__device__ __forceinline__ float wave_sum(float v) {
#pragma unroll
    for (int o = 1; o < 64; o <<= 1) v += __shfl_xor(v, o);
    return v;
}
__device__ __forceinline__ float wave_max(float v) {
#pragma unroll
    for (int o = 1; o < 64; o <<= 1) v = fmaxf(v, __shfl_xor(v, o));
    return v;
}
__device__ __forceinline__ float logsig(float x) { return fminf(x, 0.f) - log1pf(__expf(-fabsf(x))); }
__device__ __forceinline__ float silu(float x) { return x / (1.f + __expf(-x)); }
__device__ __forceinline__ f32x4 mfma16(bf16x8 a, bf16x8 b, f32x4 c) { return __builtin_amdgcn_mfma_f32_16x16x32_bf16(a, b, c, 0, 0, 0); }

struct Frame {
    LAS unsigned char* lds;
    int wave, G, blk;
    const float* in[25]; float* out; unsigned char* ws;
};
#define WSP(T, off) ((T*)(F.ws + (off)))

__device__ __forceinline__ void rows16_pass(const float* X, bf16* XB16, float* ssq, float* FL, const LAS bf16* Wf, int row0, int lane) {
    const int r = lane & 15, q = lane >> 4;
    const float* xp = X + (size_t)(row0 + r) * DM + q * 8; bf16* hp = XB16 + (size_t)(row0 + r) * DM + q * 8;
    f32x4 acc = {0.f, 0.f, 0.f, 0.f}; float ss = 0.f;
#pragma unroll 1
    for (int c0 = 0; c0 < 32; c0 += 8) { f32x4 a[16];
#pragma unroll
        for (int u = 0; u < 8; ++u) { a[2 * u] = __builtin_nontemporal_load((const f32x4*)(xp + (c0 + u) * 32)); a[2 * u + 1] = __builtin_nontemporal_load((const f32x4*)(xp + (c0 + u) * 32 + 4)); }
#pragma unroll
        for (int u = 0; u < 8; ++u) { const f32x4 a0 = a[2 * u], a1 = a[2 * u + 1];
            ss += ((a0[0] * a0[0] + a0[1] * a0[1]) + (a0[2] * a0[2] + a0[3] * a0[3])) + ((a1[0] * a1[0] + a1[1] * a1[1]) + (a1[2] * a1[2] + a1[3] * a1[3]));
            u32x4 aw; aw.x = pk2(a0[0], a0[1]); aw.y = pk2(a0[2], a0[3]); aw.z = pk2(a1[0], a1[1]); aw.w = pk2(a1[2], a1[3]);
            *(u32x4*)(hp + (c0 + u) * 32) = aw;
            if (FL) { const bf16x8 wfr = *(const LAS bf16x8*)(Wf + r * 1032 + (c0 + u) * 32 + q * 8); acc = mfma16(wfr, __builtin_bit_cast(bf16x8, aw), acc); } } }
    ss += __shfl_xor(ss, 16); ss += __shfl_xor(ss, 32);
    if (q == 0) ssq[row0 + r] = ss;
    if (FL) { acc = acc * rsqrtf(ss * (1.f / DM) + EPS); *(f32x4*)(FL + (size_t)(row0 + r) * 16 + q * 4) = acc; }
}
__device__ __forceinline__ void p0_prologue(const Frame& F) {
    const int lane = pg8::pg8_lane_id(), tid = F.wave * 64 + lane; (void)tid;
    LAS bf16* Wf = (LAS bf16*)(F.lds + 98304);
    { const float* win = F.in[8]; const float* gm = F.in[7];
#pragma unroll
      for (int kk = 0; kk < 2; ++kk) { const int k = tid * 2 + kk; const float g = gm[k]; const f32x4* wr = (const f32x4*)(win + (size_t)k * INC + 2048);
#pragma unroll
          for (int j4 = 0; j4 < 4; ++j4) { const f32x4 w = wr[j4];
#pragma unroll
              for (int e = 0; e < 4; ++e) Wf[(j4 * 4 + e) * 1032 + k] = (bf16)(pk2(w[e] * g, 0.f) & 0xffffu); } } }
    __syncthreads();
    { const float* wp = F.in[11]; const float* ps = F.in[12]; const float* wo = F.in[14]; bf16* wt = WSP(bf16, WS_WOUT);
      LAS float* Wp = (LAS float*)F.lds; LAS float* Wo = (LAS float*)(F.lds + 65536);
      for (int it = F.blk; it < 64; it += F.G) { const int g = it >> 4, n0 = (it & 15) * 64;
#pragma unroll
          for (int i = 0; i < 8; ++i) { const int i4 = (i * 512 + tid) * 4; *(LAS f32x4*)(Wp + i4) = *(const f32x4*)(wp + (size_t)g * 16384 + i4); }
#pragma unroll
          for (int i = 0; i < 16; ++i) { const int e = i * 512 + tid, d = e >> 6, nn = e & 63; Wo[e] = wo[(size_t)(g * 128 + d) * DM + n0 + nn] * ps[g * 128 + d]; }
          __syncthreads();
          const int n = tid & 63; float acc[16];
#pragma unroll
          for (int ci = 0; ci < 16; ++ci) acc[ci] = 0.f;
#pragma unroll 2
          for (int d4 = 0; d4 < 32; ++d4) { const float a0 = Wo[(d4 * 4 + 0) * 64 + n], a1 = Wo[(d4 * 4 + 1) * 64 + n], a2 = Wo[(d4 * 4 + 2) * 64 + n], a3 = Wo[(d4 * 4 + 3) * 64 + n];
#pragma unroll
              for (int ci = 0; ci < 16; ++ci) { const f32x4 w4 = *(const LAS f32x4*)(Wp + (F.wave * 16 + ci) * 128 + d4 * 4); acc[ci] += (w4[0] * a0 + w4[1] * a1) + (w4[2] * a2 + w4[3] * a3); } }
          u32x4* dst = (u32x4*)(wt + (size_t)(n0 + n) * DM + g * 128 + F.wave * 16);
          dst[0] = (u32x4){pk2(acc[0], acc[1]), pk2(acc[2], acc[3]), pk2(acc[4], acc[5]), pk2(acc[6], acc[7])};
          dst[1] = (u32x4){pk2(acc[8], acc[9]), pk2(acc[10], acc[11]), pk2(acc[12], acc[13]), pk2(acc[14], acc[15])};
          __syncthreads(); } }
    const int gw = F.blk * NWAVES + F.wave, NGW = F.G * NWAVES;
    { constexpr int I_IN = 8 * 9, I_SQ = 8 * 4, I_OUT = 4 * 4, I_UP = 8 * 16, I_DN = 32 * 4;
      constexpr int NITEMS = I_IN + 2 * I_SQ + I_OUT + 2 * I_SQ + I_UP + I_DN;
      LAS bf16* T = (LAS bf16*)F.lds;
      for (int it = (F.blk + 192) % F.G; it < NITEMS; it += F.G) {
        int r = it; const float* W; const float* gain = nullptr; bf16* WT; int ldw, nreal, ldt = DM, row_off = 0, nb = 4, kofs = 0;
        if (r < I_IN) { W = F.in[8]; ldw = INC; nreal = INC; WT = WSP(bf16, WS_WIN); gain = F.in[7]; nb = 9; }
        else if ((r -= I_IN) < I_SQ) { W = F.in[16]; ldw = DM; nreal = DM; WT = WSP(bf16, WS_WKV); gain = F.in[15]; }
        else if ((r -= I_SQ) < I_SQ) { W = F.in[17]; ldw = DM; nreal = DM; WT = WSP(bf16, WS_WKV); gain = F.in[15]; row_off = DM; }
        else if ((r -= I_SQ) < I_OUT) { W = F.in[14]; ldw = DM; nreal = DM; WT = WSP(bf16, WS_WOUT); kofs = 512; }
        else if ((r -= I_OUT) < I_SQ) { W = F.in[19]; ldw = DM; nreal = DM; WT = WSP(bf16, WS_WQM); gain = F.in[18]; }
        else if ((r -= I_SQ) < I_SQ) { W = F.in[20]; ldw = DM; nreal = DM; WT = WSP(bf16, WS_WOM); }
        else if ((r -= I_SQ) < I_UP) { W = F.in[22]; ldw = FF; nreal = FF; WT = WSP(bf16, WS_WUP); gain = F.in[21]; nb = 16; }
        else { r -= I_UP; W = F.in[23]; ldw = DM; nreal = DM; WT = WSP(bf16, WS_WDN); ldt = FF; }
        const int k0 = kofs + 128 * (r / nb), n0 = 256 * (r % nb);
        f32x4 tv[16];
#pragma unroll
        for (int i = 0; i < 16; ++i) { const int idx = i * 512 + tid, kk = idx >> 6, n = n0 + (idx & 63) * 4;
            tv[i] = (f32x4){0.f, 0.f, 0.f, 0.f}; if (n < nreal) tv[i] = __builtin_nontemporal_load((const f32x4*)(W + (size_t)(k0 + kk) * ldw + n)); }
#pragma unroll
        for (int i = 0; i < 16; ++i) { const int idx = i * 512 + tid, kk = idx >> 6; const float g = gain ? gain[k0 + kk] : 1.f; const f32x4 v = tv[i] * g;
            u32x2 o; o.x = pk2(v[0], v[1]); o.y = pk2(v[2], v[3]); *(LAS u32x2*)(T + kk * 256 + (idx & 63) * 4) = o; }
        __syncthreads();
        { const int n = tid & 255;
#pragma unroll
          for (int i = 0; i < 8; ++i) { const int kg = (tid >> 8) + 2 * i; const LAS bf16* tp = T + (kg * 8) * 256 + n;
              u32x4 o; o.x = tp[0] | ((unsigned)tp[256] << 16); o.y = tp[512] | ((unsigned)tp[768] << 16); o.z = tp[1024] | ((unsigned)tp[1280] << 16); o.w = tp[1536] | ((unsigned)tp[1792] << 16);
              *(u32x4*)(WT + (size_t)(row_off + n0 + n) * ldt + k0 + kg * 8) = o; } }
        __syncthreads();
      } }
    for (int it = gw; it < MP / 16 + (NB * 256) / 16; it += NGW) {
        if (it < MP / 16) rows16_pass(F.in[0], WSP(bf16, WS_H), WSP(float, WS_SSQ0), WSP(float, WS_FLOW), Wf, it * 16, lane);
        else rows16_pass(F.in[6], WSP(bf16, WS_MN), WSP(float, WS_SSQ0) + MP, nullptr, Wf, (it - MP / 16) * 16, lane); }
}

template <bool NORM, class Epi>
__device__ __forceinline__ void skinny_gemm(const Frame& F, const float* A, int lda, const bf16* Bt, int ldb, int K, int nslab, int ksplit, const Epi& E) {
    const int lane = pg8::pg8_lane_id(), tid = F.wave * 64 + lane; (void)tid;
    const int fr = lane & 15, fq = lane >> 4;
    for (int item = F.blk; item < nslab * ksplit; item += F.G) {
        const int slab = item % nslab, ks = item / nslab;
        const float* ap = A + (size_t)(F.wave * 16 + fr) * lda + (size_t)ks * K + fq * 8;
        const bf16* bp = Bt + (size_t)(slab * 16 + fr) * ldb + (size_t)ks * K + fq * 8;
        f32x4 acc = {0.f, 0.f, 0.f, 0.f}; float ss = 0.f;
#pragma unroll 1
        for (int k0 = 0; k0 < K; k0 += 256) {
            f32x4 a[16]; bf16x8 b[8];
#pragma unroll
            for (int u = 0; u < 8; ++u) { a[2 * u] = *(const f32x4*)(ap + k0 + u * 32); a[2 * u + 1] = *(const f32x4*)(ap + k0 + u * 32 + 4); b[u] = *(const bf16x8*)(bp + k0 + u * 32); }
#pragma unroll
            for (int u = 0; u < 8; ++u) { const f32x4 a0 = a[2 * u], a1 = a[2 * u + 1];
                if (NORM) ss += ((a0[0] * a0[0] + a0[1] * a0[1]) + (a0[2] * a0[2] + a0[3] * a0[3])) + ((a1[0] * a1[0] + a1[1] * a1[1]) + (a1[2] * a1[2] + a1[3] * a1[3]));
                u32x4 aw; aw.x = pk2(a0[0], a0[1]); aw.y = pk2(a0[2], a0[3]); aw.z = pk2(a1[0], a1[1]); aw.w = pk2(a1[2], a1[3]);
                acc = mfma16(b[u], __builtin_bit_cast(bf16x8, aw), acc); }
        }
        if (NORM) { ss += __shfl_xor(ss, 16); ss += __shfl_xor(ss, 32); acc = acc * rsqrtf(ss / (float)K + EPS); }
        E(F.wave * 16 + fr, slab * 16 + fq * 4, ks, acc);
    }
}
struct SEpiStore { float* O; int ldc; float scale; __device__ __forceinline__ void operator()(int row, int col, int, f32x4 v) const { *(f32x4*)(O + (size_t)row * ldc + col) = v * scale; } };
struct SEpiPart  { float* O; __device__ __forceinline__ void operator()(int row, int col, int ks, f32x4 v) const { *(f32x4*)(O + ((size_t)ks * MS + row) * DM + col) = v; } };
struct SEpiRes   { const float* base; float* O; __device__ __forceinline__ void operator()(int row, int col, int, f32x4 v) const { const f32x4 b = *(const f32x4*)(base + (size_t)row * DM + col); *(f32x4*)(O + (size_t)row * DM + col) = b + v; } };
struct SEpiRelu2 { float* O; __device__ __forceinline__ void operator()(int row, int col, int, f32x4 v) const { f32x4 o;
#pragma unroll
    for (int e = 0; e < 4; ++e) { const float a = fmaxf(v[e], 0.f); o[e] = a * a; } *(f32x4*)(O + (size_t)row * FF + col) = o; } };
__device__ __forceinline__ void p2_pool_prompt(const Frame& F) {
    const bf16* proj = WSP(const bf16, WS_PROJ); bf16* mixed = WSP(bf16, WS_H);
    const int lane = pg8::pg8_lane_id(), tid = F.wave * 64 + lane; (void)tid;
    const int c8 = lane * 8, g = lane >> 4, w = 2 << g;
    for (int it = F.blk; it < MP / 64; it += F.G) {
        const int row0 = it * 64 + F.wave * 8, t0 = row0 & (SEQ - 1), b = row0 >> 11;
        u32x4 rw[23];
#pragma unroll
        for (int i = 0; i < 23; ++i) { rw[i] = (u32x4){0u, 0u, 0u, 0u}; if (t0 + i - 15 >= 0) rw[i] = *(const u32x4*)(proj + (size_t)(row0 + i - 15) * INP + c8); }
        float cs[23][8];
#pragma unroll
        for (int i = 0; i < 23; ++i) { const float u[8] = {bflo(rw[i].x), bfhi(rw[i].x), bflo(rw[i].y), bfhi(rw[i].y), bflo(rw[i].z), bfhi(rw[i].z), bflo(rw[i].w), bfhi(rw[i].w)};
#pragma unroll
            for (int e2 = 0; e2 < 8; ++e2) cs[i][e2] = (i ? cs[i - 1][e2] : 0.f) + u[e2]; }
#pragma unroll
        for (int i = 0; i < 8; ++i) { const int t = t0 + i, cnt = (t + 1 < w) ? (t + 1) : w; const float inv = 1.f / (float)cnt; float o[8]; const u32x4 ur = rw[15 + i]; const float un[8] = {bflo(ur.x), bfhi(ur.x), bflo(ur.y), bfhi(ur.y), bflo(ur.z), bfhi(ur.z), bflo(ur.w), bfhi(ur.w)};
#pragma unroll
            for (int e2 = 0; e2 < 8; ++e2) { const float lo2 = cs[15 + i - 2][e2], lo4 = cs[15 + i - 4][e2], lo8 = cs[15 + i - 8][e2], lo16 = (i ? cs[i - 1][e2] : 0.f);
                const float lo = (g == 0) ? lo2 : (g == 1) ? lo4 : (g == 2) ? lo8 : lo16;
                o[e2] = (cs[15 + i][e2] - lo) * inv - un[e2]; }
            u32x4 ov; ov.x = pk2(o[0], o[1]); ov.y = pk2(o[2], o[3]); ov.z = pk2(o[4], o[5]); ov.w = pk2(o[6], o[7]);
            *(u32x4*)(mixed + (size_t)(row0 + i) * DM + c8) = ov;
            if (t >= SEQ - 15) { float* sp = F.out + O_SPP + ((size_t)b * 15 + (t - (SEQ - 15))) * 512 + c8; *(f32x4*)sp = (f32x4){un[0], un[1], un[2], un[3]}; *(f32x4*)(sp + 4) = (f32x4){un[4], un[5], un[6], un[7]}; } }
    }
}
__device__ __forceinline__ void p2_gla_local(const Frame& F) {
    const bf16* proj = WSP(const bf16, WS_PROJ); float* GL = WSP(float, WS_GL); float* CUM = WSP(float, WS_CUM);
    LAS float* fl = (LAS float*)(F.lds);
    LAS float* segt = (LAS float*)(F.lds + 4096);
    LAS bf16* Aop = (LAS bf16*)(F.lds + 8192);
    LAS bf16* Bop = (LAS bf16*)(F.lds + 8192 + 9216);
    const int lane = pg8::pg8_lane_id(), tid = F.wave * 64 + lane; const int wave = F.wave, fr = lane & 15, fq = lane >> 4;
    for (int unit = F.blk; unit < 1024; unit += F.G) {
        const int b = unit >> 7, n = (unit >> 2) & 31, h = unit & 3; const size_t r0 = (size_t)b * SEQ + n * 64;
        for (int e = tid; e < 1024; e += 512) fl[e] = WSP(const float, WS_FLOW)[r0 * 16 + e];
        const int d = tid & 63, seg = tid >> 6;
        float wf[16];
#pragma unroll
        for (int r = 0; r < 16; ++r) wf[r] = F.in[9][r * 256 + h * 64 + d];
        const float bias = F.in[10][h * 64 + d];
        __syncthreads();
        float cum[8]; float run = 0.f;
#pragma unroll
        for (int i = 0; i < 8; ++i) { const int t = seg * 8 + i; float pre = bias;
#pragma unroll
            for (int r = 0; r < 16; ++r) pre += fl[t * 16 + r] * wf[r];
            run += logsig(pre) * (1.f / 16.f); cum[i] = run; }
        segt[seg * 64 + d] = run;
        __syncthreads();
        float pre_s = 0.f, tot = 0.f;
#pragma unroll
        for (int s2 = 0; s2 < 8; ++s2) { const float v = segt[s2 * 64 + d]; tot += v; if (s2 < seg) pre_s += v; }
        float ke[8];
#pragma unroll
        for (int i = 0; i < 8; ++i) { const int t = seg * 8 + i; cum[i] += pre_s; CUM[(size_t)unit * 4096 + t * 64 + d] = cum[i];
            ke[i] = bf2f(proj[(r0 + t) * INP + C_K + h * 64 + d]) * __expf(tot - cum[i]); }
        { u32x4 o; o.x = pk2(ke[0], ke[1]); o.y = pk2(ke[2], ke[3]); o.z = pk2(ke[4], ke[5]); o.w = pk2(ke[6], ke[7]); *(LAS u32x4*)(Aop + d * 72 + seg * 8) = o; }
        { const int dv = tid & 127, ts = tid >> 7; unsigned short vv[16];
#pragma unroll
          for (int i = 0; i < 16; ++i) vv[i] = proj[(r0 + ts * 16 + i) * INP + C_V + h * 128 + dv];
          u32x4 o0, o1; o0.x = vv[0] | ((unsigned)vv[1] << 16); o0.y = vv[2] | ((unsigned)vv[3] << 16); o0.z = vv[4] | ((unsigned)vv[5] << 16); o0.w = vv[6] | ((unsigned)vv[7] << 16);
          o1.x = vv[8] | ((unsigned)vv[9] << 16); o1.y = vv[10] | ((unsigned)vv[11] << 16); o1.z = vv[12] | ((unsigned)vv[13] << 16); o1.w = vv[14] | ((unsigned)vv[15] << 16);
          *(LAS u32x4*)(Bop + dv * 72 + ts * 16) = o0; *(LAS u32x4*)(Bop + dv * 72 + ts * 16 + 8) = o1; }
        __syncthreads();
        const int mi = wave & 3;
#pragma unroll
        for (int jj = 0; jj < 4; ++jj) { const int nj = (wave >> 2) * 4 + jj; f32x4 acc = {0.f, 0.f, 0.f, 0.f};
#pragma unroll
            for (int ks = 0; ks < 2; ++ks) { const bf16x8 a = *(const LAS bf16x8*)(Aop + (mi * 16 + fr) * 72 + ks * 32 + fq * 8); const bf16x8 bb = *(const LAS bf16x8*)(Bop + (nj * 16 + fr) * 72 + ks * 32 + fq * 8);
                acc = mfma16(bb, a, acc); }
            *(f32x4*)(GL + (size_t)unit * 8192 + (mi * 16 + fr) * 128 + nj * 16 + fq * 4) = acc; }
        __syncthreads();
    }
}
__device__ __forceinline__ void p3_gla_scan(const Frame& F) {
    const float* GL = WSP(const float, WS_GL); const float* CUM = WSP(const float, WS_CUM); bf16* ST = WSP(bf16, WS_ST);
    const int lane = pg8::pg8_lane_id(), tid = F.wave * 64 + lane; (void)tid;
    for (int e = F.blk * 512 + tid; e < 65536; e += F.G * 512) {
        const int dv = e & 127, dg = (e >> 7) & 15, bh = e >> 11, b = bh >> 2, h = bh & 3;
        float S[4] = {0.f, 0.f, 0.f, 0.f};
#pragma unroll 8
        for (int n = 0; n < 32; ++n) { const size_t unit = (size_t)(b * 32 + n) * 4 + h;
            const f32x4 cl = *(const f32x4*)(CUM + unit * 4096 + 63 * 64 + dg * 4);
            float Lv[4];
#pragma unroll
            for (int i = 0; i < 4; ++i) Lv[i] = __builtin_nontemporal_load(GL + unit * 8192 + (dg * 4 + i) * 128 + dv);
            u32x2 o; o.x = pk2(S[0], S[1]); o.y = pk2(S[2], S[3]); *(u32x2*)(ST + unit * 8192 + dv * 64 + dg * 4) = o;
#pragma unroll
            for (int i = 0; i < 4; ++i) S[i] = __expf(cl[i]) * S[i] + Lv[i]; }
#pragma unroll
        for (int i = 0; i < 4; ++i) F.out[O_SGP + ((size_t)(b * 4 + h) * 64 + dg * 4 + i) * 128 + dv] = S[i];
    }
}
__device__ __forceinline__ void p4_gla_out(const Frame& F) {
    const bf16* proj = WSP(const bf16, WS_PROJ); const float* CUM = WSP(const float, WS_CUM); const bf16* ST = WSP(const bf16, WS_ST); bf16* mixed = WSP(bf16, WS_H);
    LAS bf16* Aq = (LAS bf16*)(F.lds);
    LAS bf16* Bk = (LAS bf16*)(F.lds + 9216);
    LAS bf16* Bv = (LAS bf16*)(F.lds + 18432);
    LAS bf16* Bs = (LAS bf16*)(F.lds + 36864);
    LAS bf16* Ap = (LAS bf16*)(F.lds + 55296);
    LAS float* red = (LAS float*)(F.lds + 64512);
    const int lane = pg8::pg8_lane_id(), tid = F.wave * 64 + lane; const int wave = F.wave, fr = lane & 15, fq = lane >> 4;
    for (int unit = F.blk; unit < 1024; unit += F.G) {
        const int b = unit >> 7, n = (unit >> 2) & 31, h = unit & 3; const size_t r0 = (size_t)b * SEQ + n * 64;
        { const int t = tid >> 3, d8 = (tid & 7) * 8;
          const f32x4 c0 = *(const f32x4*)(CUM + (size_t)unit * 4096 + t * 64 + d8), c1 = *(const f32x4*)(CUM + (size_t)unit * 4096 + t * 64 + d8 + 4);
          const u32x4 qw = *(const u32x4*)(proj + (r0 + t) * INP + C_Q + h * 64 + d8), kw = *(const u32x4*)(proj + (r0 + t) * INP + C_K + h * 64 + d8);
          float cu[8] = {c0[0], c0[1], c0[2], c0[3], c1[0], c1[1], c1[2], c1[3]};
          float qv[8] = {bflo(qw.x), bfhi(qw.x), bflo(qw.y), bfhi(qw.y), bflo(qw.z), bfhi(qw.z), bflo(qw.w), bfhi(qw.w)};
          float kv[8] = {bflo(kw.x), bfhi(kw.x), bflo(kw.y), bfhi(kw.y), bflo(kw.z), bfhi(kw.z), bflo(kw.w), bfhi(kw.w)};
#pragma unroll
          for (int e = 0; e < 8; ++e) { const float ex = __expf(cu[e]); qv[e] = qv[e] * 0.125f * ex; kv[e] = kv[e] / ex; }
          u32x4 o; o.x = pk2(qv[0], qv[1]); o.y = pk2(qv[2], qv[3]); o.z = pk2(qv[4], qv[5]); o.w = pk2(qv[6], qv[7]); *(LAS u32x4*)(Aq + t * 72 + d8) = o;
          o.x = pk2(kv[0], kv[1]); o.y = pk2(kv[2], kv[3]); o.z = pk2(kv[4], kv[5]); o.w = pk2(kv[6], kv[7]); *(LAS u32x4*)(Bk + t * 72 + d8) = o; }
        { const int dv = tid & 127, ts = tid >> 7; unsigned short vv[16];
#pragma unroll
          for (int i = 0; i < 16; ++i) vv[i] = proj[(r0 + ts * 16 + i) * INP + C_V + h * 128 + dv];
          u32x4 o0, o1; o0.x = vv[0] | ((unsigned)vv[1] << 16); o0.y = vv[2] | ((unsigned)vv[3] << 16); o0.z = vv[4] | ((unsigned)vv[5] << 16); o0.w = vv[6] | ((unsigned)vv[7] << 16);
          o1.x = vv[8] | ((unsigned)vv[9] << 16); o1.y = vv[10] | ((unsigned)vv[11] << 16); o1.z = vv[12] | ((unsigned)vv[13] << 16); o1.w = vv[14] | ((unsigned)vv[15] << 16);
          *(LAS u32x4*)(Bv + dv * 72 + ts * 16) = o0; *(LAS u32x4*)(Bv + dv * 72 + ts * 16 + 8) = o1; }
#pragma unroll
        for (int p = 0; p < 2; ++p) { const int pc = tid + p * 512, dv = pc >> 3, part = pc & 7;
            *(LAS u32x4*)(Bs + dv * 72 + part * 8) = *(const u32x4*)(ST + (size_t)unit * 8192 + dv * 64 + part * 8); }
        __syncthreads();
        const int mi = wave & 3;
#pragma unroll
        for (int jj = 0; jj < 2; ++jj) { const int nj = (wave >> 2) * 2 + jj; f32x4 acc = {0.f, 0.f, 0.f, 0.f};
#pragma unroll
            for (int ks = 0; ks < 2; ++ks) { const bf16x8 a = *(const LAS bf16x8*)(Aq + (mi * 16 + fr) * 72 + ks * 32 + fq * 8); const bf16x8 bb = *(const LAS bf16x8*)(Bk + (nj * 16 + fr) * 72 + ks * 32 + fq * 8);
                acc = mfma16(bb, a, acc); }
            const int i = mi * 16 + fr, j0 = nj * 16 + fq * 4;
#pragma unroll
            for (int r = 0; r < 4; ++r) if (j0 + r > i) acc[r] = 0.f;
            u32x2 o; o.x = pk2(acc[0], acc[1]); o.y = pk2(acc[2], acc[3]); *(LAS u32x2*)(Ap + i * 72 + j0) = o; }
        __syncthreads();
        f32x4 oacc[4]; float ssq = 0.f;
#pragma unroll
        for (int jj = 0; jj < 4; ++jj) { const int nj = (wave >> 2) * 4 + jj; f32x4 acc = {0.f, 0.f, 0.f, 0.f};
#pragma unroll
            for (int ks = 0; ks < 2; ++ks) {
                const bf16x8 ap = *(const LAS bf16x8*)(Ap + (mi * 16 + fr) * 72 + ks * 32 + fq * 8), bv = *(const LAS bf16x8*)(Bv + (nj * 16 + fr) * 72 + ks * 32 + fq * 8);
                acc = mfma16(bv, ap, acc);
                const bf16x8 aq = *(const LAS bf16x8*)(Aq + (mi * 16 + fr) * 72 + ks * 32 + fq * 8), bs = *(const LAS bf16x8*)(Bs + (nj * 16 + fr) * 72 + ks * 32 + fq * 8);
                acc = mfma16(bs, aq, acc); }
            oacc[jj] = acc; ssq += (acc[0] * acc[0] + acc[1] * acc[1]) + (acc[2] * acc[2] + acc[3] * acc[3]); }
        ssq += __shfl_xor(ssq, 16); ssq += __shfl_xor(ssq, 32);
        if (fq == 0) red[(wave >> 2) * 64 + mi * 16 + fr] = ssq;
        __syncthreads();
        const float rstd = rsqrtf((red[mi * 16 + fr] + red[64 + mi * 16 + fr]) * (1.f / 128.f) + EPS);
        const size_t row = r0 + mi * 16 + fr;
#pragma unroll
        for (int jj = 0; jj < 4; ++jj) { const int dv0 = ((wave >> 2) * 4 + jj) * 16 + fq * 4;
            const f32x4 gn = *(const f32x4*)(F.in[13] + h * 128 + dv0); const u32x2 gw = *(const u32x2*)(proj + row * INP + C_G + h * 128 + dv0);
            const float g0 = silu(bflo(gw.x)), g1 = silu(bfhi(gw.x)), g2 = silu(bflo(gw.y)), g3 = silu(bfhi(gw.y));
            u32x2 o; o.x = pk2(oacc[jj][0] * rstd * gn[0] * g0, oacc[jj][1] * rstd * gn[1] * g1); o.y = pk2(oacc[jj][2] * rstd * gn[2] * g2, oacc[jj][3] * rstd * gn[3] * g3);
            *(u32x2*)(mixed + row * DM + 512 + h * 128 + dv0) = o; }
        __syncthreads();
    }
}

__device__ __forceinline__ void s_mixers(const Frame& F) {
    const float* projs = WSP(const float, WS_PROJS); float* mixs = WSP(float, WS_MIXS);
    const float* spool = F.in[2]; const float* sgla = F.in[3];
    const int lane = pg8::pg8_lane_id(), tid = F.wave * 64 + lane; (void)tid;
    for (int e = F.blk * 512 + tid; e < MS * 512; e += F.G * 512) { const int b = e >> 9, c = e & 511, g = c >> 7, w = 2 << g;
        const float u = projs[(size_t)b * INC + c]; float s = u;
        for (int j = 1; j < w; ++j) s += spool[((size_t)b * 15 + 15 - j) * 512 + c];
        mixs[(size_t)b * DM + c] = s / (float)w - u;
        float* so = F.out + O_SPS + (size_t)b * 15 * 512 + c;
#pragma unroll
        for (int i = 0; i < 14; ++i) so[(size_t)i * 512] = spool[((size_t)b * 15 + i + 1) * 512 + c];
        so[(size_t)14 * 512] = u; }
    LAS float* dec = (LAS float*)(F.lds); LAS float* qs = dec + 64; LAS float* ks = dec + 128; LAS float* vs = dec + 192;
    LAS float* red = dec + 320;
    LAS float* red2 = red + 2048;
    for (int it = F.blk; it < MS * 4; it += F.G) { const int b = it >> 2, h = it & 3; const float* pr = projs + (size_t)b * INC;
        if (tid < 64) { float pre = F.in[10][h * 64 + tid];
#pragma unroll
            for (int r = 0; r < 16; ++r) pre += pr[C_F + r] * F.in[9][r * 256 + h * 64 + tid];
            dec[tid] = __expf(logsig(pre) * (1.f / 16.f)); qs[tid] = pr[C_Q + h * 64 + tid] * 0.125f; ks[tid] = pr[C_K + h * 64 + tid]; }
        else if (tid < 192) vs[tid - 64] = pr[C_V + h * 128 + (tid - 64)];
        __syncthreads();
        { const int v4 = (tid & 31) * 4, dgp = tid >> 5; const f32x4 vv = *(const LAS f32x4*)(vs + v4); f32x4 po = {0.f, 0.f, 0.f, 0.f};
#pragma unroll
          for (int i = 0; i < 4; ++i) { const int d = dgp * 4 + i; const size_t off = ((size_t)(b * 4 + h) * 64 + d) * 128 + v4;
              const f32x4 s0 = __builtin_nontemporal_load((const f32x4*)(sgla + off)); const f32x4 sn = s0 * dec[d] + vv * ks[d]; __builtin_nontemporal_store(sn, (f32x4*)(F.out + O_SGS + off)); po += sn * qs[d]; }
          *(LAS f32x4*)(red + dgp * 128 + v4) = po; }
        __syncthreads();
        float o = 0.f;
        if (tid < 128) {
#pragma unroll
            for (int g = 0; g < 16; ++g) o += red[g * 128 + tid];
            const float s2 = wave_sum(o * o); if (lane == 0) red2[tid >> 6] = s2; }
        __syncthreads();
        if (tid < 128) { const float rstd = rsqrtf((red2[0] + red2[1]) * (1.f / 128.f) + EPS);
            mixs[(size_t)b * DM + 512 + h * 128 + tid] = o * rstd * F.in[13][h * 128 + tid] * silu(pr[C_G + h * 128 + tid]); }
        __syncthreads();
    }
}
constexpr int KST = 264;
__device__ __forceinline__ void p7_attn_prompt(const Frame& F) {
    const bf16* Q = WSP(const bf16, WS_Q); const bf16* KB = WSP(const bf16, WS_KB); const bf16* VT = WSP(const bf16, WS_VT); bf16* CTX = WSP(bf16, WS_CTX);
    LAS bf16* L = (LAS bf16*)F.lds;
    const int lane = pg8::pg8_lane_id(), tid = F.wave * 64 + lane; const int wave = F.wave, fr = lane & 15, fq = lane >> 4;
    for (int unit = F.blk; unit < 256; unit += F.G) {
        const int b = unit >> 5, h = (unit >> 3) & 3, qt = unit & 7; const size_t row0 = (size_t)b * SEQ + qt * 256 + wave * 32;
        const bf16* kg = KB + (size_t)(b * 4 + h) * 65536; const bf16* vg = VT + (size_t)(b * 4 + h) * 65536;
        bf16x8 qf[2][8];
#pragma unroll
        for (int mi = 0; mi < 2; ++mi)
#pragma unroll
            for (int ks = 0; ks < 8; ++ks) qf[mi][ks] = *(const bf16x8*)(Q + (row0 + mi * 16 + fr) * DM + h * 256 + ks * 32 + fq * 8);
#pragma unroll 1
        for (int i0 = 0; i0 < 16; i0 += 8) { u32x4 t[8];
#pragma unroll
          for (int i = 0; i < 8; ++i) { const int p = tid + (i0 + i) * 512; t[i] = *(const u32x4*)(kg + (p >> 5) * 256 + (p & 31) * 8); }
#pragma unroll
          for (int i = 0; i < 8; ++i) { const int p = tid + (i0 + i) * 512; *(LAS u32x4*)(L + (p >> 5) * KST + (p & 31) * 8) = t[i]; } }
        __syncthreads();
        f32x4 sacc[2][16];
        unsigned koff = (unsigned)(fr * KST + fq * 8) * 2u;
#pragma unroll
        for (int nj = 0; nj < 16; ++nj) { sacc[0][nj] = (f32x4){0.f, 0.f, 0.f, 0.f}; sacc[1][nj] = (f32x4){0.f, 0.f, 0.f, 0.f};
            const LAS unsigned char* kp = F.lds + koff; koff += 16u * KST * 2u; asm volatile("" : "+v"(koff));
            bf16x8 kf[8];
#pragma unroll
            for (int ks = 0; ks < 8; ++ks) kf[ks] = *(const LAS bf16x8*)(kp + ks * 64);
            __builtin_amdgcn_sched_barrier(0);
#pragma unroll
            for (int ks = 0; ks < 8; ++ks) { sacc[0][nj] = mfma16(kf[ks], qf[0][ks], sacc[0][nj]); sacc[1][nj] = mfma16(kf[ks], qf[1][ks], sacc[1][nj]); }
            __builtin_amdgcn_sched_barrier(0); }
        float inv[2]; bf16x8 pf[2][8];
#pragma unroll
        for (int mi = 0; mi < 2; ++mi) { float mx = -3.0e38f;
#pragma unroll
            for (int nj = 0; nj < 16; ++nj) mx = fmaxf(mx, fmaxf(fmaxf(sacc[mi][nj][0], sacc[mi][nj][1]), fmaxf(sacc[mi][nj][2], sacc[mi][nj][3])));
            mx = fmaxf(mx, __shfl_xor(mx, 16)); mx = fmaxf(mx, __shfl_xor(mx, 32));
            float sm = 0.f;
#pragma unroll
            for (int s = 0; s < 8; ++s) { float e[8];
#pragma unroll
                for (int r = 0; r < 4; ++r) { e[r] = __expf(sacc[mi][2 * s][r] - mx); e[4 + r] = __expf(sacc[mi][2 * s + 1][r] - mx); }
                sm += ((e[0] + e[1]) + (e[2] + e[3])) + ((e[4] + e[5]) + (e[6] + e[7]));
                u32x4 w; w.x = pk2(e[0], e[1]); w.y = pk2(e[2], e[3]); w.z = pk2(e[4], e[5]); w.w = pk2(e[6], e[7]); pf[mi][s] = __builtin_bit_cast(bf16x8, w); }
            sm += __shfl_xor(sm, 16); sm += __shfl_xor(sm, 32); inv[mi] = 1.f / sm; }
        __syncthreads();
#pragma unroll 1
        for (int i0 = 0; i0 < 16; i0 += 8) { u32x4 t[8];
#pragma unroll
          for (int i = 0; i < 8; ++i) { const int p = tid + (i0 + i) * 512; t[i] = *(const u32x4*)(vg + (p >> 5) * 256 + (p & 31) * 8); }
#pragma unroll
          for (int i = 0; i < 8; ++i) { const int p = tid + (i0 + i) * 512; *(LAS u32x4*)(L + (p >> 5) * KST + (p & 31) * 8) = t[i]; } }
        __syncthreads();
        unsigned voff = (unsigned)(fr * KST + fq * 8) * 2u;
        bf16* cp = CTX + (row0 + fr) * DM + h * 256 + fq * 4;
#pragma unroll
        for (int nj = 0; nj < 16; ++nj) { f32x4 o0 = {0.f, 0.f, 0.f, 0.f}, o1 = {0.f, 0.f, 0.f, 0.f};
            const LAS unsigned char* vp = F.lds + voff; voff += 16u * KST * 2u; asm volatile("" : "+v"(voff));
            bf16x8 vf[8];
#pragma unroll
            for (int s = 0; s < 8; ++s) vf[s] = *(const LAS bf16x8*)(vp + s * 64);
            __builtin_amdgcn_sched_barrier(0);
#pragma unroll
            for (int s = 0; s < 8; ++s) { o0 = mfma16(vf[s], pf[0][s], o0); o1 = mfma16(vf[s], pf[1][s], o1); }
            __builtin_amdgcn_sched_barrier(0);
            u32x2 w0; w0.x = pk2(o0[0] * inv[0], o0[1] * inv[0]); w0.y = pk2(o0[2] * inv[0], o0[3] * inv[0]); *(u32x2*)(cp + nj * 16) = w0;
            u32x2 w1; w1.x = pk2(o1[0] * inv[1], o1[1] * inv[1]); w1.y = pk2(o1[2] * inv[1], o1[3] * inv[1]); *(u32x2*)(cp + 16 * DM + nj * 16) = w1; }
        __syncthreads();
    }
}
__device__ __forceinline__ void s_attn(const Frame& F) {
    const float* qsb = WSP(const float, WS_QS); float* ctxs = WSP(float, WS_CTXS); const float* ck = F.in[4]; const float* cv = F.in[5];
    LAS float* part = (LAS float*)F.lds; LAS float* ml = part + 8 * 256;
    const int lane = pg8::pg8_lane_id(), tid = F.wave * 64 + lane; const int wave = F.wave;
    for (int it = F.blk; it < MS * 4; it += F.G) { const int b = it >> 2, h = it & 3;
        const f32x4 q4 = *(const f32x4*)(qsb + (size_t)b * DM + h * 256 + lane * 4);
        const float* kb = ck + ((size_t)b * 256 * 4 + h) * 256 + lane * 4 + (size_t)(wave * 32) * 1024;
        const float* vb = cv + ((size_t)b * 256 * 4 + h) * 256 + lane * 4 + (size_t)(wave * 32) * 1024;
        float mrun = -3.0e38f, l = 0.f; f32x4 acc = {0.f, 0.f, 0.f, 0.f};
#pragma unroll 1
        for (int i0 = 0; i0 < 32; i0 += 8) { f32x4 k4[8], v4[8]; float sc[8];
#pragma unroll
            for (int u = 0; u < 8; ++u) { k4[u] = __builtin_nontemporal_load((const f32x4*)(kb + (size_t)(i0 + u) * 1024)); v4[u] = __builtin_nontemporal_load((const f32x4*)(vb + (size_t)(i0 + u) * 1024)); }
            float mx = mrun;
#pragma unroll
            for (int u = 0; u < 8; ++u) { sc[u] = wave_sum((k4[u][0] * q4[0] + k4[u][1] * q4[1]) + (k4[u][2] * q4[2] + k4[u][3] * q4[3])); mx = fmaxf(mx, sc[u]); }
            const float rescale = __expf(mrun - mx); l *= rescale; acc = acc * rescale; mrun = mx;
#pragma unroll
            for (int u = 0; u < 8; ++u) { const float p = __expf(sc[u] - mx); l += p; acc += v4[u] * p; } }
        *(LAS f32x4*)(part + wave * 256 + lane * 4) = acc; if (lane == 0) { ml[wave * 2] = mrun; ml[wave * 2 + 1] = l; }
        __syncthreads();
        if (tid < 256) { float M = -3.0e38f;
#pragma unroll
            for (int w = 0; w < 8; ++w) M = fmaxf(M, ml[w * 2]);
            float o = 0.f, L = 0.f;
#pragma unroll
            for (int w = 0; w < 8; ++w) { const float e = __expf(ml[w * 2] - M); L += e * ml[w * 2 + 1]; o += e * part[w * 256 + tid]; }
            ctxs[(size_t)b * DM + h * 256 + tid] = o / L; }
        __syncthreads();
    }
}
__device__ __forceinline__ void final_norm_prompt(const Frame& F) {
    const int lane = pg8::pg8_lane_id(), tid = F.wave * 64 + lane; (void)tid;
    const int gw = F.blk * NWAVES + F.wave, NGW = F.G * NWAVES; const f32x4* g4 = (const f32x4*)F.in[24] + lane;
    for (int m = gw; m < MP; m += NGW) { f32x4* xr = (f32x4*)(F.out + O_YP + (size_t)m * DM) + lane; f32x4 v[4]; float s = 0.f;
#pragma unroll
        for (int j = 0; j < 4; ++j) { v[j] = xr[64 * j]; s += (v[j].x * v[j].x + v[j].y * v[j].y) + (v[j].z * v[j].z + v[j].w * v[j].w); }
        const float rstd = rsqrtf(wave_sum(s) * (1.f / DM) + EPS);
#pragma unroll
        for (int j = 0; j < 4; ++j) xr[64 * j] = v[j] * rstd * g4[64 * j]; }
}
__device__ __forceinline__ void final_norm_sample(const Frame& F) {
    const int lane = pg8::pg8_lane_id(), tid = F.wave * 64 + lane; (void)tid;
    const int gw = F.blk * NWAVES + F.wave, NGW = F.G * NWAVES; const f32x4* g4 = (const f32x4*)F.in[24] + lane; const float* parts = WSP(const float, WS_PARTS);
    for (int m = gw; m < MS; m += NGW) { f32x4* xr = (f32x4*)(F.out + O_YS + (size_t)m * DM) + lane; f32x4 v[4]; float s = 0.f;
#pragma unroll
        for (int j = 0; j < 4; ++j) { v[j] = xr[64 * j];
#pragma unroll
            for (int ks = 0; ks < 4; ++ks) v[j] += ((const f32x4*)(parts + ((size_t)ks * MS + m) * DM) + lane)[64 * j];
            s += (v[j].x * v[j].x + v[j].y * v[j].y) + (v[j].z * v[j].z + v[j].w * v[j].w); }
        const float rstd = rsqrtf(wave_sum(s) * (1.f / DM) + EPS);
#pragma unroll
        for (int j = 0; j < 4; ++j) xr[64 * j] = v[j] * rstd * g4[64 * j]; }
}
#define RLX_AGENT __ATOMIC_RELAXED, __HIP_MEMORY_SCOPE_AGENT
#define XB_TMO      128
#define XB_XCNT(j)  (256  + 64 * (j))
#define XB_XSUB(j)  (1280 + 64 * (j))
#define XB_XGEN(j)  (2304 + 64 * (j))
#define XB_TOP      3328
#define XB_TOPGEN   3392
#define XCD_BAR_WORDS 3456
#define XB_SPIN_CAP (1u << 18)

__device__ __forceinline__ unsigned xb_ld(unsigned* p)              { return __hip_atomic_load(p, __ATOMIC_RELAXED, __HIP_MEMORY_SCOPE_AGENT); }
__device__ __forceinline__ unsigned xb_add(unsigned* p, unsigned v) { return __hip_atomic_fetch_add(p, v, __ATOMIC_RELAXED, __HIP_MEMORY_SCOPE_AGENT); }
__device__ __forceinline__ unsigned xb_xcc_id() { return (unsigned)__builtin_amdgcn_s_getreg((3 << 11) | 20) & 0xFu; }
#define XB_SPIN(cond, bar) do { unsigned _sp = 0; while (cond) { __builtin_amdgcn_s_sleep(1); \
    if ((++_sp & 255u) == 0u) { if (xb_ld(&(bar)[XB_TMO])) break; if (_sp > XB_SPIN_CAP) { atomicAdd(&(bar)[XB_TMO], 1u); break; } } } } while (0)

struct XcdBarrier {
    unsigned* bar; unsigned x;
    volatile LAS unsigned* st;
};

__device__ __forceinline__ XcdBarrier xcd_barrier_post(unsigned* bar, volatile LAS unsigned* st, bool t0) {
    XcdBarrier b; b.bar = bar; b.x = xb_xcc_id(); b.st = st;
    if (t0) (void)xb_add(&bar[XB_XCNT(b.x)], 1u);
    return b;
}
__device__ __forceinline__ void xcd_barrier_complete(unsigned* bar, unsigned x, unsigned& nloc, unsigned& nx) {
    const unsigned G = gridDim.x * gridDim.y * gridDim.z;
    unsigned sum, cnt, mine, sp = 0u;
    for (;;) {
        sum = 0u; cnt = 0u; mine = 0u;
#pragma unroll
        for (unsigned j = 0; j < 16; ++j) { const unsigned c = xb_ld(&bar[XB_XCNT(j)]); sum += c; cnt += (c > 0u) ? 1u : 0u; mine = (j == x) ? c : mine; }
        if (sum == G) break;
        __builtin_amdgcn_s_sleep(1);
        if ((++sp & 255u) == 0u) { if (xb_ld(&bar[XB_TMO])) break; if (sp > XB_SPIN_CAP) { atomicAdd(&bar[XB_TMO], 1u); break; } }
    }
    nloc = mine > 0u ? mine : 1u; nx = cnt > 0u ? cnt : 1u;
}

__device__ __forceinline__ void xcd_barrier(const XcdBarrier& b, int wave) {
    asm volatile("s_waitcnt vmcnt(0)" ::: "memory");
    __syncthreads();
    if (wave == 0 && pg8::pg8_lane_id() == 0) {
        unsigned* bar = b.bar;
        __builtin_amdgcn_s_waitcnt(0);
        unsigned nloc = b.st[0], nx = b.st[1];
        if (nloc == 0u) { xcd_barrier_complete(bar, b.x, nloc, nx); b.st[0] = nloc; b.st[1] = nx; }
        const unsigned old = xb_add(&bar[XB_XSUB(b.x)], 1u);
        const unsigned gen = old / nloc;
        if (old + 1u == (gen + 1u) * nloc) {
            __builtin_amdgcn_fence(__ATOMIC_RELEASE, "agent");
            asm volatile("s_waitcnt vmcnt(0)" ::: "memory");
            const unsigned og = xb_add(&bar[XB_TOP], 1u);
            const unsigned tg = og / nx;
            if (og + 1u == (tg + 1u) * nx) xb_add(&bar[XB_TOPGEN], 1u);
            else XB_SPIN(xb_ld(&bar[XB_TOPGEN]) == tg, bar);
            __builtin_amdgcn_fence(__ATOMIC_ACQUIRE, "agent");
            xb_add(&bar[XB_XGEN(b.x)], 1u);
            asm volatile("s_waitcnt vmcnt(0)" ::: "memory");
        } else {
            XB_SPIN(xb_ld(&bar[XB_XGEN(b.x)]) == gen, bar);
            __builtin_amdgcn_fence(__ATOMIC_ACQUIRE, "agent");
            asm volatile("s_waitcnt vmcnt(0)" ::: "memory");
        }
    }
    __syncthreads();
}
#ifndef MK_N_LAUNCHES
#define MK_N_LAUNCHES 1
#endif
constexpr int N_PHASES = 12;
#ifndef REPX
#define REPX 0
#endif
#define AMP_WAIT() do { __syncthreads(); const unsigned long long t1_ = __builtin_amdgcn_s_memrealtime(); while (__builtin_amdgcn_s_memrealtime() < t1_ + (t1_ - t0_)) __builtin_amdgcn_s_sleep(8); __syncthreads(); } while (0)
#define RX(bit) for (int rx_ = 0; rx_ < 1 + ((REPX >> (bit)) & 1); ++rx_)
struct Args { const float* in[25]; float* out; unsigned char* ws; int ph_lo, ph_hi; };
struct RotOrder {
    pg8::StaticOrder S;
    __device__ void init(int M, int N, int G, int c, int rot) { S.init(M, N, G, (c + G - (rot % G)) % G); }
    __device__ bool next(int i, pg8::Unit& u) const { return S.next(i, u); }
    __device__ __forceinline__ void a_ready(const pg8::Unit&) const {}
    __device__ __forceinline__ void done(const pg8::Unit&) const {}
};
__global__ void __launch_bounds__(NWAVES * 64, 2) mk_fwd(Args args) {
    extern __shared__ __attribute__((aligned(16))) unsigned char lds_raw[];
    Frame F;
    F.lds = (LAS unsigned char*)lds_raw;
    F.wave = __builtin_amdgcn_readfirstlane((int)threadIdx.x >> 6);
    F.G = gridDim.x; F.blk = blockIdx.x;
#pragma unroll
    for (int i = 0; i < 25; ++i) F.in[i] = args.in[i];
    F.out = args.out; F.ws = args.ws;
    const int lo = args.ph_lo, hi = args.ph_hi;
#define IN(k) (lo <= (k) && (k) < hi)
    volatile LAS unsigned* bst = (volatile LAS unsigned*)(F.lds + 143360);
    { const int l0 = pg8::pg8_lane_id(); if (F.wave == 0 && l0 < 2) bst[l0] = 0u; }
    __syncthreads();
    XcdBarrier bar = xcd_barrier_post((unsigned*)args.ws, bst, F.wave == 0 && pg8::pg8_lane_id() == 0);
    if (lo < 0) cg::this_grid().sync();
#define GRID_BAR() xcd_barrier(bar, F.wave)
#define SEAM(k) do { if (IN(k) && IN((k) + 1)) GRID_BAR(); } while (0)
    typedef pg8::bf16_t pb;
    if (IN(0)) { constexpr int rep = 0; (void)rep; p0_prologue(F); __syncthreads(); }
    SEAM(0);
    if (IN(1)) { constexpr int rep = 0; (void)rep;
        RX(10) { SEpiStore E{WSP(float, WS_PROJS), INC, 1.f}; skinny_gemm<true>(F, F.in[1], DM, WSP(const bf16, WS_WIN), DM, DM, INC / 16, 1, E); }
        { pg8::Gemm g{WSP(const pb, WS_H), WSP(const pb, WS_WIN), MP, INP, DM}; pg8::StaticOrder S; S.init(MP, INP, F.G, F.blk);
          pg8::EpiScale<0, 1> E{WSP(pb, WS_PROJ), INP, WSP(const float, WS_SSQ0), 1.f}; pg8::gemm_phase<pg8::EpiScale<0, 1>, pg8::StaticOrder, true, true>(F.lds, F.wave, g, S, E); }
    }
    SEAM(1);
    if (IN(2)) { constexpr int rep = 0; (void)rep; RX(7) s_mixers(F); RX(6) p2_pool_prompt(F); RX(5) p2_gla_local(F); }
    SEAM(2);
    if (IN(3)) { constexpr int rep = 0; (void)rep;
        { SEpiRes E{F.in[1], F.out + O_YS}; skinny_gemm<false>(F, WSP(const float, WS_MIXS), DM, WSP(const bf16, WS_WOUT), DM, DM, DM / 16, 1, E); }
        RX(2) p3_gla_scan(F);
        { pg8::Gemm g{WSP(const pb, WS_MN), WSP(const pb, WS_WKV), NB * 256, 2048, DM}; RotOrder S; S.init(NB * 256, 2048, F.G, F.blk, 128);
          pg8::EpiKV E{F.out + O_KP, F.out + O_VP, WSP(pb, WS_KB), WSP(pb, WS_VT), WSP(const float, WS_SSQ0) + MP}; pg8::gemm_phase<pg8::EpiKV, RotOrder, true, true>(F.lds, F.wave, g, S, E); }
    }
    SEAM(3);
    if (IN(4)) { constexpr int rep = 0; (void)rep;
        RX(4) { SEpiStore E{WSP(float, WS_QS), DM, 0.0625f}; skinny_gemm<true>(F, F.out + O_YS, DM, WSP(const bf16, WS_WQM), DM, DM, DM / 16, 1, E); }
        RX(3) p4_gla_out(F);
    }
    SEAM(4);
    if (IN(5)) { constexpr int rep = 0; (void)rep;
        RX(9) s_attn(F);
        { pg8::Gemm g{WSP(const pb, WS_H), WSP(const pb, WS_WOUT), MP, DM, DM}; pg8::StaticOrder S; S.init(MP, DM, F.G, F.blk);
          pg8::EpiRes<true, true, true, false, false> E{F.in[0], nullptr, WSP(pb, WS_XB), WSP(float, WS_SSQ1)}; pg8::gemm_phase<pg8::EpiRes<true, true, true, false, false>, pg8::StaticOrder, true, true>(F.lds, F.wave, g, S, E); }
    }
    SEAM(5);
    if (IN(6)) { constexpr int rep = 0; (void)rep;
        if (rep == 0) { SEpiRes E{F.out + O_YS, F.out + O_YS}; skinny_gemm<false>(F, WSP(const float, WS_CTXS), DM, WSP(const bf16, WS_WOM), DM, DM, DM / 16, 1, E); }
        { pg8::Gemm g{WSP(const pb, WS_XB), WSP(const pb, WS_WQM), MP, DM, DM}; pg8::StaticOrder S; S.init(MP, DM, F.G, F.blk);
          pg8::EpiScale<0> E{WSP(pb, WS_Q), DM, WSP(const float, WS_SSQ1), 0.0625f}; pg8::gemm_phase<pg8::EpiScale<0>, pg8::StaticOrder, true, true>(F.lds, F.wave, g, S, E); }
    }
    SEAM(6);
    if (IN(7)) { constexpr int rep = 0; (void)rep;
        RX(0) { SEpiRelu2 E{WSP(float, WS_HFFS)}; skinny_gemm<true>(F, F.out + O_YS, DM, WSP(const bf16, WS_WUP), DM, DM, FF / 16, 1, E); }
        __syncthreads();
        RX(1) p7_attn_prompt(F);
    }
    SEAM(7);
    if (IN(8)) { constexpr int rep = 0; (void)rep;
        { SEpiPart E{WSP(float, WS_PARTS)}; skinny_gemm<false>(F, WSP(const float, WS_HFFS), FF, WSP(const bf16, WS_WDN), FF, DM, DM / 16, 4, E); }
        { pg8::Gemm g{WSP(const pb, WS_CTX), WSP(const pb, WS_WOM), MP, DM, DM}; pg8::StaticOrder S; S.init(MP, DM, F.G, F.blk);
          pg8::EpiRes<true, true, false, true, false> E{nullptr, nullptr, WSP(pb, WS_XB), WSP(float, WS_SSQ2)}; pg8::gemm_phase<pg8::EpiRes<true, true, false, true, false>, pg8::StaticOrder, true, true>(F.lds, F.wave, g, S, E); }
    }
    SEAM(8);
    if (IN(9)) { constexpr int rep = 0; (void)rep;
        if (rep == 0) final_norm_sample(F);
        { pg8::Gemm g{WSP(const pb, WS_XB), WSP(const pb, WS_WUP), MP, FF, DM}; pg8::StaticOrder S; S.init(MP, FF, F.G, F.blk);
          pg8::EpiScale<1> E{WSP(pb, WS_HFF), FF, WSP(const float, WS_SSQ2), 1.f}; pg8::gemm_phase<pg8::EpiScale<1>, pg8::StaticOrder, true, true>(F.lds, F.wave, g, S, E); }
    }
    SEAM(9);
    if (IN(10)) { constexpr int rep = 0; (void)rep;
        pg8::Gemm g{WSP(const pb, WS_HFF), WSP(const pb, WS_WDN), MP, DM, FF}; pg8::StaticOrder S; S.init(MP, DM, F.G, F.blk);
        if (F.G == 256) {
            pg8::EpiResRms E{WSP(const pb, WS_XB), F.out + O_YP, F.in[24], WSP(unsigned, WS_SSQ1), (unsigned*)(args.ws + 32768)};
            pg8::gemm_phase<pg8::EpiResRms, pg8::StaticOrder, false, true>(F.lds, F.wave, g, S, E);
        } else { pg8::EpiRes<false, false, false, true, true> E{nullptr, F.out + O_YP, WSP(pb, WS_XB), nullptr}; pg8::gemm_phase<pg8::EpiRes<false, false, false, true, true>, pg8::StaticOrder, true, true>(F.lds, F.wave, g, S, E); }
    }
    if (F.G != 256) SEAM(10);
    if (IN(11) && F.G != 256) { constexpr int rep = 0; (void)rep; final_norm_prompt(F); }
    if ((REPX >> 8) & 1) { for (int q = 0; q < 4; ++q) { GRID_BAR(); } }
#undef IN
#undef SEAM
}

extern "C" void kernel_launch(void* const* d_in, const int* in_sizes, int n_in, void* d_out, int out_size, void* d_ws, size_t ws_size, hipStream_t stream) {
    static int grid = 0;
    if (grid == 0) {
        if (n_in != 25 || ws_size < WS_END) { fprintf(stderr, "kernel_launch: unexpected inputs (n_in %d, ws %zu)\n", n_in, ws_size); grid = -1; return; }
        int dev = 0, cus = 0, per_cu = 0;
        hipGetDevice(&dev); hipDeviceGetAttribute(&cus, hipDeviceAttributeMultiprocessorCount, dev);
        if (hipFuncSetAttribute((const void*)mk_fwd, hipFuncAttributeMaxDynamicSharedMemorySize, LDS_BYTES) != hipSuccess) { fprintf(stderr, "kernel_launch: hipFuncSetAttribute failed\n"); grid = -1; return; }
        if (hipOccupancyMaxActiveBlocksPerMultiprocessor(&per_cu, (const void*)mk_fwd, NWAVES * 64, LDS_BYTES) != hipSuccess || per_cu < 1) { fprintf(stderr, "kernel_launch: occupancy query says %d\n", per_cu); per_cu = 1; }
        (void)hipGetLastError();
        grid = cus * 1;
        fprintf(stderr, "kernel_launch: grid %d (cus %d, per_cu %d)\n", grid, cus, per_cu);
    }
    if (grid < 0) return;
    if (hipMemsetAsync(d_ws, 0, 65536, stream) != hipSuccess) { fprintf(stderr, "kernel_launch: memset failed\n"); return; }
    Args a{};
    for (int i = 0; i < 25; ++i) a.in[i] = (const float*)d_in[i];
    a.out = (float*)d_out; a.ws = (unsigned char*)d_ws;
#if MK_N_LAUNCHES == 1
    a.ph_lo = 0; a.ph_hi = N_PHASES;
    void* kargs[] = {&a};
    hipError_t e = hipLaunchCooperativeKernel((const void*)mk_fwd, dim3(grid), dim3(NWAVES * 64), kargs, LDS_BYTES, stream);
    if (e != hipSuccess) fprintf(stderr, "cooperative launch failed: %s (grid %d)\n", hipGetErrorString(e), grid);
#else
    for (int p = 0; p < N_PHASES; ++p) { a.ph_lo = p; a.ph_hi = p + 1; hipLaunchKernelGGL(mk_fwd, dim3(grid), dim3(NWAVES * 64), LDS_BYTES, stream, a); }
#endif
}
```

```cpp
#include <hip/hip_runtime.h>
#include <hip/hip_cooperative_groups.h>
#include <cstdio>
#include <cstdint>
namespace cg = cooperative_groups;
namespace pg8 {
#define PG8_LAS __attribute__((address_space(3)))
typedef unsigned short bf16_t;
typedef short bf16x8 __attribute__((ext_vector_type(8)));
typedef float f32x4 __attribute__((ext_vector_type(4)));
typedef unsigned u32x4 __attribute__((ext_vector_type(4)));
constexpr int BM = 256, BK = 64, HALF = 128, HTB = HALF * BK * 2  , STAGE_BYTES = 8 * HTB, NXCD = 8, WGM = 8;

__host__ __device__ __forceinline__ int lds_byte(int r, int c) { const int st = (r >> 4) * 2 + (c >> 5), rr = r & 15, cc = c & 31, ob = rr * 64 + cc * 2; return st * 1024 + (ob ^ (((ob >> 9) & 1) << 5)); }
__host__ __device__ __forceinline__ void stage_rc(int b, int& R, int& C) { const int st = b / 1024, sb = b % 1024, swz = sb ^ (((sb >> 9) & 1) << 5); R = (st >> 1) * 16 + swz / 64; C = (st & 1) * 32 + (swz % 64) / 2; }
__host__ __device__ __forceinline__ int perm32(int rho) { const int n = rho >> 4, i = rho & 15; return 8 * (i >> 2) + 4 * n + (i & 3); }

struct Unit { int pm, pn; };
struct Gemm { const bf16_t* A; const bf16_t* Bt; int M, N, K; };

struct StaticOrder {
    int nM, nN, nwg, G, c;
    __host__ __device__ void init(int M, int N, int G_, int c_) { nM = M / BM; nN = N / BM; nwg = nM * nN; G = G_; c = c_; }
    __host__ __device__ bool next(int i, Unit& u) const {
        const long L = (long)i * G + c; if (L >= nwg) return false;
        int wgid = (int)L; { const int q = nwg / NXCD, r = nwg % NXCD, xcd = wgid % NXCD, off = wgid / NXCD; wgid = (xcd < r ? xcd * (q + 1) : r * (q + 1) + (xcd - r) * q) + off; }
        const int nig = WGM * nN, gid = wgid / nig, fm = gid * WGM, gsz = (nM - fm) < WGM ? (nM - fm) : WGM;
        u.pm = fm + ((wgid % nig) % gsz); u.pn = (wgid % nig) / gsz; return true;
    }
    __device__ __forceinline__ void a_ready(const Unit&) const {}
    __device__ __forceinline__ void done(const Unit&) const {}
};

typedef float f32x2 __attribute__((ext_vector_type(2)));
typedef __bf16 bf16x2_t __attribute__((ext_vector_type(2)));
__device__ __forceinline__ unsigned cvt_pk_bf16(float lo, float hi) { const f32x2 v = {lo, hi}; return __builtin_bit_cast(unsigned, __builtin_convertvector(v, bf16x2_t)); }
__device__ __forceinline__ int pg8_lane_id() { int l; asm volatile("v_mbcnt_lo_u32_b32 %0, -1, 0\n\tv_mbcnt_hi_u32_b32 %0, -1, %0" : "=v"(l)); return l; }
typedef unsigned u32x2 __attribute__((ext_vector_type(2)));
struct EpiPlainBf16 {
    static constexpr bool PERM = true, AFTER_DRAIN = false;
    bf16_t* O; int ldc;
    __device__ __forceinline__ void operator()(const f32x4 (&acc)[2][2][4][2], const Unit& u, int wr, int wc, int fr, int fq) const {
        asm volatile("" : "+v"(fr), "+v"(fq));
        const int row0 = u.pm * BM + wr * 64 + fr, col0 = u.pn * BM + wc * 32 + 8 * fq;
#pragma unroll
        for (int ai = 0; ai < 2; ++ai)
#pragma unroll
            for (int m = 0; m < 4; ++m) { bf16_t* rowp = O + (size_t)(row0 + ai * HALF + m * 16) * ldc + col0;
#pragma unroll
                for (int bj = 0; bj < 2; ++bj) { const f32x4 v0 = acc[ai][bj][m][0], v1 = acc[ai][bj][m][1];
                    u32x4 w; w.x = cvt_pk_bf16(v0[0], v0[1]); w.y = cvt_pk_bf16(v0[2], v0[3]); w.z = cvt_pk_bf16(v1[0], v1[1]); w.w = cvt_pk_bf16(v1[2], v1[3]);
                    *(u32x4*)(rowp + bj * HALF) = w; } }
    }
};
struct EpiKV {
    static constexpr bool PERM = true, AFTER_DRAIN = false;
    float* outK; float* outV; bf16_t* KB; bf16_t* VT; const float* ssq;
    __device__ __forceinline__ void operator()(const f32x4 (&acc)[2][2][4][2], const Unit& u, int wr, int wc, int fr, int fq) const {
        asm volatile("" : "+v"(fr), "+v"(fq));
        const bool isV = u.pn >= 4; const int h = u.pn & 3, b = u.pm;
        float* of = isV ? outV : outK;
        const int ct0 = wc * 32 + 8 * fq;
#pragma unroll
        for (int ai = 0; ai < 2; ++ai)
#pragma unroll
            for (int m = 0; m < 4; ++m) { const int key = ai * HALF + wr * 64 + m * 16 + fr; const float rs = rsqrtf(ssq[b * 256 + key] * (1.0f / 1024.0f) + 1e-6f);
#pragma unroll
                for (int bj = 0; bj < 2; ++bj) { const f32x4 v0 = acc[ai][bj][m][0] * rs, v1 = acc[ai][bj][m][1] * rs; const int ct = ct0 + bj * HALF;
                    float* fp = of + (size_t)(b * 256 + key) * 1024 + h * 256 + ct;
                    __builtin_nontemporal_store(v0, (f32x4*)fp); __builtin_nontemporal_store(v1, (f32x4*)(fp + 4));
                    if (!isV) { u32x4 w; w.x = cvt_pk_bf16(v0[0], v0[1]); w.y = cvt_pk_bf16(v0[2], v0[3]); w.z = cvt_pk_bf16(v1[0], v1[1]); w.w = cvt_pk_bf16(v1[2], v1[3]);
                        *(u32x4*)(KB + ((size_t)(b * 4 + h) * 256 + key) * 256 + ct) = w; }
                    else { const int kp = (key & ~31) | (((key >> 2) & 3) << 3) | (((key >> 4) & 1) << 2) | (key & 3);
                        bf16_t* vp = VT + ((size_t)(b * 4 + h) * 256 + ct) * 256 + kp;
#pragma unroll
                        for (int e = 0; e < 4; ++e) { vp[(size_t)e * 256] = (bf16_t)(cvt_pk_bf16(v0[e], 0.f) & 0xffffu); vp[(size_t)(e + 4) * 256] = (bf16_t)(cvt_pk_bf16(v1[e], 0.f) & 0xffffu); } }
                } }
    }
};
template <bool XB, bool SSQ, bool NTB = false, bool BASEBF = false, bool OUTF = true> struct EpiRes {
    static constexpr bool PERM = false, AFTER_DRAIN = false;
    const float* base; float* out; bf16_t* xb; float* ssq;
    __device__ __forceinline__ void operator()(const f32x4 (&acc)[2][2][4][2], const Unit& u, int wr, int wc, int fr, int fq) const {
        asm volatile("" : "+v"(fr), "+v"(fq));
        const int col0 = u.pn * BM + wc * 32 + 4 * fq;
#pragma unroll
        for (int ai = 0; ai < 2; ++ai)
#pragma unroll
            for (int m = 0; m < 4; ++m) { const int r = u.pm * BM + ai * HALF + wr * 64 + m * 16 + fr; const size_t off = (size_t)r * 1024 + col0; float s = 0.f;
#pragma unroll
                for (int bj = 0; bj < 2; ++bj)
#pragma unroll
                    for (int n = 0; n < 2; ++n) { f32x4 bs;
                        if (BASEBF) { const u32x2 w = *(const u32x2*)(xb + off + bj * HALF + n * 16); bs = (f32x4){__uint_as_float(w.x << 16), __uint_as_float(w.x & 0xffff0000u), __uint_as_float(w.y << 16), __uint_as_float(w.y & 0xffff0000u)}; }
                        else bs = NTB ? __builtin_nontemporal_load((const f32x4*)(base + off + bj * HALF + n * 16)) : *(const f32x4*)(base + off + bj * HALF + n * 16);
                        const f32x4 o = bs + acc[ai][bj][m][n];
                        if (OUTF) *(f32x4*)(out + off + bj * HALF + n * 16) = o;
                        if (SSQ) s += (o[0] * o[0] + o[1] * o[1]) + (o[2] * o[2] + o[3] * o[3]);
                        if (XB) { u32x2 w; w.x = cvt_pk_bf16(o[0], o[1]); w.y = cvt_pk_bf16(o[2], o[3]); *(u32x2*)(xb + off + bj * HALF + n * 16) = w; } }
                if (SSQ) { s += __shfl_xor(s, 16); s += __shfl_xor(s, 32); if (fq == 0) ssq[(size_t)r * 16 + u.pn * 4 + wc] = s; }
            }
    }
};
template <int MODE, int NPART = 16> struct EpiScale {
    static constexpr bool PERM = true, AFTER_DRAIN = false;
    bf16_t* O; int ldc; const float* ssq; float scale;
    __device__ __forceinline__ void operator()(const f32x4 (&acc)[2][2][4][2], const Unit& u, int wr, int wc, int fr, int fq) const {
        asm volatile("" : "+v"(fr), "+v"(fq));
        const int row0 = u.pm * BM + wr * 64 + fr, col0 = u.pn * BM + wc * 32 + 8 * fq;
#pragma unroll
        for (int ai = 0; ai < 2; ++ai)
#pragma unroll
            for (int m = 0; m < 4; ++m) { const int r = row0 + ai * HALF + m * 16; bf16_t* rowp = O + (size_t)r * ldc + col0;
                float tot;
                if (NPART == 16) { const f32x4* sp = (const f32x4*)(ssq + (size_t)r * 16); const f32x4 s0 = sp[0], s1 = sp[1], s2 = sp[2], s3 = sp[3];
                    tot = ((s0[0] + s0[1]) + (s0[2] + s0[3])) + ((s1[0] + s1[1]) + (s1[2] + s1[3])) + ((s2[0] + s2[1]) + (s2[2] + s2[3])) + ((s3[0] + s3[1]) + (s3[2] + s3[3])); }
                else tot = ssq[r];
                const float rs = rsqrtf(tot * (1.0f / 1024.0f) + 1e-6f) * (MODE == 0 ? scale : 1.0f);
#pragma unroll
                for (int bj = 0; bj < 2; ++bj) { f32x4 v0 = acc[ai][bj][m][0] * rs, v1 = acc[ai][bj][m][1] * rs;
                    if (MODE == 1) {
#pragma unroll
                        for (int e = 0; e < 4; ++e) { const float a0 = fmaxf(v0[e], 0.f), a1 = fmaxf(v1[e], 0.f); v0[e] = a0 * a0; v1[e] = a1 * a1; } }
                    u32x4 w; w.x = cvt_pk_bf16(v0[0], v0[1]); w.y = cvt_pk_bf16(v0[2], v0[3]); w.z = cvt_pk_bf16(v1[0], v1[1]); w.w = cvt_pk_bf16(v1[2], v1[3]);
                    *(u32x4*)(rowp + bj * HALF) = w; } }
    }
};

struct EpiResRms {
    static constexpr bool PERM = false, AFTER_DRAIN = true;
    const bf16_t* xbase; float* out; const float* gain; unsigned* xs; unsigned* cnt;
    __device__ __forceinline__ void fused(f32x4 (&acc)[2][2][4][2], const Unit& u, int wr, int wc, int fr, int fq, PG8_LAS unsigned char* lds, int wid, int lane) const {
        asm volatile("" : "+v"(fr), "+v"(fq));
        PG8_LAS float* P = (PG8_LAS float*)lds;
        PG8_LAS float* S = (PG8_LAS float*)(lds + 4096);
        const int col0 = u.pn * BM + wc * 32 + 4 * fq;
#pragma unroll
        for (int ai = 0; ai < 2; ++ai)
#pragma unroll
            for (int m = 0; m < 4; ++m) { const int r = ai * HALF + wr * 64 + m * 16 + fr; const size_t off = (size_t)(u.pm * BM + r) * 1024 + col0; float s = 0.f;
#pragma unroll
                for (int bj = 0; bj < 2; ++bj)
#pragma unroll
                    for (int n = 0; n < 2; ++n) { const u32x2 w = *(const u32x2*)(xbase + off + bj * HALF + n * 16); const f32x4 bs = {__uint_as_float(w.x << 16), __uint_as_float(w.x & 0xffff0000u), __uint_as_float(w.y << 16), __uint_as_float(w.y & 0xffff0000u)}; const f32x4 o = bs + acc[ai][bj][m][n]; acc[ai][bj][m][n] = o;
                        s += (o[0] * o[0] + o[1] * o[1]) + (o[2] * o[2] + o[3] * o[3]); }
                s += __shfl_xor(s, 16); s += __shfl_xor(s, 32); if (fq == 0) P[r * 4 + wc] = s;
                if (m & 1) asm volatile("" ::: "memory"); }
        asm volatile("s_waitcnt lgkmcnt(0)" ::: "memory"); __builtin_amdgcn_s_barrier(); asm volatile("" ::: "memory");
        const int row = wid * 32 + (lane & 31);
        if (lane < 32) { const float t = (P[row * 4 + 0] + P[row * 4 + 1]) + (P[row * 4 + 2] + P[row * 4 + 3]);
            __hip_atomic_store(xs + (size_t)(u.pm * BM + row) * 4 + u.pn, __float_as_uint(t), __ATOMIC_RELAXED, __HIP_MEMORY_SCOPE_AGENT); }
        asm volatile("s_waitcnt vmcnt(0)" ::: "memory");
        if (lane == 0) __hip_atomic_fetch_add(cnt + 64 * u.pm, 1u, __ATOMIC_RELAXED, __HIP_MEMORY_SCOPE_AGENT);
        if (wid == 0) { unsigned spins = 0;
            while ((unsigned)__builtin_amdgcn_readfirstlane(__hip_atomic_load(cnt + 64 * u.pm, __ATOMIC_RELAXED, __HIP_MEMORY_SCOPE_AGENT)) < 32u) { __builtin_amdgcn_s_sleep(2); if (++spins > (1u << 22)) break; }
            __builtin_amdgcn_fence(__ATOMIC_ACQUIRE, "agent"); }
        asm volatile("s_waitcnt vmcnt(0) lgkmcnt(0)" ::: "memory"); __builtin_amdgcn_s_barrier(); asm volatile("" ::: "memory");
        if (lane < 32) { const unsigned* sl = xs + (size_t)(u.pm * BM + row) * 4; float t = 0.f;
#pragma unroll
            for (int q = 0; q < 4; ++q) t += __uint_as_float(__hip_atomic_load(sl + q, __ATOMIC_RELAXED, __HIP_MEMORY_SCOPE_AGENT));
            S[row] = rsqrtf(t * (1.0f / 1024.0f) + 1e-6f); }
        asm volatile("s_waitcnt lgkmcnt(0)" ::: "memory"); __builtin_amdgcn_s_barrier(); asm volatile("" ::: "memory");
        f32x4 gv[2][2];
#pragma unroll
        for (int bj = 0; bj < 2; ++bj)
#pragma unroll
            for (int n = 0; n < 2; ++n) gv[bj][n] = *(const f32x4*)(gain + col0 + bj * HALF + n * 16);
#pragma unroll
        for (int ai = 0; ai < 2; ++ai)
#pragma unroll
            for (int m = 0; m < 4; ++m) { const int r = ai * HALF + wr * 64 + m * 16 + fr; const float rs = S[r]; const size_t off = (size_t)(u.pm * BM + r) * 1024 + col0;
#pragma unroll
                for (int bj = 0; bj < 2; ++bj)
#pragma unroll
                    for (int n = 0; n < 2; ++n) __builtin_nontemporal_store(acc[ai][bj][m][n] * rs * gv[bj][n], (f32x4*)(out + off + bj * HALF + n * 16)); }
    }
};

template <class Epi, class Sched, bool ALIGN_EPI = false, bool SP2 = false>
__device__ __forceinline__ void gemm_phase(PG8_LAS unsigned char* lds, const int wave_in, const Gemm g, const Sched& S, const Epi& E) {
    const int wid = wave_in, lane = pg8_lane_id(), tid = wid * 64 + lane, wr = wid >> 2, wc = wid & 3, fr = lane & 15, fq = lane >> 4;
    const int K = g.K, nt = K / BK;
    unsigned voffA[2], voffB[2];
#pragma unroll
    for (int i = 0; i < 2; ++i) { int R, C; stage_rc(tid * 16 + i * 8192, R, C); const int Rb = Epi::PERM ? ((R & ~31) + perm32(R & 31)) : R;
        voffA[i] = (unsigned)(R * K + C) * 2u; voffB[i] = (unsigned)(Rb * K + C) * 2u; }
    const size_t kstep = (size_t)(BK * 2);
    const size_t hstep = (size_t)HALF * K * 2;
    const size_t tstep = 2 * hstep;
    const unsigned ldsw = (unsigned)wid * 1024u;
    const int aoff = lds_byte(wr * 64 + fr, fq * 8), boff = lds_byte(wc * 32 + fr, fq * 8);
#define PG8_SA(b, h) (((b) * 2 + (h)) * HTB)
#define PG8_SB(b, h) ((4 + (b) * 2 + (h)) * HTB)
#define PG8_STAGE(bufoff, gbase, voff) do { _Pragma("unroll") for (int _i = 0; _i < 2; ++_i) \
        __builtin_amdgcn_global_load_lds((const unsigned*)((const char*)(gbase) + (voff)[_i]), (PG8_LAS unsigned*)(lds + (bufoff) + ldsw + _i * 8192), 16, 0, 0); } while (0)
#define PG8_LDA(dst, b, h) do { _Pragma("unroll") for (int m = 0; m < 4; ++m) _Pragma("unroll") for (int k = 0; k < 2; ++k) dst[m][k] = *(const PG8_LAS bf16x8*)(lds + PG8_SA(b, h) + aoff + m * 2048 + k * 1024); } while (0)
#define PG8_LDB(dst, b, h) do { _Pragma("unroll") for (int n = 0; n < 2; ++n) _Pragma("unroll") for (int k = 0; k < 2; ++k) dst[n][k] = *(const PG8_LAS bf16x8*)(lds + PG8_SB(b, h) + boff + n * 2048 + k * 1024); } while (0)
#define PG8_MMA(ai, bj, At, Bt) do { __builtin_amdgcn_s_setprio(1); _Pragma("unroll") for (int m = 0; m < 4; ++m) _Pragma("unroll") for (int n = 0; n < 2; ++n) _Pragma("unroll") for (int k = 0; k < 2; ++k) \
        acc[ai][bj][m][n] = __builtin_amdgcn_mfma_f32_16x16x32_bf16(Bt[n][k], At[m][k], acc[ai][bj][m][n], 0, 0, 0); __builtin_amdgcn_s_setprio(0); } while (0)
#define PG8_WAIT_V(n) asm volatile("s_waitcnt vmcnt(" #n ")" ::: "memory")
#define PG8_WAIT_L(n) asm volatile("s_waitcnt lgkmcnt(" #n ")" ::: "memory")
#define PG8_BAR __builtin_amdgcn_s_barrier()
#define PG8_SCHED __builtin_amdgcn_sched_barrier(0)
    Unit cur, nxt; int ui = 0;
    if (!S.next(0, cur)) return;
    f32x4 acc[2][2][4][2];
#pragma unroll
    for (int a = 0; a < 2; ++a)
#pragma unroll
        for (int b = 0; b < 2; ++b)
#pragma unroll
            for (int m = 0; m < 4; ++m)
#pragma unroll
                for (int n = 0; n < 2; ++n) acc[a][b][m][n] = (f32x4){0.f, 0.f, 0.f, 0.f};
    bf16x8 At[4][2], B0[2][2], B1[2][2];
    const char* cA = (const char*)g.A + (size_t)cur.pm * tstep; const char* cB = (const char*)g.Bt + (size_t)cur.pn * tstep;
    S.a_ready(cur);
    if constexpr (SP2) {
        PG8_STAGE(PG8_SB(0, 0), cB, voffB); PG8_STAGE(PG8_SB(0, 1), cB + hstep, voffB); PG8_STAGE(PG8_SA(0, 0), cA, voffA); PG8_STAGE(PG8_SA(0, 1), cA + hstep, voffA);
        if (wr == 1) PG8_BAR;
        PG8_WAIT_V(2); PG8_BAR;
        PG8_STAGE(PG8_SB(1, 0), cB + kstep, voffB); PG8_STAGE(PG8_SA(1, 0), cA + kstep, voffA); PG8_STAGE(PG8_SB(1, 1), cB + hstep + kstep, voffB);
        PG8_WAIT_V(6); PG8_BAR;
    } else {
        PG8_STAGE(PG8_SB(0, 0), cB, voffB); PG8_STAGE(PG8_SA(0, 0), cA, voffA); PG8_STAGE(PG8_SB(0, 1), cB + hstep, voffB); PG8_STAGE(PG8_SA(0, 1), cA + hstep, voffA);
        if (wr == 1) PG8_BAR;
        PG8_WAIT_V(4); PG8_BAR;
        PG8_STAGE(PG8_SB(1, 0), cB + kstep, voffB); PG8_STAGE(PG8_SA(1, 0), cA + kstep, voffA); PG8_STAGE(PG8_SB(1, 1), cB + hstep + kstep, voffB);
        PG8_WAIT_V(6); PG8_BAR;
    }
    for (;;) {
        const bool has_next = S.next(ui + 1, nxt);
        const char* nA = has_next ? (const char*)g.A + (size_t)nxt.pm * tstep : cA; const char* nB = has_next ? (const char*)g.Bt + (size_t)nxt.pn * tstep : cB;
        for (int t = 0; t < nt; t += 2) {
            const bool last = (t == nt - 2);
            const char* a1 = cA + (size_t)(t + 1) * kstep;
            const char* a2 = last ? nA : cA + (size_t)(t + 2) * kstep; const char* b2 = last ? nB : cB + (size_t)(t + 2) * kstep;
            const char* a3 = a2 + kstep; const char* b3 = b2 + kstep;
            if (last && has_next) S.a_ready(nxt);
            if constexpr (SP2) {
            PG8_LDB(B0, 0, 0); PG8_LDB(B1, 0, 1); PG8_SCHED; PG8_LDA(At, 0, 0); PG8_STAGE(PG8_SA(1, 1), a1 + hstep, voffA);
            PG8_WAIT_V(8); PG8_WAIT_L(0); PG8_BAR; PG8_MMA(0, 0, At, B0); PG8_MMA(0, 1, At, B1); PG8_BAR; PG8_SCHED;
            PG8_LDA(At, 0, 1); PG8_STAGE(PG8_SB(0, 0), b2, voffB); PG8_STAGE(PG8_SB(0, 1), b2 + hstep, voffB); PG8_STAGE(PG8_SA(0, 0), a2, voffA);
            PG8_WAIT_V(8); PG8_WAIT_L(0); PG8_BAR; PG8_MMA(1, 0, At, B0); PG8_MMA(1, 1, At, B1); PG8_BAR; PG8_SCHED;
            PG8_LDB(B0, 1, 0); PG8_LDB(B1, 1, 1); PG8_SCHED; PG8_LDA(At, 1, 0); PG8_STAGE(PG8_SA(0, 1), a2 + hstep, voffA);
            PG8_WAIT_V(8); PG8_WAIT_L(0); PG8_BAR; PG8_MMA(0, 0, At, B0); PG8_MMA(0, 1, At, B1); PG8_BAR; PG8_SCHED;
            PG8_LDA(At, 1, 1); PG8_STAGE(PG8_SB(1, 0), b3, voffB); PG8_STAGE(PG8_SB(1, 1), b3 + hstep, voffB); PG8_STAGE(PG8_SA(1, 0), a3, voffA);
            PG8_WAIT_V(8); PG8_WAIT_L(0); PG8_BAR; PG8_MMA(1, 0, At, B0); PG8_MMA(1, 1, At, B1); PG8_BAR; PG8_SCHED;
            } else {
            PG8_LDB(B0, 0, 0); PG8_SCHED; PG8_LDA(At, 0, 0); PG8_STAGE(PG8_SA(1, 1), a1 + hstep, voffA);
            PG8_WAIT_L(8); PG8_BAR; PG8_WAIT_L(0); PG8_MMA(0, 0, At, B0); PG8_BAR; PG8_SCHED;
            PG8_LDB(B1, 0, 1); PG8_STAGE(PG8_SB(0, 0), b2, voffB);
            PG8_BAR; PG8_WAIT_L(0); PG8_MMA(0, 1, At, B1); PG8_BAR;
            PG8_LDA(At, 0, 1); PG8_STAGE(PG8_SA(0, 0), a2, voffA);
            PG8_BAR; PG8_WAIT_L(0); PG8_MMA(1, 0, At, B0); PG8_BAR; PG8_SCHED;
            PG8_STAGE(PG8_SB(0, 1), b2 + hstep, voffB);
            PG8_WAIT_V(6); PG8_BAR; PG8_MMA(1, 1, At, B1); PG8_BAR;
            PG8_LDB(B0, 1, 0); PG8_SCHED; PG8_LDA(At, 1, 0); PG8_STAGE(PG8_SA(0, 1), a2 + hstep, voffA);
            PG8_WAIT_L(8); PG8_BAR; PG8_WAIT_L(0); PG8_MMA(0, 0, At, B0); PG8_BAR; PG8_SCHED;
            PG8_LDB(B1, 1, 1); PG8_STAGE(PG8_SB(1, 0), b3, voffB);
            PG8_BAR; PG8_WAIT_L(0); PG8_MMA(0, 1, At, B1); PG8_BAR;
            PG8_LDA(At, 1, 1); PG8_STAGE(PG8_SA(1, 0), a3, voffA);
            PG8_BAR; PG8_WAIT_L(0); PG8_MMA(1, 0, At, B0); PG8_BAR; PG8_SCHED;
            PG8_STAGE(PG8_SB(1, 1), b3 + hstep, voffB);
            PG8_WAIT_V(6); PG8_BAR; PG8_MMA(1, 1, At, B1); PG8_BAR;
            }
        }
        if constexpr (ALIGN_EPI) { if (wr == 0) PG8_BAR; }
        if constexpr (!Epi::AFTER_DRAIN) { E(acc, cur, wr, wc, fr, fq); S.done(cur); }
        if (!has_next) break;
#pragma unroll
        for (int a = 0; a < 2; ++a)
#pragma unroll
            for (int b = 0; b < 2; ++b)
#pragma unroll
                for (int m = 0; m < 4; ++m)
#pragma unroll
                    for (int n = 0; n < 2; ++n) acc[a][b][m][n] = (f32x4){0.f, 0.f, 0.f, 0.f};
        cur = nxt; cA = nA; cB = nB; ++ui;
        if constexpr (ALIGN_EPI) { if (wr == 1) PG8_BAR; }
    }
    PG8_WAIT_V(0);
    if constexpr (!ALIGN_EPI) { if (wr == 0) PG8_BAR; }
    PG8_BAR;
    if constexpr (Epi::AFTER_DRAIN) { E.fused(acc, cur, wr, wc, fr, fq, lds, wid, lane); S.done(cur); }
#undef PG8_SA
#undef PG8_SB
#undef PG8_STAGE
#undef PG8_LDA
#undef PG8_LDB
#undef PG8_MMA
#undef PG8_WAIT_V
#undef PG8_WAIT_L
#undef PG8_BAR
#undef PG8_SCHED
}
}
constexpr int NWAVES = 8;
constexpr int DM = 1024, MP = 16384, SEQ = 2048, NB = 8, MS = 128;
constexpr int INC = 2064, INP = 2048;
constexpr int C_Q = 512, C_K = 768, C_V = 1024, C_G = 1536, C_F = 2048;
constexpr int FF = 4096;
constexpr float EPS = 1e-6f;
constexpr size_t O_YP = 0, O_YS = 16777216, O_SPP = O_YS + 131072, O_SGP = O_SPP + 61440, O_KP = O_SGP + 262144, O_VP = O_KP + 2097152, O_SPS = O_VP + 2097152, O_SGS = O_SPS + 983040;
constexpr size_t MiB = 1u << 20;
constexpr size_t WS_WIN = 2 * MiB, WS_WKV = 8 * MiB, WS_WOUT = 12 * MiB, WS_WQM = 14 * MiB, WS_WOM = 16 * MiB, WS_WUP = 18 * MiB, WS_WDN = 26 * MiB;
constexpr size_t WS_MN = 34 * MiB, WS_KB = 38 * MiB, WS_VT = 42 * MiB, WS_SSQ1 = 46 * MiB, WS_SSQ2 = 47 * MiB, WS_SSQ0 = 48 * MiB  , WS_FLOW = 58 * MiB  ;
constexpr size_t WS_PROJS = 49 * MiB  , WS_MIXS = 51 * MiB  , WS_QS = 52 * MiB, WS_CTXS = 53 * MiB, WS_HFFS = 54 * MiB  , WS_PARTS = 56 * MiB  ;
constexpr size_t WS_H = 64 * MiB  , WS_XB = 96 * MiB, WS_Q = 128 * MiB, WS_CTX = 160 * MiB;
constexpr size_t WS_PROJ = 192 * MiB  , WS_GL = 264 * MiB  , WS_CUM = 296 * MiB  , WS_ST = 312 * MiB  ;
constexpr size_t WS_HFF = 192 * MiB  ;
constexpr size_t WS_END = 328 * MiB;
constexpr int LDS_BYTES = 147456;

#define LAS __attribute__((address_space(3)))
typedef unsigned short bf16;
typedef unsigned u32x4 __attribute__((ext_vector_type(4)));
typedef unsigned u32x2 __attribute__((ext_vector_type(2)));
typedef float f32x4 __attribute__((ext_vector_type(4)));
typedef short bf16x8 __attribute__((ext_vector_type(8)));
typedef short bf16x4 __attribute__((ext_vector_type(4)));
#define LDS_WAIT() asm volatile("s_waitcnt lgkmcnt(0)" ::: "memory")
__device__ __forceinline__ unsigned pk2(float lo, float hi) { return pg8::cvt_pk_bf16(lo, hi); }
__device__ __forceinline__ float bf2f(unsigned short h) { return __uint_as_float((unsigned)h << 16); }
__device__ __forceinline__ float bflo(unsigned w) { return __uint_as_float(w << 16); }
__device__ __forceinline__ float bfhi(unsigned w) { return __uint_as_float(w & 0xffff0000u); }
__device__ __forceinline__ float wave_sum(float v) {
#pragma unroll
    for (int o = 1; o < 64; o <<= 1) v += __shfl_xor(v, o);
    return v;
}
__device__ __forceinline__ float wave_max(float v) {
#pragma unroll
    for (int o = 1; o < 64; o <<= 1) v = fmaxf(v, __shfl_xor(v, o));
    return v;
}
__device__ __forceinline__ float logsig(float x) { return fminf(x, 0.f) - log1pf(__expf(-fabsf(x))); }
__device__ __forceinline__ float silu(float x) { return x / (1.f + __expf(-x)); }
__device__ __forceinline__ f32x4 mfma16(bf16x8 a, bf16x8 b, f32x4 c) { return __builtin_amdgcn_mfma_f32_16x16x32_bf16(a, b, c, 0, 0, 0); }

struct Frame {
    LAS unsigned char* lds;
    int wave, G, blk;
    const float* in[25]; float* out; unsigned char* ws;
};
#define WSP(T, off) ((T*)(F.ws + (off)))

__device__ __forceinline__ void rows16_pass(const float* X, bf16* XB16, float* ssq, float* FL, const LAS bf16* Wf, int row0, int lane) {
    const int r = lane & 15, q = lane >> 4;
    const float* xp = X + (size_t)(row0 + r) * DM + q * 8; bf16* hp = XB16 + (size_t)(row0 + r) * DM + q * 8;
    f32x4 acc = {0.f, 0.f, 0.f, 0.f}; float ss = 0.f;
#pragma unroll 1
    for (int c0 = 0; c0 < 32; c0 += 8) { f32x4 a[16];
#pragma unroll
        for (int u = 0; u < 8; ++u) { a[2 * u] = __builtin_nontemporal_load((const f32x4*)(xp + (c0 + u) * 32)); a[2 * u + 1] = __builtin_nontemporal_load((const f32x4*)(xp + (c0 + u) * 32 + 4)); }
#pragma unroll
        for (int u = 0; u < 8; ++u) { const f32x4 a0 = a[2 * u], a1 = a[2 * u + 1];
            ss += ((a0[0] * a0[0] + a0[1] * a0[1]) + (a0[2] * a0[2] + a0[3] * a0[3])) + ((a1[0] * a1[0] + a1[1] * a1[1]) + (a1[2] * a1[2] + a1[3] * a1[3]));
            u32x4 aw; aw.x = pk2(a0[0], a0[1]); aw.y = pk2(a0[2], a0[3]); aw.z = pk2(a1[0], a1[1]); aw.w = pk2(a1[2], a1[3]);
            *(u32x4*)(hp + (c0 + u) * 32) = aw;
            if (FL) { const bf16x8 wfr = *(const LAS bf16x8*)(Wf + r * 1032 + (c0 + u) * 32 + q * 8); acc = mfma16(wfr, __builtin_bit_cast(bf16x8, aw), acc); } } }
    ss += __shfl_xor(ss, 16); ss += __shfl_xor(ss, 32);
    if (q == 0) ssq[row0 + r] = ss;
    if (FL) { acc = acc * rsqrtf(ss * (1.f / DM) + EPS); *(f32x4*)(FL + (size_t)(row0 + r) * 16 + q * 4) = acc; }
}
__device__ __forceinline__ void p0_prologue(const Frame& F) {
    const int lane = pg8::pg8_lane_id(), tid = F.wave * 64 + lane; (void)tid;
    LAS bf16* Wf = (LAS bf16*)(F.lds + 98304);
    { const float* win = F.in[8]; const float* gm = F.in[7];
#pragma unroll
      for (int kk = 0; kk < 2; ++kk) { const int k = tid * 2 + kk; const float g = gm[k]; const f32x4* wr = (const f32x4*)(win + (size_t)k * INC + 2048);
#pragma unroll
          for (int j4 = 0; j4 < 4; ++j4) { const f32x4 w = wr[j4];
#pragma unroll
              for (int e = 0; e < 4; ++e) Wf[(j4 * 4 + e) * 1032 + k] = (bf16)(pk2(w[e] * g, 0.f) & 0xffffu); } } }
    __syncthreads();
    { const float* wp = F.in[11]; const float* ps = F.in[12]; const float* wo = F.in[14]; bf16* wt = WSP(bf16, WS_WOUT);
      LAS float* Wp = (LAS float*)F.lds; LAS float* Wo = (LAS float*)(F.lds + 65536);
      for (int it = F.blk; it < 64; it += F.G) { const int g = it >> 4, n0 = (it & 15) * 64;
#pragma unroll
          for (int i = 0; i < 8; ++i) { const int i4 = (i * 512 + tid) * 4; *(LAS f32x4*)(Wp + i4) = *(const f32x4*)(wp + (size_t)g * 16384 + i4); }
#pragma unroll
          for (int i = 0; i < 16; ++i) { const int e = i * 512 + tid, d = e >> 6, nn = e & 63; Wo[e] = wo[(size_t)(g * 128 + d) * DM + n0 + nn] * ps[g * 128 + d]; }
          __syncthreads();
          const int n = tid & 63; float acc[16];
#pragma unroll
          for (int ci = 0; ci < 16; ++ci) acc[ci] = 0.f;
#pragma unroll 2
          for (int d4 = 0; d4 < 32; ++d4) { const float a0 = Wo[(d4 * 4 + 0) * 64 + n], a1 = Wo[(d4 * 4 + 1) * 64 + n], a2 = Wo[(d4 * 4 + 2) * 64 + n], a3 = Wo[(d4 * 4 + 3) * 64 + n];
#pragma unroll
              for (int ci = 0; ci < 16; ++ci) { const f32x4 w4 = *(const LAS f32x4*)(Wp + (F.wave * 16 + ci) * 128 + d4 * 4); acc[ci] += (w4[0] * a0 + w4[1] * a1) + (w4[2] * a2 + w4[3] * a3); } }
          u32x4* dst = (u32x4*)(wt + (size_t)(n0 + n) * DM + g * 128 + F.wave * 16);
          dst[0] = (u32x4){pk2(acc[0], acc[1]), pk2(acc[2], acc[3]), pk2(acc[4], acc[5]), pk2(acc[6], acc[7])};
          dst[1] = (u32x4){pk2(acc[8], acc[9]), pk2(acc[10], acc[11]), pk2(acc[12], acc[13]), pk2(acc[14], acc[15])};
          __syncthreads(); } }
    const int gw = F.blk * NWAVES + F.wave, NGW = F.G * NWAVES;
    { constexpr int I_IN = 8 * 9, I_SQ = 8 * 4, I_OUT = 4 * 4, I_UP = 8 * 16, I_DN = 32 * 4;
      constexpr int NITEMS = I_IN + 2 * I_SQ + I_OUT + 2 * I_SQ + I_UP + I_DN;
      LAS bf16* T = (LAS bf16*)F.lds;
      const bool deal = (F.G == 256);
      const int tfirst = deal ? (F.blk >= 64 ? F.blk - 64 : 384 + F.blk) : F.blk, tstride = deal ? 192 : F.G, tcount = deal ? (F.blk >= 88 ? 2 : F.blk >= 64 ? 3 : 1) : (NITEMS + F.G - 1) / F.G;
      for (int ti = 0; ti < tcount; ++ti) { const int it = (deal && ti == 2) ? 448 + (F.blk - 64) : tfirst + ti * tstride; if (it >= NITEMS) break;
        int r = it; const float* W; const float* gain = nullptr; bf16* WT; int ldw, nreal, ldt = DM, row_off = 0, nb = 4, kofs = 0;
        if (r < I_IN) { W = F.in[8]; ldw = INC; nreal = INC; WT = WSP(bf16, WS_WIN); gain = F.in[7]; nb = 9; }
        else if ((r -= I_IN) < I_SQ) { W = F.in[16]; ldw = DM; nreal = DM; WT = WSP(bf16, WS_WKV); gain = F.in[15]; }
        else if ((r -= I_SQ) < I_SQ) { W = F.in[17]; ldw = DM; nreal = DM; WT = WSP(bf16, WS_WKV); gain = F.in[15]; row_off = DM; }
        else if ((r -= I_SQ) < I_OUT) { W = F.in[14]; ldw = DM; nreal = DM; WT = WSP(bf16, WS_WOUT); kofs = 512; }
        else if ((r -= I_OUT) < I_SQ) { W = F.in[19]; ldw = DM; nreal = DM; WT = WSP(bf16, WS_WQM); gain = F.in[18]; }
        else if ((r -= I_SQ) < I_SQ) { W = F.in[20]; ldw = DM; nreal = DM; WT = WSP(bf16, WS_WOM); }
        else if ((r -= I_SQ) < I_UP) { W = F.in[22]; ldw = FF; nreal = FF; WT = WSP(bf16, WS_WUP); gain = F.in[21]; nb = 16; }
        else { r -= I_UP; W = F.in[23]; ldw = DM; nreal = DM; WT = WSP(bf16, WS_WDN); ldt = FF; }
        const int k0 = kofs + 128 * (r / nb), n0 = 256 * (r % nb);
        f32x4 tv[16];
#pragma unroll
        for (int i = 0; i < 16; ++i) { const int idx = i * 512 + tid, kk = idx >> 6, n = n0 + (idx & 63) * 4;
            tv[i] = (f32x4){0.f, 0.f, 0.f, 0.f}; if (n < nreal) tv[i] = __builtin_nontemporal_load((const f32x4*)(W + (size_t)(k0 + kk) * ldw + n)); }
#pragma unroll
        for (int i = 0; i < 16; ++i) { const int idx = i * 512 + tid, kk = idx >> 6; const float g = gain ? gain[k0 + kk] : 1.f; const f32x4 v = tv[i] * g;
            u32x2 o; o.x = pk2(v[0], v[1]); o.y = pk2(v[2], v[3]); *(LAS u32x2*)(T + kk * 256 + (idx & 63) * 4) = o; }
        __syncthreads();
        { const int n = tid & 255;
#pragma unroll
          for (int i = 0; i < 8; ++i) { const int kg = (tid >> 8) + 2 * i; const LAS bf16* tp = T + (kg * 8) * 256 + n;
              u32x4 o; o.x = tp[0] | ((unsigned)tp[256] << 16); o.y = tp[512] | ((unsigned)tp[768] << 16); o.z = tp[1024] | ((unsigned)tp[1280] << 16); o.w = tp[1536] | ((unsigned)tp[1792] << 16);
              *(u32x4*)(WT + (size_t)(row_off + n0 + n) * ldt + k0 + kg * 8) = o; } }
        __syncthreads();
      } }
    for (int it = (F.G - 1 - F.blk) * NWAVES + F.wave; it < MP / 16 + (NB * 256) / 16; it += NGW) {
        if (it < MP / 16) rows16_pass(F.in[0], WSP(bf16, WS_H), WSP(float, WS_SSQ0), WSP(float, WS_FLOW), Wf, it * 16, lane);
        else rows16_pass(F.in[6], WSP(bf16, WS_MN), WSP(float, WS_SSQ0) + MP, nullptr, Wf, (it - MP / 16) * 16, lane); }
}

template <bool NORM, class Epi>
__device__ __forceinline__ void skinny_gemm(const Frame& F, const float* A, int lda, const bf16* Bt, int ldb, int K, int nslab, int ksplit, const Epi& E) {
    const int lane = pg8::pg8_lane_id(), tid = F.wave * 64 + lane; (void)tid;
    const int fr = lane & 15, fq = lane >> 4;
    for (int item = F.blk; item < nslab * ksplit; item += F.G) {
        const int slab = item % nslab, ks = item / nslab;
        const float* ap = A + (size_t)(F.wave * 16 + fr) * lda + (size_t)ks * K + fq * 8;
        const bf16* bp = Bt + (size_t)(slab * 16 + fr) * ldb + (size_t)ks * K + fq * 8;
        f32x4 acc = {0.f, 0.f, 0.f, 0.f}; float ss = 0.f;
#pragma unroll 1
        for (int k0 = 0; k0 < K; k0 += 256) {
            f32x4 a[16]; bf16x8 b[8];
#pragma unroll
            for (int u = 0; u < 8; ++u) { a[2 * u] = *(const f32x4*)(ap + k0 + u * 32); a[2 * u + 1] = *(const f32x4*)(ap + k0 + u * 32 + 4); b[u] = *(const bf16x8*)(bp + k0 + u * 32); }
#pragma unroll
            for (int u = 0; u < 8; ++u) { const f32x4 a0 = a[2 * u], a1 = a[2 * u + 1];
                if (NORM) ss += ((a0[0] * a0[0] + a0[1] * a0[1]) + (a0[2] * a0[2] + a0[3] * a0[3])) + ((a1[0] * a1[0] + a1[1] * a1[1]) + (a1[2] * a1[2] + a1[3] * a1[3]));
                u32x4 aw; aw.x = pk2(a0[0], a0[1]); aw.y = pk2(a0[2], a0[3]); aw.z = pk2(a1[0], a1[1]); aw.w = pk2(a1[2], a1[3]);
                acc = mfma16(b[u], __builtin_bit_cast(bf16x8, aw), acc); }
        }
        if (NORM) { ss += __shfl_xor(ss, 16); ss += __shfl_xor(ss, 32); acc = acc * rsqrtf(ss / (float)K + EPS); }
        E(F.wave * 16 + fr, slab * 16 + fq * 4, ks, acc);
    }
}
struct SEpiStore { float* O; int ldc; float scale; __device__ __forceinline__ void operator()(int row, int col, int, f32x4 v) const { *(f32x4*)(O + (size_t)row * ldc + col) = v * scale; } };
struct SEpiPart  { float* O; __device__ __forceinline__ void operator()(int row, int col, int ks, f32x4 v) const { *(f32x4*)(O + ((size_t)ks * MS + row) * DM + col) = v; } };
struct SEpiRes   { const float* base; float* O; __device__ __forceinline__ void operator()(int row, int col, int, f32x4 v) const { const f32x4 b = *(const f32x4*)(base + (size_t)row * DM + col); *(f32x4*)(O + (size_t)row * DM + col) = b + v; } };
struct SEpiRelu2 { float* O; __device__ __forceinline__ void operator()(int row, int col, int, f32x4 v) const { f32x4 o;
#pragma unroll
    for (int e = 0; e < 4; ++e) { const float a = fmaxf(v[e], 0.f); o[e] = a * a; } *(f32x4*)(O + (size_t)row * FF + col) = o; } };
__device__ __forceinline__ void p2_pool_prompt(const Frame& F) {
    const bf16* proj = WSP(const bf16, WS_PROJ); bf16* mixed = WSP(bf16, WS_H);
    const int lane = pg8::pg8_lane_id(), tid = F.wave * 64 + lane; (void)tid;
    const int c8 = lane * 8, g = lane >> 4, w = 2 << g;
    for (int it = F.blk; it < MP / 64; it += F.G) {
        const int row0 = it * 64 + F.wave * 8, t0 = row0 & (SEQ - 1), b = row0 >> 11;
        u32x4 rw[23];
#pragma unroll
        for (int i = 0; i < 23; ++i) { rw[i] = (u32x4){0u, 0u, 0u, 0u}; if (t0 + i - 15 >= 0) rw[i] = *(const u32x4*)(proj + (size_t)(row0 + i - 15) * INP + c8); }
        float cs[23][8];
#pragma unroll
        for (int i = 0; i < 23; ++i) { const float u[8] = {bflo(rw[i].x), bfhi(rw[i].x), bflo(rw[i].y), bfhi(rw[i].y), bflo(rw[i].z), bfhi(rw[i].z), bflo(rw[i].w), bfhi(rw[i].w)};
#pragma unroll
            for (int e2 = 0; e2 < 8; ++e2) cs[i][e2] = (i ? cs[i - 1][e2] : 0.f) + u[e2]; }
#pragma unroll
        for (int i = 0; i < 8; ++i) { const int t = t0 + i, cnt = (t + 1 < w) ? (t + 1) : w; const float inv = 1.f / (float)cnt; float o[8]; const u32x4 ur = rw[15 + i]; const float un[8] = {bflo(ur.x), bfhi(ur.x), bflo(ur.y), bfhi(ur.y), bflo(ur.z), bfhi(ur.z), bflo(ur.w), bfhi(ur.w)};
#pragma unroll
            for (int e2 = 0; e2 < 8; ++e2) { const float lo2 = cs[15 + i - 2][e2], lo4 = cs[15 + i - 4][e2], lo8 = cs[15 + i - 8][e2], lo16 = (i ? cs[i - 1][e2] : 0.f);
                const float lo = (g == 0) ? lo2 : (g == 1) ? lo4 : (g == 2) ? lo8 : lo16;
                o[e2] = (cs[15 + i][e2] - lo) * inv - un[e2]; }
            u32x4 ov; ov.x = pk2(o[0], o[1]); ov.y = pk2(o[2], o[3]); ov.z = pk2(o[4], o[5]); ov.w = pk2(o[6], o[7]);
            *(u32x4*)(mixed + (size_t)(row0 + i) * DM + c8) = ov;
            if (t >= SEQ - 15) { float* sp = F.out + O_SPP + ((size_t)b * 15 + (t - (SEQ - 15))) * 512 + c8; *(f32x4*)sp = (f32x4){un[0], un[1], un[2], un[3]}; *(f32x4*)(sp + 4) = (f32x4){un[4], un[5], un[6], un[7]}; } }
    }
}
__device__ __forceinline__ void p2_gla_local(const Frame& F) {
    const bf16* proj = WSP(const bf16, WS_PROJ); float* GL = WSP(float, WS_GL); float* CUM = WSP(float, WS_CUM);
    LAS float* fl = (LAS float*)(F.lds);
    LAS float* segt = (LAS float*)(F.lds + 4096);
    LAS bf16* Aop = (LAS bf16*)(F.lds + 8192);
    LAS bf16* Bop = (LAS bf16*)(F.lds + 8192 + 9216);
    const int lane = pg8::pg8_lane_id(), tid = F.wave * 64 + lane; const int wave = F.wave, fr = lane & 15, fq = lane >> 4;
    for (int unit = F.blk; unit < 1024; unit += F.G) {
        const int b = unit >> 7, n = (unit >> 2) & 31, h = unit & 3; const size_t r0 = (size_t)b * SEQ + n * 64;
        for (int e = tid; e < 1024; e += 512) fl[e] = WSP(const float, WS_FLOW)[r0 * 16 + e];
        const int d = tid & 63, seg = tid >> 6;
        float wf[16];
#pragma unroll
        for (int r = 0; r < 16; ++r) wf[r] = F.in[9][r * 256 + h * 64 + d];
        const float bias = F.in[10][h * 64 + d];
        unsigned short kr[8], vv[16];
#pragma unroll
        for (int i = 0; i < 8; ++i) kr[i] = proj[(r0 + seg * 8 + i) * INP + C_K + h * 64 + d];
        { const int dv = tid & 127, ts = tid >> 7;
#pragma unroll
          for (int i = 0; i < 16; ++i) vv[i] = proj[(r0 + ts * 16 + i) * INP + C_V + h * 128 + dv]; }
        __syncthreads();
        float cum[8]; float run = 0.f;
#pragma unroll
        for (int i = 0; i < 8; ++i) { const int t = seg * 8 + i; float pre = bias;
#pragma unroll
            for (int r = 0; r < 16; ++r) pre += fl[t * 16 + r] * wf[r];
            run += logsig(pre) * (1.f / 16.f); cum[i] = run; }
        segt[seg * 64 + d] = run;
        __syncthreads();
        float pre_s = 0.f, tot = 0.f;
#pragma unroll
        for (int s2 = 0; s2 < 8; ++s2) { const float v = segt[s2 * 64 + d]; tot += v; if (s2 < seg) pre_s += v; }
        float ke[8];
#pragma unroll
        for (int i = 0; i < 8; ++i) { const int t = seg * 8 + i; cum[i] += pre_s; CUM[(size_t)unit * 4096 + t * 64 + d] = cum[i];
            ke[i] = bf2f(kr[i]) * __expf(tot - cum[i]); }
        { u32x4 o; o.x = pk2(ke[0], ke[1]); o.y = pk2(ke[2], ke[3]); o.z = pk2(ke[4], ke[5]); o.w = pk2(ke[6], ke[7]); *(LAS u32x4*)(Aop + d * 72 + seg * 8) = o; }
        { const int dv = tid & 127, ts = tid >> 7;
          u32x4 o0, o1; o0.x = vv[0] | ((unsigned)vv[1] << 16); o0.y = vv[2] | ((unsigned)vv[3] << 16); o0.z = vv[4] | ((unsigned)vv[5] << 16); o0.w = vv[6] | ((unsigned)vv[7] << 16);
          o1.x = vv[8] | ((unsigned)vv[9] << 16); o1.y = vv[10] | ((unsigned)vv[11] << 16); o1.z = vv[12] | ((unsigned)vv[13] << 16); o1.w = vv[14] | ((unsigned)vv[15] << 16);
          *(LAS u32x4*)(Bop + dv * 72 + ts * 16) = o0; *(LAS u32x4*)(Bop + dv * 72 + ts * 16 + 8) = o1; }
        __syncthreads();
        const int mi = wave & 3;
#pragma unroll
        for (int jj = 0; jj < 4; ++jj) { const int nj = (wave >> 2) * 4 + jj; f32x4 acc = {0.f, 0.f, 0.f, 0.f};
#pragma unroll
            for (int ks = 0; ks < 2; ++ks) { const bf16x8 a = *(const LAS bf16x8*)(Aop + (mi * 16 + fr) * 72 + ks * 32 + fq * 8); const bf16x8 bb = *(const LAS bf16x8*)(Bop + (nj * 16 + fr) * 72 + ks * 32 + fq * 8);
                acc = mfma16(bb, a, acc); }
            *(f32x4*)(GL + (size_t)unit * 8192 + (mi * 16 + fr) * 128 + nj * 16 + fq * 4) = acc; }
        __syncthreads();
    }
}
__device__ __forceinline__ void p3_gla_scan(const Frame& F) {
    const float* GL = WSP(const float, WS_GL); const float* CUM = WSP(const float, WS_CUM); bf16* ST = WSP(bf16, WS_ST);
    const int lane = pg8::pg8_lane_id(), tid = F.wave * 64 + lane; (void)tid;
    for (int e = F.blk * 512 + tid; e < 65536; e += F.G * 512) {
        const int dv = e & 127, dg = (e >> 7) & 15, bh = e >> 11, b = bh >> 2, h = bh & 3;
        float S[4] = {0.f, 0.f, 0.f, 0.f};
#pragma unroll 8
        for (int n = 0; n < 32; ++n) { const size_t unit = (size_t)(b * 32 + n) * 4 + h;
            const f32x4 cl = *(const f32x4*)(CUM + unit * 4096 + 63 * 64 + dg * 4);
            float Lv[4];
#pragma unroll
            for (int i = 0; i < 4; ++i) Lv[i] = __builtin_nontemporal_load(GL + unit * 8192 + (dg * 4 + i) * 128 + dv);
            u32x2 o; o.x = pk2(S[0], S[1]); o.y = pk2(S[2], S[3]); *(u32x2*)(ST + unit * 8192 + dv * 64 + dg * 4) = o;
#pragma unroll
            for (int i = 0; i < 4; ++i) S[i] = __expf(cl[i]) * S[i] + Lv[i]; }
#pragma unroll
        for (int i = 0; i < 4; ++i) F.out[O_SGP + ((size_t)(b * 4 + h) * 64 + dg * 4 + i) * 128 + dv] = S[i];
    }
}
__device__ __forceinline__ void p4_gla_out(const Frame& F, int nskip) {
    const bf16* proj = WSP(const bf16, WS_PROJ); const float* CUM = WSP(const float, WS_CUM); const bf16* ST = WSP(const bf16, WS_ST); bf16* mixed = WSP(bf16, WS_H);
    LAS bf16* Aq = (LAS bf16*)(F.lds);
    LAS bf16* Bk = (LAS bf16*)(F.lds + 9216);
    LAS bf16* Bv = (LAS bf16*)(F.lds + 18432);
    LAS bf16* Bs = (LAS bf16*)(F.lds + 36864);
    LAS bf16* Ap = (LAS bf16*)(F.lds + 55296);
    LAS float* red = (LAS float*)(F.lds + 64512);
    const int lane = pg8::pg8_lane_id(), tid = F.wave * 64 + lane; const int wave = F.wave, fr = lane & 15, fq = lane >> 4;
    int first, stride, count;
    if (nskip > 0 && F.G > nskip && 3 * nskip <= 1024) { const int rest = 1024 - 3 * nskip, others = F.G - nskip;
        if (F.blk < nskip) { first = F.blk; stride = nskip; count = 3; }
        else { first = 3 * nskip + (F.blk - nskip); stride = others; count = (rest - (F.blk - nskip) + others - 1) / others; } }
    else { first = F.blk; stride = F.G; count = (1024 - F.blk + F.G - 1) / F.G; }
    if (count <= 0) return;
    const int mi = wave & 3, t = tid >> 3, d8 = (tid & 7) * 8, dvl = tid & 127, ts = tid >> 7;
    f32x4 c0, c1; u32x4 qw, kw, st0, st1; unsigned short vv[16]; u32x2 gwv[4]; f32x4 gnv[4];
#define G3_LOAD(unit_) do { const int u_ = (unit_); const int b_ = u_ >> 7, n_ = (u_ >> 2) & 31, h_ = u_ & 3; const size_t r0_ = (size_t)b_ * SEQ + n_ * 64; \
        c0 = *(const f32x4*)(CUM + (size_t)u_ * 4096 + t * 64 + d8); c1 = *(const f32x4*)(CUM + (size_t)u_ * 4096 + t * 64 + d8 + 4); \
        qw = *(const u32x4*)(proj + (r0_ + t) * INP + C_Q + h_ * 64 + d8); kw = *(const u32x4*)(proj + (r0_ + t) * INP + C_K + h_ * 64 + d8); \
        _Pragma("unroll") for (int i = 0; i < 16; ++i) vv[i] = proj[(r0_ + ts * 16 + i) * INP + C_V + h_ * 128 + dvl]; \
        st0 = *(const u32x4*)(ST + (size_t)u_ * 8192 + (tid >> 3) * 64 + (tid & 7) * 8); st1 = *(const u32x4*)(ST + (size_t)u_ * 8192 + ((tid + 512) >> 3) * 64 + (tid & 7) * 8); \
        _Pragma("unroll") for (int jj = 0; jj < 4; ++jj) { const int dv0 = ((wave >> 2) * 4 + jj) * 16 + fq * 4; gnv[jj] = *(const f32x4*)(F.in[13] + h_ * 128 + dv0); gwv[jj] = *(const u32x2*)(proj + (r0_ + mi * 16 + fr) * INP + C_G + h_ * 128 + dv0); } } while (0)
    int unit = first; G3_LOAD(unit);
    for (int it = 0; it < count; ++it) {
        const int b = unit >> 7, n = (unit >> 2) & 31, h = unit & 3; const size_t r0 = (size_t)b * SEQ + n * 64;
        { float cu[8] = {c0[0], c0[1], c0[2], c0[3], c1[0], c1[1], c1[2], c1[3]};
          float qv[8] = {bflo(qw.x), bfhi(qw.x), bflo(qw.y), bfhi(qw.y), bflo(qw.z), bfhi(qw.z), bflo(qw.w), bfhi(qw.w)};
          float kv[8] = {bflo(kw.x), bfhi(kw.x), bflo(kw.y), bfhi(kw.y), bflo(kw.z), bfhi(kw.z), bflo(kw.w), bfhi(kw.w)};
#pragma unroll
          for (int e2 = 0; e2 < 8; ++e2) { const float ex = __expf(cu[e2]); qv[e2] = qv[e2] * 0.125f * ex; kv[e2] = kv[e2] / ex; }
          u32x4 o; o.x = pk2(qv[0], qv[1]); o.y = pk2(qv[2], qv[3]); o.z = pk2(qv[4], qv[5]); o.w = pk2(qv[6], qv[7]); *(LAS u32x4*)(Aq + t * 72 + d8) = o;
          o.x = pk2(kv[0], kv[1]); o.y = pk2(kv[2], kv[3]); o.z = pk2(kv[4], kv[5]); o.w = pk2(kv[6], kv[7]); *(LAS u32x4*)(Bk + t * 72 + d8) = o; }
        { u32x4 o0, o1; o0.x = vv[0] | ((unsigned)vv[1] << 16); o0.y = vv[2] | ((unsigned)vv[3] << 16); o0.z = vv[4] | ((unsigned)vv[5] << 16); o0.w = vv[6] | ((unsigned)vv[7] << 16);
          o1.x = vv[8] | ((unsigned)vv[9] << 16); o1.y = vv[10] | ((unsigned)vv[11] << 16); o1.z = vv[12] | ((unsigned)vv[13] << 16); o1.w = vv[14] | ((unsigned)vv[15] << 16);
          *(LAS u32x4*)(Bv + dvl * 72 + ts * 16) = o0; *(LAS u32x4*)(Bv + dvl * 72 + ts * 16 + 8) = o1; }
        *(LAS u32x4*)(Bs + (tid >> 3) * 72 + (tid & 7) * 8) = st0; *(LAS u32x4*)(Bs + ((tid + 512) >> 3) * 72 + (tid & 7) * 8) = st1;
        u32x2 gwc[4]; f32x4 gnc[4];
#pragma unroll
        for (int jj = 0; jj < 4; ++jj) { gwc[jj] = gwv[jj]; gnc[jj] = gnv[jj]; }
        const int nextu = unit + stride;
        if (it + 1 < count) G3_LOAD(nextu);
        __syncthreads();
#pragma unroll
        for (int jj = 0; jj < 2; ++jj) { const int nj = (wave >> 2) * 2 + jj; f32x4 acc = {0.f, 0.f, 0.f, 0.f};
#pragma unroll
            for (int ks = 0; ks < 2; ++ks) { const bf16x8 a = *(const LAS bf16x8*)(Aq + (mi * 16 + fr) * 72 + ks * 32 + fq * 8); const bf16x8 bb = *(const LAS bf16x8*)(Bk + (nj * 16 + fr) * 72 + ks * 32 + fq * 8);
                acc = mfma16(bb, a, acc); }
            const int i = mi * 16 + fr, j0 = nj * 16 + fq * 4;
#pragma unroll
            for (int r = 0; r < 4; ++r) if (j0 + r > i) acc[r] = 0.f;
            u32x2 o; o.x = pk2(acc[0], acc[1]); o.y = pk2(acc[2], acc[3]); *(LAS u32x2*)(Ap + i * 72 + j0) = o; }
        __syncthreads();
        f32x4 oacc[4]; float ssq = 0.f;
#pragma unroll
        for (int jj = 0; jj < 4; ++jj) { const int nj = (wave >> 2) * 4 + jj; f32x4 acc = {0.f, 0.f, 0.f, 0.f};
#pragma unroll
            for (int ks = 0; ks < 2; ++ks) {
                const bf16x8 ap = *(const LAS bf16x8*)(Ap + (mi * 16 + fr) * 72 + ks * 32 + fq * 8), bv = *(const LAS bf16x8*)(Bv + (nj * 16 + fr) * 72 + ks * 32 + fq * 8);
                acc = mfma16(bv, ap, acc);
                const bf16x8 aq = *(const LAS bf16x8*)(Aq + (mi * 16 + fr) * 72 + ks * 32 + fq * 8), bs = *(const LAS bf16x8*)(Bs + (nj * 16 + fr) * 72 + ks * 32 + fq * 8);
                acc = mfma16(bs, aq, acc); }
            oacc[jj] = acc; ssq += (acc[0] * acc[0] + acc[1] * acc[1]) + (acc[2] * acc[2] + acc[3] * acc[3]); }
        ssq += __shfl_xor(ssq, 16); ssq += __shfl_xor(ssq, 32);
        if (fq == 0) red[(wave >> 2) * 64 + mi * 16 + fr] = ssq;
        __syncthreads();
        const float rstd = rsqrtf((red[mi * 16 + fr] + red[64 + mi * 16 + fr]) * (1.f / 128.f) + EPS);
        const size_t row = r0 + mi * 16 + fr;
#pragma unroll
        for (int jj = 0; jj < 4; ++jj) { const int dv0 = ((wave >> 2) * 4 + jj) * 16 + fq * 4;
            const f32x4 gn = gnc[jj]; const u32x2 gw = gwc[jj];
            const float g0 = silu(bflo(gw.x)), g1 = silu(bfhi(gw.x)), g2 = silu(bflo(gw.y)), g3 = silu(bfhi(gw.y));
            u32x2 o; o.x = pk2(oacc[jj][0] * rstd * gn[0] * g0, oacc[jj][1] * rstd * gn[1] * g1); o.y = pk2(oacc[jj][2] * rstd * gn[2] * g2, oacc[jj][3] * rstd * gn[3] * g3);
            *(u32x2*)(mixed + row * DM + 512 + h * 128 + dv0) = o; }
        __syncthreads();
        unit = nextu;
    }
#undef G3_LOAD
}

__device__ __forceinline__ void s_mixers(const Frame& F) {
    const float* projs = WSP(const float, WS_PROJS); float* mixs = WSP(float, WS_MIXS);
    const float* spool = F.in[2]; const float* sgla = F.in[3];
    const int lane = pg8::pg8_lane_id(), tid = F.wave * 64 + lane; (void)tid;
    for (int e = F.blk * 512 + tid; e < MS * 512; e += F.G * 512) { const int b = e >> 9, c = e & 511, g = c >> 7, w = 2 << g;
        const float u = projs[(size_t)b * INC + c]; float s = u;
        for (int j = 1; j < w; ++j) s += spool[((size_t)b * 15 + 15 - j) * 512 + c];
        mixs[(size_t)b * DM + c] = s / (float)w - u;
        float* so = F.out + O_SPS + (size_t)b * 15 * 512 + c;
#pragma unroll
        for (int i = 0; i < 14; ++i) so[(size_t)i * 512] = spool[((size_t)b * 15 + i + 1) * 512 + c];
        so[(size_t)14 * 512] = u; }
    LAS float* dec = (LAS float*)(F.lds); LAS float* qs = dec + 64; LAS float* ks = dec + 128; LAS float* vs = dec + 192;
    LAS float* red = dec + 320;
    LAS float* red2 = red + 2048;
    for (int it = F.blk; it < MS * 4; it += F.G) { const int b = it >> 2, h = it & 3; const float* pr = projs + (size_t)b * INC;
        if (tid < 64) { float pre = F.in[10][h * 64 + tid];
#pragma unroll
            for (int r = 0; r < 16; ++r) pre += pr[C_F + r] * F.in[9][r * 256 + h * 64 + tid];
            dec[tid] = __expf(logsig(pre) * (1.f / 16.f)); qs[tid] = pr[C_Q + h * 64 + tid] * 0.125f; ks[tid] = pr[C_K + h * 64 + tid]; }
        else if (tid < 192) vs[tid - 64] = pr[C_V + h * 128 + (tid - 64)];
        __syncthreads();
        { const int v4 = (tid & 31) * 4, dgp = tid >> 5; const f32x4 vv = *(const LAS f32x4*)(vs + v4); f32x4 po = {0.f, 0.f, 0.f, 0.f};
#pragma unroll
          for (int i = 0; i < 4; ++i) { const int d = dgp * 4 + i; const size_t off = ((size_t)(b * 4 + h) * 64 + d) * 128 + v4;
              const f32x4 s0 = __builtin_nontemporal_load((const f32x4*)(sgla + off)); const f32x4 sn = s0 * dec[d] + vv * ks[d]; __builtin_nontemporal_store(sn, (f32x4*)(F.out + O_SGS + off)); po += sn * qs[d]; }
          *(LAS f32x4*)(red + dgp * 128 + v4) = po; }
        __syncthreads();
        float o = 0.f;
        if (tid < 128) {
#pragma unroll
            for (int g = 0; g < 16; ++g) o += red[g * 128 + tid];
            const float s2 = wave_sum(o * o); if (lane == 0) red2[tid >> 6] = s2; }
        __syncthreads();
        if (tid < 128) { const float rstd = rsqrtf((red2[0] + red2[1]) * (1.f / 128.f) + EPS);
            mixs[(size_t)b * DM + 512 + h * 128 + tid] = o * rstd * F.in[13][h * 128 + tid] * silu(pr[C_G + h * 128 + tid]); }
        __syncthreads();
    }
}
constexpr int KST = 264;
__device__ __forceinline__ void p7_attn_prompt(const Frame& F) {
    const bf16* Q = WSP(const bf16, WS_Q); const bf16* KB = WSP(const bf16, WS_KB); const bf16* VT = WSP(const bf16, WS_VT); bf16* CTX = WSP(bf16, WS_CTX);
    LAS bf16* L = (LAS bf16*)F.lds;
    const int lane = pg8::pg8_lane_id(), tid = F.wave * 64 + lane; const int wave = F.wave, fr = lane & 15, fq = lane >> 4;
    for (int unit = F.blk; unit < 256; unit += F.G) {
        const int b = unit >> 5, h = (unit >> 3) & 3, qt = unit & 7; const size_t row0 = (size_t)b * SEQ + qt * 256 + wave * 32;
        const bf16* kg = KB + (size_t)(b * 4 + h) * 65536; const bf16* vg = VT + (size_t)(b * 4 + h) * 65536;
        bf16x8 qf[2][8];
#pragma unroll
        for (int mi = 0; mi < 2; ++mi)
#pragma unroll
            for (int ks = 0; ks < 8; ++ks) qf[mi][ks] = *(const bf16x8*)(Q + (row0 + mi * 16 + fr) * DM + h * 256 + ks * 32 + fq * 8);
#pragma unroll 1
        for (int i0 = 0; i0 < 16; i0 += 8) { u32x4 t[8];
#pragma unroll
          for (int i = 0; i < 8; ++i) { const int p = tid + (i0 + i) * 512; t[i] = *(const u32x4*)(kg + (p >> 5) * 256 + (p & 31) * 8); }
#pragma unroll
          for (int i = 0; i < 8; ++i) { const int p = tid + (i0 + i) * 512; *(LAS u32x4*)(L + (p >> 5) * KST + (p & 31) * 8) = t[i]; } }
        __syncthreads();
        f32x4 sacc[2][16];
        unsigned koff = (unsigned)(fr * KST + fq * 8) * 2u;
#pragma unroll
        for (int nj = 0; nj < 16; ++nj) { sacc[0][nj] = (f32x4){0.f, 0.f, 0.f, 0.f}; sacc[1][nj] = (f32x4){0.f, 0.f, 0.f, 0.f};
            const LAS unsigned char* kp = F.lds + koff; koff += 16u * KST * 2u; asm volatile("" : "+v"(koff));
            bf16x8 kf[8];
#pragma unroll
            for (int ks = 0; ks < 8; ++ks) kf[ks] = *(const LAS bf16x8*)(kp + ks * 64);
            __builtin_amdgcn_sched_barrier(0);
#pragma unroll
            for (int ks = 0; ks < 8; ++ks) { sacc[0][nj] = mfma16(kf[ks], qf[0][ks], sacc[0][nj]); sacc[1][nj] = mfma16(kf[ks], qf[1][ks], sacc[1][nj]); }
            __builtin_amdgcn_sched_barrier(0); }
        float inv[2]; bf16x8 pf[2][8];
#pragma unroll
        for (int mi = 0; mi < 2; ++mi) { float mx = -3.0e38f;
#pragma unroll
            for (int nj = 0; nj < 16; ++nj) mx = fmaxf(mx, fmaxf(fmaxf(sacc[mi][nj][0], sacc[mi][nj][1]), fmaxf(sacc[mi][nj][2], sacc[mi][nj][3])));
            mx = fmaxf(mx, __shfl_xor(mx, 16)); mx = fmaxf(mx, __shfl_xor(mx, 32));
            float sm = 0.f;
#pragma unroll
            for (int s = 0; s < 8; ++s) { float e[8];
#pragma unroll
                for (int r = 0; r < 4; ++r) { e[r] = __expf(sacc[mi][2 * s][r] - mx); e[4 + r] = __expf(sacc[mi][2 * s + 1][r] - mx); }
                sm += ((e[0] + e[1]) + (e[2] + e[3])) + ((e[4] + e[5]) + (e[6] + e[7]));
                u32x4 w; w.x = pk2(e[0], e[1]); w.y = pk2(e[2], e[3]); w.z = pk2(e[4], e[5]); w.w = pk2(e[6], e[7]); pf[mi][s] = __builtin_bit_cast(bf16x8, w); }
            sm += __shfl_xor(sm, 16); sm += __shfl_xor(sm, 32); inv[mi] = 1.f / sm; }
        __syncthreads();
#pragma unroll 1
        for (int i0 = 0; i0 < 16; i0 += 8) { u32x4 t[8];
#pragma unroll
          for (int i = 0; i < 8; ++i) { const int p = tid + (i0 + i) * 512; t[i] = *(const u32x4*)(vg + (p >> 5) * 256 + (p & 31) * 8); }
#pragma unroll
          for (int i = 0; i < 8; ++i) { const int p = tid + (i0 + i) * 512; *(LAS u32x4*)(L + (p >> 5) * KST + (p & 31) * 8) = t[i]; } }
        __syncthreads();
        unsigned voff = (unsigned)(fr * KST + fq * 8) * 2u;
        bf16* cp = CTX + (row0 + fr) * DM + h * 256 + fq * 4;
#pragma unroll
        for (int nj = 0; nj < 16; ++nj) { f32x4 o0 = {0.f, 0.f, 0.f, 0.f}, o1 = {0.f, 0.f, 0.f, 0.f};
            const LAS unsigned char* vp = F.lds + voff; voff += 16u * KST * 2u; asm volatile("" : "+v"(voff));
            bf16x8 vf[8];
#pragma unroll
            for (int s = 0; s < 8; ++s) vf[s] = *(const LAS bf16x8*)(vp + s * 64);
            __builtin_amdgcn_sched_barrier(0);
#pragma unroll
            for (int s = 0; s < 8; ++s) { o0 = mfma16(vf[s], pf[0][s], o0); o1 = mfma16(vf[s], pf[1][s], o1); }
            __builtin_amdgcn_sched_barrier(0);
            u32x2 w0; w0.x = pk2(o0[0] * inv[0], o0[1] * inv[0]); w0.y = pk2(o0[2] * inv[0], o0[3] * inv[0]); *(u32x2*)(cp + nj * 16) = w0;
            u32x2 w1; w1.x = pk2(o1[0] * inv[1], o1[1] * inv[1]); w1.y = pk2(o1[2] * inv[1], o1[3] * inv[1]); *(u32x2*)(cp + 16 * DM + nj * 16) = w1; }
        __syncthreads();
    }
}
__device__ __forceinline__ void s_attn(const Frame& F) {
    const float* qsb = WSP(const float, WS_QS); float* ctxs = WSP(float, WS_CTXS); const float* ck = F.in[4]; const float* cv = F.in[5];
    LAS float* part = (LAS float*)F.lds; LAS float* ml = part + 8 * 256;
    const int lane = pg8::pg8_lane_id(), tid = F.wave * 64 + lane; const int wave = F.wave;
    for (int it = F.blk; it < MS * 4; it += F.G) { const int b = it >> 2, h = it & 3;
        const f32x4 q4 = *(const f32x4*)(qsb + (size_t)b * DM + h * 256 + lane * 4);
        const float* kb = ck + ((size_t)b * 256 * 4 + h) * 256 + lane * 4 + (size_t)(wave * 32) * 1024;
        const float* vb = cv + ((size_t)b * 256 * 4 + h) * 256 + lane * 4 + (size_t)(wave * 32) * 1024;
        float mrun = -3.0e38f, l = 0.f; f32x4 acc = {0.f, 0.f, 0.f, 0.f};
#pragma unroll 1
        for (int i0 = 0; i0 < 32; i0 += 8) { f32x4 k4[8], v4[8]; float sc[8];
#pragma unroll
            for (int u = 0; u < 8; ++u) { k4[u] = __builtin_nontemporal_load((const f32x4*)(kb + (size_t)(i0 + u) * 1024)); v4[u] = __builtin_nontemporal_load((const f32x4*)(vb + (size_t)(i0 + u) * 1024)); }
            float mx = mrun;
#pragma unroll
            for (int u = 0; u < 8; ++u) { sc[u] = wave_sum((k4[u][0] * q4[0] + k4[u][1] * q4[1]) + (k4[u][2] * q4[2] + k4[u][3] * q4[3])); mx = fmaxf(mx, sc[u]); }
            const float rescale = __expf(mrun - mx); l *= rescale; acc = acc * rescale; mrun = mx;
#pragma unroll
            for (int u = 0; u < 8; ++u) { const float p = __expf(sc[u] - mx); l += p; acc += v4[u] * p; } }
        *(LAS f32x4*)(part + wave * 256 + lane * 4) = acc; if (lane == 0) { ml[wave * 2] = mrun; ml[wave * 2 + 1] = l; }
        __syncthreads();
        if (tid < 256) { float M = -3.0e38f;
#pragma unroll
            for (int w = 0; w < 8; ++w) M = fmaxf(M, ml[w * 2]);
            float o = 0.f, L = 0.f;
#pragma unroll
            for (int w = 0; w < 8; ++w) { const float e = __expf(ml[w * 2] - M); L += e * ml[w * 2 + 1]; o += e * part[w * 256 + tid]; }
            ctxs[(size_t)b * DM + h * 256 + tid] = o / L; }
        __syncthreads();
    }
}
__device__ __forceinline__ void final_norm_prompt(const Frame& F) {
    const int lane = pg8::pg8_lane_id(), tid = F.wave * 64 + lane; (void)tid;
    const int gw = F.blk * NWAVES + F.wave, NGW = F.G * NWAVES; const f32x4* g4 = (const f32x4*)F.in[24] + lane;
    for (int m = gw; m < MP; m += NGW) { f32x4* xr = (f32x4*)(F.out + O_YP + (size_t)m * DM) + lane; f32x4 v[4]; float s = 0.f;
#pragma unroll
        for (int j = 0; j < 4; ++j) { v[j] = xr[64 * j]; s += (v[j].x * v[j].x + v[j].y * v[j].y) + (v[j].z * v[j].z + v[j].w * v[j].w); }
        const float rstd = rsqrtf(wave_sum(s) * (1.f / DM) + EPS);
#pragma unroll
        for (int j = 0; j < 4; ++j) xr[64 * j] = v[j] * rstd * g4[64 * j]; }
}
__device__ __forceinline__ void final_norm_sample(const Frame& F) {
    const int lane = pg8::pg8_lane_id(), tid = F.wave * 64 + lane; (void)tid;
    const int gw = F.blk * NWAVES + F.wave, NGW = F.G * NWAVES; const f32x4* g4 = (const f32x4*)F.in[24] + lane; const float* parts = WSP(const float, WS_PARTS);
    for (int m = gw; m < MS; m += NGW) { f32x4* xr = (f32x4*)(F.out + O_YS + (size_t)m * DM) + lane; f32x4 v[4]; float s = 0.f;
#pragma unroll
        for (int j = 0; j < 4; ++j) { v[j] = xr[64 * j];
#pragma unroll
            for (int ks = 0; ks < 4; ++ks) v[j] += ((const f32x4*)(parts + ((size_t)ks * MS + m) * DM) + lane)[64 * j];
            s += (v[j].x * v[j].x + v[j].y * v[j].y) + (v[j].z * v[j].z + v[j].w * v[j].w); }
        const float rstd = rsqrtf(wave_sum(s) * (1.f / DM) + EPS);
#pragma unroll
        for (int j = 0; j < 4; ++j) xr[64 * j] = v[j] * rstd * g4[64 * j]; }
}
#define RLX_AGENT __ATOMIC_RELAXED, __HIP_MEMORY_SCOPE_AGENT
#define XB_TMO      128
#define XB_XCNT(j)  (256  + 64 * (j))
#define XB_XSUB(j)  (1280 + 64 * (j))
#define XB_XGEN(j)  (2304 + 64 * (j))
#define XB_TOP      3328
#define XB_TOPGEN   3392
#define XCD_BAR_WORDS 3456
#define XB_SPIN_CAP (1u << 18)

__device__ __forceinline__ unsigned xb_ld(unsigned* p)              { return __hip_atomic_load(p, __ATOMIC_RELAXED, __HIP_MEMORY_SCOPE_AGENT); }
__device__ __forceinline__ unsigned xb_add(unsigned* p, unsigned v) { return __hip_atomic_fetch_add(p, v, __ATOMIC_RELAXED, __HIP_MEMORY_SCOPE_AGENT); }
__device__ __forceinline__ unsigned xb_xcc_id() { return (unsigned)__builtin_amdgcn_s_getreg((3 << 11) | 20) & 0xFu; }
#define XB_SPIN(cond, bar) do { unsigned _sp = 0; while (cond) { __builtin_amdgcn_s_sleep(1); \
    if ((++_sp & 255u) == 0u) { if (xb_ld(&(bar)[XB_TMO])) break; if (_sp > XB_SPIN_CAP) { atomicAdd(&(bar)[XB_TMO], 1u); break; } } } } while (0)

struct XcdBarrier {
    unsigned* bar; unsigned x;
    volatile LAS unsigned* st;
};

__device__ __forceinline__ XcdBarrier xcd_barrier_post(unsigned* bar, volatile LAS unsigned* st, bool t0) {
    XcdBarrier b; b.bar = bar; b.x = xb_xcc_id(); b.st = st;
    if (t0) (void)xb_add(&bar[XB_XCNT(b.x)], 1u);
    return b;
}
__device__ __forceinline__ void xcd_barrier_complete(unsigned* bar, unsigned x, unsigned& nloc, unsigned& nx) {
    const unsigned G = gridDim.x * gridDim.y * gridDim.z;
    unsigned sum, cnt, mine, sp = 0u;
    for (;;) {
        sum = 0u; cnt = 0u; mine = 0u;
#pragma unroll
        for (unsigned j = 0; j < 16; ++j) { const unsigned c = xb_ld(&bar[XB_XCNT(j)]); sum += c; cnt += (c > 0u) ? 1u : 0u; mine = (j == x) ? c : mine; }
        if (sum == G) break;
        __builtin_amdgcn_s_sleep(1);
        if ((++sp & 255u) == 0u) { if (xb_ld(&bar[XB_TMO])) break; if (sp > XB_SPIN_CAP) { atomicAdd(&bar[XB_TMO], 1u); break; } }
    }
    nloc = mine > 0u ? mine : 1u; nx = cnt > 0u ? cnt : 1u;
}

__device__ __forceinline__ void xcd_barrier(const XcdBarrier& b, int wave) {
    asm volatile("s_waitcnt vmcnt(0)" ::: "memory");
    __syncthreads();
    if (wave == 0 && pg8::pg8_lane_id() == 0) {
        unsigned* bar = b.bar;
        __builtin_amdgcn_s_waitcnt(0);
        unsigned nloc = b.st[0], nx = b.st[1];
        if (nloc == 0u) { xcd_barrier_complete(bar, b.x, nloc, nx); b.st[0] = nloc; b.st[1] = nx; }
        const unsigned old = xb_add(&bar[XB_XSUB(b.x)], 1u);
        const unsigned gen = old / nloc;
        if (old + 1u == (gen + 1u) * nloc) {
            __builtin_amdgcn_fence(__ATOMIC_RELEASE, "agent");
            asm volatile("s_waitcnt vmcnt(0)" ::: "memory");
            const unsigned og = xb_add(&bar[XB_TOP], 1u);
            const unsigned tg = og / nx;
            if (og + 1u == (tg + 1u) * nx) xb_add(&bar[XB_TOPGEN], 1u);
            else XB_SPIN(xb_ld(&bar[XB_TOPGEN]) == tg, bar);
            __builtin_amdgcn_fence(__ATOMIC_ACQUIRE, "agent");
            xb_add(&bar[XB_XGEN(b.x)], 1u);
            asm volatile("s_waitcnt vmcnt(0)" ::: "memory");
        } else {
            XB_SPIN(xb_ld(&bar[XB_XGEN(b.x)]) == gen, bar);
            __builtin_amdgcn_fence(__ATOMIC_ACQUIRE, "agent");
            asm volatile("s_waitcnt vmcnt(0)" ::: "memory");
        }
    }
    __syncthreads();
}
#ifndef MK_N_LAUNCHES
#define MK_N_LAUNCHES 1
#endif
constexpr int N_PHASES = 12;
#ifndef REPX
#define REPX 0
#endif
#define AMP_WAIT() do { __syncthreads(); const unsigned long long t1_ = __builtin_amdgcn_s_memrealtime(); while (__builtin_amdgcn_s_memrealtime() < t1_ + (t1_ - t0_)) __builtin_amdgcn_s_sleep(8); __syncthreads(); } while (0)
#define RX(bit) for (int rx_ = 0; rx_ < 1 + ((REPX >> (bit)) & 1); ++rx_)
struct Args { const float* in[25]; float* out; unsigned char* ws; int ph_lo, ph_hi; };
struct RotOrder {
    pg8::StaticOrder S;
    __device__ void init(int M, int N, int G, int c, int rot) { S.init(M, N, G, (c + G - (rot % G)) % G); }
    __device__ bool next(int i, pg8::Unit& u) const { return S.next(i, u); }
    __device__ __forceinline__ void a_ready(const pg8::Unit&) const {}
    __device__ __forceinline__ void done(const pg8::Unit&) const {}
};
__global__ void __launch_bounds__(NWAVES * 64, 2) mk_fwd(Args args) {
    extern __shared__ __attribute__((aligned(16))) unsigned char lds_raw[];
    Frame F;
    F.lds = (LAS unsigned char*)lds_raw;
    F.wave = __builtin_amdgcn_readfirstlane((int)threadIdx.x >> 6);
    F.G = gridDim.x; F.blk = blockIdx.x;
#pragma unroll
    for (int i = 0; i < 25; ++i) F.in[i] = args.in[i];
    F.out = args.out; F.ws = args.ws;
    const int lo = args.ph_lo, hi = args.ph_hi;
#define IN(k) (lo <= (k) && (k) < hi)
    volatile LAS unsigned* bst = (volatile LAS unsigned*)(F.lds + 143360);
    { const int l0 = pg8::pg8_lane_id(); if (F.wave == 0 && l0 < 2) bst[l0] = 0u; }
    __syncthreads();
    XcdBarrier bar = xcd_barrier_post((unsigned*)args.ws, bst, F.wave == 0 && pg8::pg8_lane_id() == 0);
    if (lo < 0) cg::this_grid().sync();
#define GRID_BAR() xcd_barrier(bar, F.wave)
#define SEAM(k) do { if (IN(k) && IN((k) + 1)) GRID_BAR(); } while (0)
    typedef pg8::bf16_t pb;
    if (IN(0)) { constexpr int rep = 0; (void)rep; p0_prologue(F); __syncthreads(); }
    SEAM(0);
    if (IN(1)) { constexpr int rep = 0; (void)rep;
        RX(10) { SEpiStore E{WSP(float, WS_PROJS), INC, 1.f}; skinny_gemm<true>(F, F.in[1], DM, WSP(const bf16, WS_WIN), DM, DM, INC / 16, 1, E); }
        { pg8::Gemm g{WSP(const pb, WS_H), WSP(const pb, WS_WIN), MP, INP, DM}; pg8::StaticOrder S; S.init(MP, INP, F.G, F.blk);
          pg8::EpiScale<0, 1> E{WSP(pb, WS_PROJ), INP, WSP(const float, WS_SSQ0), 1.f}; pg8::gemm_phase<pg8::EpiScale<0, 1>, pg8::StaticOrder, true, true>(F.lds, F.wave, g, S, E); }
    }
    SEAM(1);
    if (IN(2)) { constexpr int rep = 0; (void)rep; RX(7) s_mixers(F); RX(6) p2_pool_prompt(F); RX(5) p2_gla_local(F); }
    SEAM(2);
    if (IN(3)) { constexpr int rep = 0; (void)rep;
        { SEpiRes E{F.in[1], F.out + O_YS}; skinny_gemm<false>(F, WSP(const float, WS_MIXS), DM, WSP(const bf16, WS_WOUT), DM, DM, DM / 16, 1, E); }
        RX(2) p3_gla_scan(F);
        { pg8::Gemm g{WSP(const pb, WS_MN), WSP(const pb, WS_WKV), NB * 256, 2048, DM}; RotOrder S; S.init(NB * 256, 2048, F.G, F.blk, 128);
          pg8::EpiKV E{F.out + O_KP, F.out + O_VP, WSP(pb, WS_KB), WSP(pb, WS_VT), WSP(const float, WS_SSQ0) + MP}; pg8::gemm_phase<pg8::EpiKV, RotOrder, true, true>(F.lds, F.wave, g, S, E); }
    }
    SEAM(3);
    if (IN(4)) { constexpr int rep = 0; (void)rep;
        RX(4) { SEpiStore E{WSP(float, WS_QS), DM, 0.0625f}; skinny_gemm<true>(F, F.out + O_YS, DM, WSP(const bf16, WS_WQM), DM, DM, DM / 16, 1, E); }
        RX(3) p4_gla_out(F, DM / 16);
    }
    SEAM(4);
    if (IN(5)) { constexpr int rep = 0; (void)rep;
        if (F.blk & 1) { RX(9) s_attn(F); }
        { pg8::Gemm g{WSP(const pb, WS_H), WSP(const pb, WS_WOUT), MP, DM, DM}; pg8::StaticOrder S; S.init(MP, DM, F.G, F.blk);
          pg8::EpiRes<true, true, true, false, false> E{F.in[0], nullptr, WSP(pb, WS_XB), WSP(float, WS_SSQ1)}; pg8::gemm_phase<pg8::EpiRes<true, true, true, false, false>, pg8::StaticOrder, true, true>(F.lds, F.wave, g, S, E); }
        if (!(F.blk & 1)) { __syncthreads(); s_attn(F); }
    }
    SEAM(5);
    if (IN(6)) { constexpr int rep = 0; (void)rep;
        if (rep == 0) { SEpiRes E{F.out + O_YS, F.out + O_YS}; skinny_gemm<false>(F, WSP(const float, WS_CTXS), DM, WSP(const bf16, WS_WOM), DM, DM, DM / 16, 1, E); }
        { pg8::Gemm g{WSP(const pb, WS_XB), WSP(const pb, WS_WQM), MP, DM, DM}; pg8::StaticOrder S; S.init(MP, DM, F.G, F.blk);
          pg8::EpiScale<0> E{WSP(pb, WS_Q), DM, WSP(const float, WS_SSQ1), 0.0625f}; pg8::gemm_phase<pg8::EpiScale<0>, pg8::StaticOrder, true, true>(F.lds, F.wave, g, S, E); }
    }
    SEAM(6);
    if (IN(7)) { constexpr int rep = 0; (void)rep;
        if (F.blk & 1) { RX(0) { SEpiRelu2 E{WSP(float, WS_HFFS)}; skinny_gemm<true>(F, F.out + O_YS, DM, WSP(const bf16, WS_WUP), DM, DM, FF / 16, 1, E); } }
        __syncthreads();
        RX(1) p7_attn_prompt(F);
        if (!(F.blk & 1)) { SEpiRelu2 E{WSP(float, WS_HFFS)}; skinny_gemm<true>(F, F.out + O_YS, DM, WSP(const bf16, WS_WUP), DM, DM, FF / 16, 1, E); }
    }
    SEAM(7);
    if (IN(8)) { constexpr int rep = 0; (void)rep;
        if (F.blk & 1) { SEpiPart E{WSP(float, WS_PARTS)}; skinny_gemm<false>(F, WSP(const float, WS_HFFS), FF, WSP(const bf16, WS_WDN), FF, DM, DM / 16, 4, E); }
        { pg8::Gemm g{WSP(const pb, WS_CTX), WSP(const pb, WS_WOM), MP, DM, DM}; pg8::StaticOrder S; S.init(MP, DM, F.G, F.blk);
          pg8::EpiRes<true, true, false, true, false> E{nullptr, nullptr, WSP(pb, WS_XB), WSP(float, WS_SSQ2)}; pg8::gemm_phase<pg8::EpiRes<true, true, false, true, false>, pg8::StaticOrder, true, true>(F.lds, F.wave, g, S, E); }
        if (!(F.blk & 1)) { SEpiPart E{WSP(float, WS_PARTS)}; skinny_gemm<false>(F, WSP(const float, WS_HFFS), FF, WSP(const bf16, WS_WDN), FF, DM, DM / 16, 4, E); }
    }
    SEAM(8);
    if (IN(9)) { constexpr int rep = 0; (void)rep;
        if (rep == 0) final_norm_sample(F);
        { pg8::Gemm g{WSP(const pb, WS_XB), WSP(const pb, WS_WUP), MP, FF, DM}; pg8::StaticOrder S; S.init(MP, FF, F.G, F.blk);
          pg8::EpiScale<1> E{WSP(pb, WS_HFF), FF, WSP(const float, WS_SSQ2), 1.f}; pg8::gemm_phase<pg8::EpiScale<1>, pg8::StaticOrder, true, true>(F.lds, F.wave, g, S, E); }
    }
    SEAM(9);
    if (IN(10)) { constexpr int rep = 0; (void)rep;
        pg8::Gemm g{WSP(const pb, WS_HFF), WSP(const pb, WS_WDN), MP, DM, FF}; pg8::StaticOrder S; S.init(MP, DM, F.G, F.blk);
        if (F.G == 256) {
            pg8::EpiResRms E{WSP(const pb, WS_XB), F.out + O_YP, F.in[24], WSP(unsigned, WS_SSQ1), (unsigned*)(args.ws + 32768)};
            pg8::gemm_phase<pg8::EpiResRms, pg8::StaticOrder, false, true>(F.lds, F.wave, g, S, E);
        } else { pg8::EpiRes<false, false, false, true, true> E{nullptr, F.out + O_YP, WSP(pb, WS_XB), nullptr}; pg8::gemm_phase<pg8::EpiRes<false, false, false, true, true>, pg8::StaticOrder, true, true>(F.lds, F.wave, g, S, E); }
    }
    if (F.G != 256) SEAM(10);
    if (IN(11) && F.G != 256) { constexpr int rep = 0; (void)rep; final_norm_prompt(F); }
    if ((REPX >> 8) & 1) { for (int q = 0; q < 4; ++q) { GRID_BAR(); } }
#undef IN
#undef SEAM
}

extern "C" void kernel_launch(void* const* d_in, const int* in_sizes, int n_in, void* d_out, int out_size, void* d_ws, size_t ws_size, hipStream_t stream) {
    static int grid = 0;
    if (grid == 0) {
        if (n_in != 25 || ws_size < WS_END) { fprintf(stderr, "kernel_launch: unexpected inputs (n_in %d, ws %zu)\n", n_in, ws_size); grid = -1; return; }
        int dev = 0, cus = 0, per_cu = 0;
        hipGetDevice(&dev); hipDeviceGetAttribute(&cus, hipDeviceAttributeMultiprocessorCount, dev);
        if (hipFuncSetAttribute((const void*)mk_fwd, hipFuncAttributeMaxDynamicSharedMemorySize, LDS_BYTES) != hipSuccess) { fprintf(stderr, "kernel_launch: hipFuncSetAttribute failed\n"); grid = -1; return; }
        if (hipOccupancyMaxActiveBlocksPerMultiprocessor(&per_cu, (const void*)mk_fwd, NWAVES * 64, LDS_BYTES) != hipSuccess || per_cu < 1) { fprintf(stderr, "kernel_launch: occupancy query says %d\n", per_cu); per_cu = 1; }
        (void)hipGetLastError();
        grid = cus * 1;
        fprintf(stderr, "kernel_launch: grid %d (cus %d, per_cu %d)\n", grid, cus, per_cu);
    }
    if (grid < 0) return;
    if (hipMemsetAsync(d_ws, 0, 65536, stream) != hipSuccess) { fprintf(stderr, "kernel_launch: memset failed\n"); return; }
    Args a{};
    for (int i = 0; i < 25; ++i) a.in[i] = (const float*)d_in[i];
    a.out = (float*)d_out; a.ws = (unsigned char*)d_ws;
#if MK_N_LAUNCHES == 1
    a.ph_lo = 0; a.ph_hi = N_PHASES;
    void* kargs[] = {&a};
    hipError_t e = hipLaunchCooperativeKernel((const void*)mk_fwd, dim3(grid), dim3(NWAVES * 64), kargs, LDS_BYTES, stream);
    if (e != hipSuccess) fprintf(stderr, "cooperative launch failed: %s (grid %d)\n", hipGetErrorString(e), grid);
#else
    for (int p = 0; p < N_PHASES; ++p) { a.ph_lo = p; a.ph_hi = p + 1; hipLaunchKernelGGL(mk_fwd, dim3(grid), dim3(NWAVES * 64), LDS_BYTES, stream, a); }
#endif
}
```

```cpp
#include <hip/hip_runtime.h>
#include <hip/hip_cooperative_groups.h>
#include <cstdio>
#include <cstdint>
namespace cg = cooperative_groups;
namespace pg8 {
#define PG8_LAS __attribute__((address_space(3)))
typedef unsigned short bf16_t;
typedef short bf16x8 __attribute__((ext_vector_type(8)));
typedef float f32x4 __attribute__((ext_vector_type(4)));
typedef unsigned u32x4 __attribute__((ext_vector_type(4)));
constexpr int BM = 256, BK = 64, HALF = 128, HTB = HALF * BK * 2  , STAGE_BYTES = 8 * HTB, NXCD = 8, WGM = 8;

__host__ __device__ __forceinline__ int lds_byte(int r, int c) { const int st = (r >> 4) * 2 + (c >> 5), rr = r & 15, cc = c & 31, ob = rr * 64 + cc * 2; return st * 1024 + (ob ^ (((ob >> 9) & 1) << 5)); }
__host__ __device__ __forceinline__ void stage_rc(int b, int& R, int& C) { const int st = b / 1024, sb = b % 1024, swz = sb ^ (((sb >> 9) & 1) << 5); R = (st >> 1) * 16 + swz / 64; C = (st & 1) * 32 + (swz % 64) / 2; }
__host__ __device__ __forceinline__ int perm32(int rho) { const int n = rho >> 4, i = rho & 15; return 8 * (i >> 2) + 4 * n + (i & 3); }

struct Unit { int pm, pn; };
struct Gemm { const bf16_t* A; const bf16_t* Bt; int M, N, K; };

struct StaticOrder {
    int nM, nN, nwg, G, c;
    __host__ __device__ void init(int M, int N, int G_, int c_) { nM = M / BM; nN = N / BM; nwg = nM * nN; G = G_; c = c_; }
    __host__ __device__ bool next(int i, Unit& u) const {
        const long L = (long)i * G + c; if (L >= nwg) return false;
        int wgid = (int)L; { const int q = nwg / NXCD, r = nwg % NXCD, xcd = wgid % NXCD, off = wgid / NXCD; wgid = (xcd < r ? xcd * (q + 1) : r * (q + 1) + (xcd - r) * q) + off; }
        const int nig = WGM * nN, gid = wgid / nig, fm = gid * WGM, gsz = (nM - fm) < WGM ? (nM - fm) : WGM;
        u.pm = fm + ((wgid % nig) % gsz); u.pn = (wgid % nig) / gsz; return true;
    }
    __device__ __forceinline__ void a_ready(const Unit&) const {}
    __device__ __forceinline__ void done(const Unit&) const {}
};

typedef float f32x2 __attribute__((ext_vector_type(2)));
typedef __bf16 bf16x2_t __attribute__((ext_vector_type(2)));
__device__ __forceinline__ unsigned cvt_pk_bf16(float lo, float hi) { const f32x2 v = {lo, hi}; return __builtin_bit_cast(unsigned, __builtin_convertvector(v, bf16x2_t)); }
__device__ __forceinline__ int pg8_lane_id() { int l; asm volatile("v_mbcnt_lo_u32_b32 %0, -1, 0\n\tv_mbcnt_hi_u32_b32 %0, -1, %0" : "=v"(l)); return l; }
typedef unsigned u32x2 __attribute__((ext_vector_type(2)));
struct EpiPlainBf16 {
    static constexpr bool PERM = true, AFTER_DRAIN = false;
    bf16_t* O; int ldc;
    __device__ __forceinline__ void operator()(const f32x4 (&acc)[2][2][4][2], const Unit& u, int wr, int wc, int fr, int fq) const {
        asm volatile("" : "+v"(fr), "+v"(fq));
        const int row0 = u.pm * BM + wr * 64 + fr, col0 = u.pn * BM + wc * 32 + 8 * fq;
#pragma unroll
        for (int ai = 0; ai < 2; ++ai)
#pragma unroll
            for (int m = 0; m < 4; ++m) { bf16_t* rowp = O + (size_t)(row0 + ai * HALF + m * 16) * ldc + col0;
#pragma unroll
                for (int bj = 0; bj < 2; ++bj) { const f32x4 v0 = acc[ai][bj][m][0], v1 = acc[ai][bj][m][1];
                    u32x4 w; w.x = cvt_pk_bf16(v0[0], v0[1]); w.y = cvt_pk_bf16(v0[2], v0[3]); w.z = cvt_pk_bf16(v1[0], v1[1]); w.w = cvt_pk_bf16(v1[2], v1[3]);
                    *(u32x4*)(rowp + bj * HALF) = w; } }
    }
};
struct EpiKV {
    static constexpr bool PERM = true, AFTER_DRAIN = false;
    float* outK; float* outV; bf16_t* KB; bf16_t* VT; const float* ssq;
    __device__ __forceinline__ void operator()(const f32x4 (&acc)[2][2][4][2], const Unit& u, int wr, int wc, int fr, int fq) const {
        asm volatile("" : "+v"(fr), "+v"(fq));
        const bool isV = u.pn >= 4; const int h = u.pn & 3, b = u.pm;
        float* of = isV ? outV : outK;
        const int ct0 = wc * 32 + 8 * fq;
#pragma unroll
        for (int ai = 0; ai < 2; ++ai)
#pragma unroll
            for (int m = 0; m < 4; ++m) { const int key = ai * HALF + wr * 64 + m * 16 + fr; const float rs = rsqrtf(ssq[b * 256 + key] * (1.0f / 1024.0f) + 1e-6f);
#pragma unroll
                for (int bj = 0; bj < 2; ++bj) { const f32x4 v0 = acc[ai][bj][m][0] * rs, v1 = acc[ai][bj][m][1] * rs; const int ct = ct0 + bj * HALF;
                    float* fp = of + (size_t)(b * 256 + key) * 1024 + h * 256 + ct;
                    __builtin_nontemporal_store(v0, (f32x4*)fp); __builtin_nontemporal_store(v1, (f32x4*)(fp + 4));
                    if (!isV) { u32x4 w; w.x = cvt_pk_bf16(v0[0], v0[1]); w.y = cvt_pk_bf16(v0[2], v0[3]); w.z = cvt_pk_bf16(v1[0], v1[1]); w.w = cvt_pk_bf16(v1[2], v1[3]);
                        *(u32x4*)(KB + ((size_t)(b * 4 + h) * 256 + key) * 256 + ct) = w; }
                    else { const int kp = (key & ~31) | (((key >> 2) & 3) << 3) | (((key >> 4) & 1) << 2) | (key & 3);
                        bf16_t* vp = VT + ((size_t)(b * 4 + h) * 256 + ct) * 256 + kp;
#pragma unroll
                        for (int e = 0; e < 4; ++e) { vp[(size_t)e * 256] = (bf16_t)(cvt_pk_bf16(v0[e], 0.f) & 0xffffu); vp[(size_t)(e + 4) * 256] = (bf16_t)(cvt_pk_bf16(v1[e], 0.f) & 0xffffu); } }
                } }
    }
};
template <bool XB, bool SSQ, bool NTB = false, bool BASEBF = false, bool OUTF = true> struct EpiRes {
    static constexpr bool PERM = false, AFTER_DRAIN = false;
    const float* base; float* out; bf16_t* xb; float* ssq;
    __device__ __forceinline__ void operator()(const f32x4 (&acc)[2][2][4][2], const Unit& u, int wr, int wc, int fr, int fq) const {
        asm volatile("" : "+v"(fr), "+v"(fq));
        const int col0 = u.pn * BM + wc * 32 + 4 * fq;
#pragma unroll
        for (int ai = 0; ai < 2; ++ai)
#pragma unroll
            for (int m = 0; m < 4; ++m) { const int r = u.pm * BM + ai * HALF + wr * 64 + m * 16 + fr; const size_t off = (size_t)r * 1024 + col0; float s = 0.f;
#pragma unroll
                for (int bj = 0; bj < 2; ++bj)
#pragma unroll
                    for (int n = 0; n < 2; ++n) { f32x4 bs;
                        if (BASEBF) { const u32x2 w = *(const u32x2*)(xb + off + bj * HALF + n * 16); bs = (f32x4){__uint_as_float(w.x << 16), __uint_as_float(w.x & 0xffff0000u), __uint_as_float(w.y << 16), __uint_as_float(w.y & 0xffff0000u)}; }
                        else bs = NTB ? __builtin_nontemporal_load((const f32x4*)(base + off + bj * HALF + n * 16)) : *(const f32x4*)(base + off + bj * HALF + n * 16);
                        const f32x4 o = bs + acc[ai][bj][m][n];
                        if (OUTF) *(f32x4*)(out + off + bj * HALF + n * 16) = o;
                        if (SSQ) s += (o[0] * o[0] + o[1] * o[1]) + (o[2] * o[2] + o[3] * o[3]);
                        if (XB) { u32x2 w; w.x = cvt_pk_bf16(o[0], o[1]); w.y = cvt_pk_bf16(o[2], o[3]); *(u32x2*)(xb + off + bj * HALF + n * 16) = w; } }
                if (SSQ) { s += __shfl_xor(s, 16); s += __shfl_xor(s, 32); if (fq == 0) ssq[(size_t)r * 16 + u.pn * 4 + wc] = s; }
            }
    }
};
template <int MODE, int NPART = 16> struct EpiScale {
    static constexpr bool PERM = true, AFTER_DRAIN = false;
    bf16_t* O; int ldc; const float* ssq; float scale;
    __device__ __forceinline__ void operator()(const f32x4 (&acc)[2][2][4][2], const Unit& u, int wr, int wc, int fr, int fq) const {
        asm volatile("" : "+v"(fr), "+v"(fq));
        const int row0 = u.pm * BM + wr * 64 + fr, col0 = u.pn * BM + wc * 32 + 8 * fq;
#pragma unroll
        for (int ai = 0; ai < 2; ++ai)
#pragma unroll
            for (int m = 0; m < 4; ++m) { const int r = row0 + ai * HALF + m * 16; bf16_t* rowp = O + (size_t)r * ldc + col0;
                float tot;
                if (NPART == 16) { const f32x4* sp = (const f32x4*)(ssq + (size_t)r * 16); const f32x4 s0 = sp[0], s1 = sp[1], s2 = sp[2], s3 = sp[3];
                    tot = ((s0[0] + s0[1]) + (s0[2] + s0[3])) + ((s1[0] + s1[1]) + (s1[2] + s1[3])) + ((s2[0] + s2[1]) + (s2[2] + s2[3])) + ((s3[0] + s3[1]) + (s3[2] + s3[3])); }
                else tot = ssq[r];
                const float rs = rsqrtf(tot * (1.0f / 1024.0f) + 1e-6f) * (MODE == 0 ? scale : 1.0f);
#pragma unroll
                for (int bj = 0; bj < 2; ++bj) { f32x4 v0 = acc[ai][bj][m][0] * rs, v1 = acc[ai][bj][m][1] * rs;
                    if (MODE == 1) {
#pragma unroll
                        for (int e = 0; e < 4; ++e) { const float a0 = fmaxf(v0[e], 0.f), a1 = fmaxf(v1[e], 0.f); v0[e] = a0 * a0; v1[e] = a1 * a1; } }
                    u32x4 w; w.x = cvt_pk_bf16(v0[0], v0[1]); w.y = cvt_pk_bf16(v0[2], v0[3]); w.z = cvt_pk_bf16(v1[0], v1[1]); w.w = cvt_pk_bf16(v1[2], v1[3]);
                    *(u32x4*)(rowp + bj * HALF) = w; } }
    }
};

struct EpiResRms {
    static constexpr bool PERM = false, AFTER_DRAIN = true;
    const bf16_t* xbase; float* out; const float* gain; unsigned* xs; unsigned* cnt;
    __device__ __forceinline__ void fused(f32x4 (&acc)[2][2][4][2], const Unit& u, int wr, int wc, int fr, int fq, PG8_LAS unsigned char* lds, int wid, int lane) const {
        asm volatile("" : "+v"(fr), "+v"(fq));
        PG8_LAS float* P = (PG8_LAS float*)lds;
        PG8_LAS float* S = (PG8_LAS float*)(lds + 4096);
        const int col0 = u.pn * BM + wc * 32 + 4 * fq;
#pragma unroll
        for (int ai = 0; ai < 2; ++ai)
#pragma unroll
            for (int m = 0; m < 4; ++m) { const int r = ai * HALF + wr * 64 + m * 16 + fr; const size_t off = (size_t)(u.pm * BM + r) * 1024 + col0; float s = 0.f;
#pragma unroll
                for (int bj = 0; bj < 2; ++bj)
#pragma unroll
                    for (int n = 0; n < 2; ++n) { const u32x2 w = *(const u32x2*)(xbase + off + bj * HALF + n * 16); const f32x4 bs = {__uint_as_float(w.x << 16), __uint_as_float(w.x & 0xffff0000u), __uint_as_float(w.y << 16), __uint_as_float(w.y & 0xffff0000u)}; const f32x4 o = bs + acc[ai][bj][m][n]; acc[ai][bj][m][n] = o;
                        s += (o[0] * o[0] + o[1] * o[1]) + (o[2] * o[2] + o[3] * o[3]); }
                s += __shfl_xor(s, 16); s += __shfl_xor(s, 32); if (fq == 0) P[r * 4 + wc] = s;
                if (m & 1) asm volatile("" ::: "memory"); }
        asm volatile("s_waitcnt lgkmcnt(0)" ::: "memory"); __builtin_amdgcn_s_barrier(); asm volatile("" ::: "memory");
        const int row = wid * 32 + (lane & 31);
        if (lane < 32) { const float t = (P[row * 4 + 0] + P[row * 4 + 1]) + (P[row * 4 + 2] + P[row * 4 + 3]);
            __hip_atomic_store(xs + (size_t)(u.pm * BM + row) * 4 + u.pn, __float_as_uint(t), __ATOMIC_RELAXED, __HIP_MEMORY_SCOPE_AGENT); }
        asm volatile("s_waitcnt vmcnt(0)" ::: "memory");
        if (lane == 0) __hip_atomic_fetch_add(cnt + 64 * u.pm, 1u, __ATOMIC_RELAXED, __HIP_MEMORY_SCOPE_AGENT);
        if (wid == 0) { unsigned spins = 0;
            while ((unsigned)__builtin_amdgcn_readfirstlane(__hip_atomic_load(cnt + 64 * u.pm, __ATOMIC_RELAXED, __HIP_MEMORY_SCOPE_AGENT)) < 32u) { __builtin_amdgcn_s_sleep(2); if (++spins > (1u << 22)) break; }
            __builtin_amdgcn_fence(__ATOMIC_ACQUIRE, "agent"); }
        asm volatile("s_waitcnt vmcnt(0) lgkmcnt(0)" ::: "memory"); __builtin_amdgcn_s_barrier(); asm volatile("" ::: "memory");
        if (lane < 32) { const unsigned* sl = xs + (size_t)(u.pm * BM + row) * 4; float t = 0.f;
#pragma unroll
            for (int q = 0; q < 4; ++q) t += __uint_as_float(__hip_atomic_load(sl + q, __ATOMIC_RELAXED, __HIP_MEMORY_SCOPE_AGENT));
            S[row] = rsqrtf(t * (1.0f / 1024.0f) + 1e-6f); }
        asm volatile("s_waitcnt lgkmcnt(0)" ::: "memory"); __builtin_amdgcn_s_barrier(); asm volatile("" ::: "memory");
        f32x4 gv[2][2];
#pragma unroll
        for (int bj = 0; bj < 2; ++bj)
#pragma unroll
            for (int n = 0; n < 2; ++n) gv[bj][n] = *(const f32x4*)(gain + col0 + bj * HALF + n * 16);
#pragma unroll
        for (int ai = 0; ai < 2; ++ai)
#pragma unroll
            for (int m = 0; m < 4; ++m) { const int r = ai * HALF + wr * 64 + m * 16 + fr; const float rs = S[r]; const size_t off = (size_t)(u.pm * BM + r) * 1024 + col0;
#pragma unroll
                for (int bj = 0; bj < 2; ++bj)
#pragma unroll
                    for (int n = 0; n < 2; ++n) __builtin_nontemporal_store(acc[ai][bj][m][n] * rs * gv[bj][n], (f32x4*)(out + off + bj * HALF + n * 16)); }
    }
};

template <class Epi, class Sched, bool ALIGN_EPI = false, bool SP2 = false>
__device__ __forceinline__ void gemm_phase(PG8_LAS unsigned char* lds, const int wave_in, const Gemm g, const Sched& S, const Epi& E) {
    const int wid = wave_in, lane = pg8_lane_id(), tid = wid * 64 + lane, wr = wid >> 2, wc = wid & 3, fr = lane & 15, fq = lane >> 4;
    const int K = g.K, nt = K / BK;
    unsigned voffA[2], voffB[2];
#pragma unroll
    for (int i = 0; i < 2; ++i) { int R, C; stage_rc(tid * 16 + i * 8192, R, C); const int Rb = Epi::PERM ? ((R & ~31) + perm32(R & 31)) : R;
        voffA[i] = (unsigned)(R * K + C) * 2u; voffB[i] = (unsigned)(Rb * K + C) * 2u; }
    const size_t kstep = (size_t)(BK * 2);
    const size_t hstep = (size_t)HALF * K * 2;
    const size_t tstep = 2 * hstep;
    const unsigned ldsw = (unsigned)wid * 1024u;
    const int aoff = lds_byte(wr * 64 + fr, fq * 8), boff = lds_byte(wc * 32 + fr, fq * 8);
#define PG8_SA(b, h) (((b) * 2 + (h)) * HTB)
#define PG8_SB(b, h) ((4 + (b) * 2 + (h)) * HTB)
#define PG8_STAGE(bufoff, gbase, voff) do { _Pragma("unroll") for (int _i = 0; _i < 2; ++_i) \
        __builtin_amdgcn_global_load_lds((const unsigned*)((const char*)(gbase) + (voff)[_i]), (PG8_LAS unsigned*)(lds + (bufoff) + ldsw + _i * 8192), 16, 0, 0); } while (0)
#define PG8_LDA(dst, b, h) do { _Pragma("unroll") for (int m = 0; m < 4; ++m) _Pragma("unroll") for (int k = 0; k < 2; ++k) dst[m][k] = *(const PG8_LAS bf16x8*)(lds + PG8_SA(b, h) + aoff + m * 2048 + k * 1024); } while (0)
#define PG8_LDB(dst, b, h) do { _Pragma("unroll") for (int n = 0; n < 2; ++n) _Pragma("unroll") for (int k = 0; k < 2; ++k) dst[n][k] = *(const PG8_LAS bf16x8*)(lds + PG8_SB(b, h) + boff + n * 2048 + k * 1024); } while (0)
#define PG8_MMA(ai, bj, At, Bt) do { __builtin_amdgcn_s_setprio(1); _Pragma("unroll") for (int m = 0; m < 4; ++m) _Pragma("unroll") for (int n = 0; n < 2; ++n) _Pragma("unroll") for (int k = 0; k < 2; ++k) \
        acc[ai][bj][m][n] = __builtin_amdgcn_mfma_f32_16x16x32_bf16(Bt[n][k], At[m][k], acc[ai][bj][m][n], 0, 0, 0); __builtin_amdgcn_s_setprio(0); } while (0)
#define PG8_WAIT_V(n) asm volatile("s_waitcnt vmcnt(" #n ")" ::: "memory")
#define PG8_WAIT_L(n) asm volatile("s_waitcnt lgkmcnt(" #n ")" ::: "memory")
#define PG8_BAR __builtin_amdgcn_s_barrier()
#define PG8_SCHED __builtin_amdgcn_sched_barrier(0)
    Unit cur, nxt; int ui = 0;
    if (!S.next(0, cur)) return;
    f32x4 acc[2][2][4][2];
#pragma unroll
    for (int a = 0; a < 2; ++a)
#pragma unroll
        for (int b = 0; b < 2; ++b)
#pragma unroll
            for (int m = 0; m < 4; ++m)
#pragma unroll
                for (int n = 0; n < 2; ++n) acc[a][b][m][n] = (f32x4){0.f, 0.f, 0.f, 0.f};
    bf16x8 At[4][2], B0[2][2], B1[2][2];
    const char* cA = (const char*)g.A + (size_t)cur.pm * tstep; const char* cB = (const char*)g.Bt + (size_t)cur.pn * tstep;
    S.a_ready(cur);
    if constexpr (SP2) {
        PG8_STAGE(PG8_SB(0, 0), cB, voffB); PG8_STAGE(PG8_SB(0, 1), cB + hstep, voffB); PG8_STAGE(PG8_SA(0, 0), cA, voffA); PG8_STAGE(PG8_SA(0, 1), cA + hstep, voffA);
        if (wr == 1) PG8_BAR;
        PG8_WAIT_V(2); PG8_BAR;
        PG8_STAGE(PG8_SB(1, 0), cB + kstep, voffB); PG8_STAGE(PG8_SA(1, 0), cA + kstep, voffA); PG8_STAGE(PG8_SB(1, 1), cB + hstep + kstep, voffB);
        PG8_WAIT_V(6); PG8_BAR;
    } else {
        PG8_STAGE(PG8_SB(0, 0), cB, voffB); PG8_STAGE(PG8_SA(0, 0), cA, voffA); PG8_STAGE(PG8_SB(0, 1), cB + hstep, voffB); PG8_STAGE(PG8_SA(0, 1), cA + hstep, voffA);
        if (wr == 1) PG8_BAR;
        PG8_WAIT_V(4); PG8_BAR;
        PG8_STAGE(PG8_SB(1, 0), cB + kstep, voffB); PG8_STAGE(PG8_SA(1, 0), cA + kstep, voffA); PG8_STAGE(PG8_SB(1, 1), cB + hstep + kstep, voffB);
        PG8_WAIT_V(6); PG8_BAR;
    }
    for (;;) {
        const bool has_next = S.next(ui + 1, nxt);
        const char* nA = has_next ? (const char*)g.A + (size_t)nxt.pm * tstep : cA; const char* nB = has_next ? (const char*)g.Bt + (size_t)nxt.pn * tstep : cB;
        for (int t = 0; t < nt; t += 2) {
            const bool last = (t == nt - 2);
            const char* a1 = cA + (size_t)(t + 1) * kstep;
            const char* a2 = last ? nA : cA + (size_t)(t + 2) * kstep; const char* b2 = last ? nB : cB + (size_t)(t + 2) * kstep;
            const char* a3 = a2 + kstep; const char* b3 = b2 + kstep;
            if (last && has_next) S.a_ready(nxt);
            if constexpr (SP2) {
            PG8_LDB(B0, 0, 0); PG8_LDB(B1, 0, 1); PG8_SCHED; PG8_LDA(At, 0, 0); PG8_STAGE(PG8_SA(1, 1), a1 + hstep, voffA);
            PG8_WAIT_V(8); PG8_WAIT_L(0); PG8_BAR; PG8_MMA(0, 0, At, B0); PG8_MMA(0, 1, At, B1); PG8_BAR; PG8_SCHED;
            PG8_LDA(At, 0, 1); PG8_STAGE(PG8_SB(0, 0), b2, voffB); PG8_STAGE(PG8_SB(0, 1), b2 + hstep, voffB); PG8_STAGE(PG8_SA(0, 0), a2, voffA);
            PG8_WAIT_V(8); PG8_WAIT_L(0); PG8_BAR; PG8_MMA(1, 0, At, B0); PG8_MMA(1, 1, At, B1); PG8_BAR; PG8_SCHED;
            PG8_LDB(B0, 1, 0); PG8_LDB(B1, 1, 1); PG8_SCHED; PG8_LDA(At, 1, 0); PG8_STAGE(PG8_SA(0, 1), a2 + hstep, voffA);
            PG8_WAIT_V(8); PG8_WAIT_L(0); PG8_BAR; PG8_MMA(0, 0, At, B0); PG8_MMA(0, 1, At, B1); PG8_BAR; PG8_SCHED;
            PG8_LDA(At, 1, 1); PG8_STAGE(PG8_SB(1, 0), b3, voffB); PG8_STAGE(PG8_SB(1, 1), b3 + hstep, voffB); PG8_STAGE(PG8_SA(1, 0), a3, voffA);
            PG8_WAIT_V(8); PG8_WAIT_L(0); PG8_BAR; PG8_MMA(1, 0, At, B0); PG8_MMA(1, 1, At, B1); PG8_BAR; PG8_SCHED;
            } else {
            PG8_LDB(B0, 0, 0); PG8_SCHED; PG8_LDA(At, 0, 0); PG8_STAGE(PG8_SA(1, 1), a1 + hstep, voffA);
            PG8_WAIT_L(8); PG8_BAR; PG8_WAIT_L(0); PG8_MMA(0, 0, At, B0); PG8_BAR; PG8_SCHED;
            PG8_LDB(B1, 0, 1); PG8_STAGE(PG8_SB(0, 0), b2, voffB);
            PG8_BAR; PG8_WAIT_L(0); PG8_MMA(0, 1, At, B1); PG8_BAR;
            PG8_LDA(At, 0, 1); PG8_STAGE(PG8_SA(0, 0), a2, voffA);
            PG8_BAR; PG8_WAIT_L(0); PG8_MMA(1, 0, At, B0); PG8_BAR; PG8_SCHED;
            PG8_STAGE(PG8_SB(0, 1), b2 + hstep, voffB);
            PG8_WAIT_V(6); PG8_BAR; PG8_MMA(1, 1, At, B1); PG8_BAR;
            PG8_LDB(B0, 1, 0); PG8_SCHED; PG8_LDA(At, 1, 0); PG8_STAGE(PG8_SA(0, 1), a2 + hstep, voffA);
            PG8_WAIT_L(8); PG8_BAR; PG8_WAIT_L(0); PG8_MMA(0, 0, At, B0); PG8_BAR; PG8_SCHED;
            PG8_LDB(B1, 1, 1); PG8_STAGE(PG8_SB(1, 0), b3, voffB);
            PG8_BAR; PG8_WAIT_L(0); PG8_MMA(0, 1, At, B1); PG8_BAR;
            PG8_LDA(At, 1, 1); PG8_STAGE(PG8_SA(1, 0), a3, voffA);
            PG8_BAR; PG8_WAIT_L(0); PG8_MMA(1, 0, At, B0); PG8_BAR; PG8_SCHED;
            PG8_STAGE(PG8_SB(1, 1), b3 + hstep, voffB);
            PG8_WAIT_V(6); PG8_BAR; PG8_MMA(1, 1, At, B1); PG8_BAR;
            }
        }
        if constexpr (ALIGN_EPI) { if (wr == 0) PG8_BAR; }
        if constexpr (!Epi::AFTER_DRAIN) { E(acc, cur, wr, wc, fr, fq); S.done(cur); }
        if (!has_next) break;
#pragma unroll
        for (int a = 0; a < 2; ++a)
#pragma unroll
            for (int b = 0; b < 2; ++b)
#pragma unroll
                for (int m = 0; m < 4; ++m)
#pragma unroll
                    for (int n = 0; n < 2; ++n) acc[a][b][m][n] = (f32x4){0.f, 0.f, 0.f, 0.f};
        cur = nxt; cA = nA; cB = nB; ++ui;
        if constexpr (ALIGN_EPI) { if (wr == 1) PG8_BAR; }
    }
    PG8_WAIT_V(0);
    if constexpr (!ALIGN_EPI) { if (wr == 0) PG8_BAR; }
    PG8_BAR;
    if constexpr (Epi::AFTER_DRAIN) { E.fused(acc, cur, wr, wc, fr, fq, lds, wid, lane); S.done(cur); }
#undef PG8_SA
#undef PG8_SB
#undef PG8_STAGE
#undef PG8_LDA
#undef PG8_LDB
#undef PG8_MMA
#undef PG8_WAIT_V
#undef PG8_WAIT_L
#undef PG8_BAR
#undef PG8_SCHED
}
}
constexpr int NWAVES = 8;
constexpr int DM = 1024, MP = 16384, SEQ = 2048, NB = 8, MS = 128;
constexpr int INC = 2064, INP = 2048;
constexpr int C_Q = 512, C_K = 768, C_V = 1024, C_G = 1536, C_F = 2048;
constexpr int FF = 4096;
constexpr float EPS = 1e-6f;
constexpr size_t O_YP = 0, O_YS = 16777216, O_SPP = O_YS + 131072, O_SGP = O_SPP + 61440, O_KP = O_SGP + 262144, O_VP = O_KP + 2097152, O_SPS = O_VP + 2097152, O_SGS = O_SPS + 983040;
constexpr size_t MiB = 1u << 20;
constexpr size_t WS_WIN = 2 * MiB, WS_WKV = 8 * MiB, WS_WOUT = 12 * MiB, WS_WQM = 14 * MiB, WS_WOM = 16 * MiB, WS_WUP = 18 * MiB, WS_WDN = 26 * MiB;
constexpr size_t WS_MN = 34 * MiB, WS_KB = 38 * MiB, WS_VT = 42 * MiB, WS_SSQ1 = 46 * MiB, WS_SSQ2 = 47 * MiB, WS_SSQ0 = 48 * MiB  , WS_FLOW = 58 * MiB  ;
constexpr size_t WS_PROJS = 49 * MiB  , WS_MIXS = 51 * MiB  , WS_QS = 52 * MiB, WS_CTXS = 53 * MiB, WS_HFFS = 54 * MiB  , WS_PARTS = 56 * MiB  ;
constexpr size_t WS_H = 64 * MiB  , WS_XB = 96 * MiB, WS_Q = 128 * MiB, WS_CTX = 160 * MiB;
constexpr size_t WS_PROJ = 192 * MiB  , WS_GL = 264 * MiB  , WS_CUM = 296 * MiB  , WS_ST = 312 * MiB  ;
constexpr size_t WS_HFF = 192 * MiB  ;
constexpr size_t WS_END = 328 * MiB;
constexpr int LDS_BYTES = 147456;
#ifndef REPX
#define REPX 0
#endif

#define LAS __attribute__((address_space(3)))
typedef unsigned short bf16;
typedef unsigned u32x4 __attribute__((ext_vector_type(4)));
typedef unsigned u32x2 __attribute__((ext_vector_type(2)));
typedef float f32x4 __attribute__((ext_vector_type(4)));
typedef short bf16x8 __attribute__((ext_vector_type(8)));
typedef short bf16x4 __attribute__((ext_vector_type(4)));
#define LDS_WAIT() asm volatile("s_waitcnt lgkmcnt(0)" ::: "memory")
__device__ __forceinline__ unsigned pk2(float lo, float hi) { return pg8::cvt_pk_bf16(lo, hi); }
__device__ __forceinline__ float bf2f(unsigned short h) { return __uint_as_float((unsigned)h << 16); }
__device__ __forceinline__ float bflo(unsigned w) { return __uint_as_float(w << 16); }
__device__ __forceinline__ float bfhi(unsigned w) { return __uint_as_float(w & 0xffff0000u); }
__device__ __forceinline__ float wave_sum(float v) {
#pragma unroll
    for (int o = 1; o < 64; o <<= 1) v += __shfl_xor(v, o);
    return v;
}
__device__ __forceinline__ float wave_max(float v) {
#pragma unroll
    for (int o = 1; o < 64; o <<= 1) v = fmaxf(v, __shfl_xor(v, o));
    return v;
}
__device__ __forceinline__ float logsig(float x) { return fminf(x, 0.f) - log1pf(__expf(-fabsf(x))); }
__device__ __forceinline__ float silu(float x) { return x / (1.f + __expf(-x)); }
__device__ __forceinline__ f32x4 mfma16(bf16x8 a, bf16x8 b, f32x4 c) { return __builtin_amdgcn_mfma_f32_16x16x32_bf16(a, b, c, 0, 0, 0); }

struct Frame {
    LAS unsigned char* lds;
    int wave, G, blk;
    const float* in[25]; float* out; unsigned char* ws;
};
#define WSP(T, off) ((T*)(F.ws + (off)))

__device__ __forceinline__ void rows16_pass(const float* X, bf16* XB16, float* ssq, float* FL, const LAS bf16* Wf, int row0, int lane) {
    const int r = lane & 15, q = lane >> 4;
    const float* xp = X + (size_t)(row0 + r) * DM + q * 8; bf16* hp = XB16 + (size_t)(row0 + r) * DM + q * 8;
    f32x4 acc = {0.f, 0.f, 0.f, 0.f}; float ss = 0.f;
#pragma unroll 1
    for (int c0 = 0; c0 < 32; c0 += 8) { f32x4 a[16];
#pragma unroll
        for (int u = 0; u < 8; ++u) { a[2 * u] = __builtin_nontemporal_load((const f32x4*)(xp + (c0 + u) * 32)); a[2 * u + 1] = __builtin_nontemporal_load((const f32x4*)(xp + (c0 + u) * 32 + 4)); }
#pragma unroll
        for (int u = 0; u < 8; ++u) { const f32x4 a0 = a[2 * u], a1 = a[2 * u + 1];
            ss += ((a0[0] * a0[0] + a0[1] * a0[1]) + (a0[2] * a0[2] + a0[3] * a0[3])) + ((a1[0] * a1[0] + a1[1] * a1[1]) + (a1[2] * a1[2] + a1[3] * a1[3]));
            u32x4 aw; aw.x = pk2(a0[0], a0[1]); aw.y = pk2(a0[2], a0[3]); aw.z = pk2(a1[0], a1[1]); aw.w = pk2(a1[2], a1[3]);
            *(u32x4*)(hp + (c0 + u) * 32) = aw;
            if (FL) { const bf16x8 wfr = *(const LAS bf16x8*)(Wf + r * 1032 + (c0 + u) * 32 + q * 8); acc = mfma16(wfr, __builtin_bit_cast(bf16x8, aw), acc); } } }
    ss += __shfl_xor(ss, 16); ss += __shfl_xor(ss, 32);
    if (q == 0) ssq[row0 + r] = ss;
    if (FL) { acc = acc * rsqrtf(ss * (1.f / DM) + EPS); *(f32x4*)(FL + (size_t)(row0 + r) * 16 + q * 4) = acc; }
}
__device__ __forceinline__ void p0_prologue(const Frame& F) {
    const int lane = pg8::pg8_lane_id(), tid = F.wave * 64 + lane; (void)tid;
    LAS bf16* Wf = (LAS bf16*)(F.lds + 98304);
    { const float* win = F.in[8]; const float* gm = F.in[7];
#pragma unroll
      for (int kk = 0; kk < 2; ++kk) { const int k = tid * 2 + kk; const float g = gm[k]; const f32x4* wr = (const f32x4*)(win + (size_t)k * INC + 2048);
#pragma unroll
          for (int j4 = 0; j4 < 4; ++j4) { const f32x4 w = wr[j4];
#pragma unroll
              for (int e = 0; e < 4; ++e) Wf[(j4 * 4 + e) * 1032 + k] = (bf16)(pk2(w[e] * g, 0.f) & 0xffffu); } } }
    __syncthreads();
    { const float* wp = F.in[11]; const float* ps = F.in[12]; const float* wo = F.in[14]; bf16* wt = WSP(bf16, WS_WOUT);
      LAS float* Wp = (LAS float*)F.lds; LAS float* Wo = (LAS float*)(F.lds + 65536);
      for (int it = F.blk; it < 64; it += F.G) { const int g = it >> 4, n0 = (it & 15) * 64;
#pragma unroll
          for (int i = 0; i < 8; ++i) { const int i4 = (i * 512 + tid) * 4; *(LAS f32x4*)(Wp + i4) = *(const f32x4*)(wp + (size_t)g * 16384 + i4); }
#pragma unroll
          for (int i = 0; i < 16; ++i) { const int e = i * 512 + tid, d = e >> 6, nn = e & 63; Wo[e] = wo[(size_t)(g * 128 + d) * DM + n0 + nn] * ps[g * 128 + d]; }
          __syncthreads();
          const int n = tid & 63; float acc[16];
#pragma unroll
          for (int ci = 0; ci < 16; ++ci) acc[ci] = 0.f;
#pragma unroll 2
          for (int d4 = 0; d4 < 32; ++d4) { const float a0 = Wo[(d4 * 4 + 0) * 64 + n], a1 = Wo[(d4 * 4 + 1) * 64 + n], a2 = Wo[(d4 * 4 + 2) * 64 + n], a3 = Wo[(d4 * 4 + 3) * 64 + n];
#pragma unroll
              for (int ci = 0; ci < 16; ++ci) { const f32x4 w4 = *(const LAS f32x4*)(Wp + (F.wave * 16 + ci) * 128 + d4 * 4); acc[ci] += (w4[0] * a0 + w4[1] * a1) + (w4[2] * a2 + w4[3] * a3); } }
          u32x4* dst = (u32x4*)(wt + (size_t)(n0 + n) * DM + g * 128 + F.wave * 16);
          dst[0] = (u32x4){pk2(acc[0], acc[1]), pk2(acc[2], acc[3]), pk2(acc[4], acc[5]), pk2(acc[6], acc[7])};
          dst[1] = (u32x4){pk2(acc[8], acc[9]), pk2(acc[10], acc[11]), pk2(acc[12], acc[13]), pk2(acc[14], acc[15])};
          __syncthreads(); } }
    const int gw = F.blk * NWAVES + F.wave, NGW = F.G * NWAVES;
    for (int rx12_ = 0; rx12_ < 1 + ((REPX >> 12) & 1); ++rx12_)
    { constexpr int I_IN = 8 * 9, I_SQ = 8 * 4, I_OUT = 4 * 4, I_UP = 8 * 16, I_DN = 32 * 4;
      constexpr int NITEMS = I_IN + 2 * I_SQ + I_OUT + 2 * I_SQ + I_UP + I_DN;
      LAS bf16* T = (LAS bf16*)F.lds;
      const bool deal = (F.G == 256);
      const int tfirst = deal ? (F.blk >= 64 ? F.blk - 64 : 384 + F.blk) : F.blk, tstride = deal ? 192 : F.G, tcount = deal ? (F.blk >= 88 ? 2 : F.blk >= 64 ? 3 : 1) : (NITEMS + F.G - 1) / F.G;
      for (int ti = 0; ti < tcount; ++ti) { const int it = (deal && ti == 2) ? 448 + (F.blk - 64) : tfirst + ti * tstride; if (it >= NITEMS) break;
        int r = it; const float* W; const float* gain = nullptr; bf16* WT; int ldw, nreal, ldt = DM, row_off = 0, nb = 4, kofs = 0;
        if (r < I_IN) { W = F.in[8]; ldw = INC; nreal = INC; WT = WSP(bf16, WS_WIN); gain = F.in[7]; nb = 9; }
        else if ((r -= I_IN) < I_SQ) { W = F.in[16]; ldw = DM; nreal = DM; WT = WSP(bf16, WS_WKV); gain = F.in[15]; }
        else if ((r -= I_SQ) < I_SQ) { W = F.in[17]; ldw = DM; nreal = DM; WT = WSP(bf16, WS_WKV); gain = F.in[15]; row_off = DM; }
        else if ((r -= I_SQ) < I_OUT) { W = F.in[14]; ldw = DM; nreal = DM; WT = WSP(bf16, WS_WOUT); kofs = 512; }
        else if ((r -= I_OUT) < I_SQ) { W = F.in[19]; ldw = DM; nreal = DM; WT = WSP(bf16, WS_WQM); gain = F.in[18]; }
        else if ((r -= I_SQ) < I_SQ) { W = F.in[20]; ldw = DM; nreal = DM; WT = WSP(bf16, WS_WOM); }
        else if ((r -= I_SQ) < I_UP) { W = F.in[22]; ldw = FF; nreal = FF; WT = WSP(bf16, WS_WUP); gain = F.in[21]; nb = 16; }
        else { r -= I_UP; W = F.in[23]; ldw = DM; nreal = DM; WT = WSP(bf16, WS_WDN); ldt = FF; }
        const int k0 = kofs + 128 * (r / nb), n0 = 256 * (r % nb);
        f32x4 tv[16];
#pragma unroll
        for (int i = 0; i < 16; ++i) { const int idx = i * 512 + tid, kk = idx >> 6, n = n0 + (idx & 63) * 4;
            tv[i] = (f32x4){0.f, 0.f, 0.f, 0.f}; if (n < nreal) tv[i] = __builtin_nontemporal_load((const f32x4*)(W + (size_t)(k0 + kk) * ldw + n)); }
#pragma unroll
        for (int i = 0; i < 16; ++i) { const int idx = i * 512 + tid, kk = idx >> 6; const float g = gain ? gain[k0 + kk] : 1.f; const f32x4 v = tv[i] * g;
            u32x2 o; o.x = pk2(v[0], v[1]); o.y = pk2(v[2], v[3]); *(LAS u32x2*)(T + kk * 256 + (idx & 63) * 4) = o; }
        __syncthreads();
        { const int n = tid & 255;
#pragma unroll
          for (int i = 0; i < 8; ++i) { const int kg = (tid >> 8) + 2 * i; const LAS bf16* tp = T + (kg * 8) * 256 + n;
              u32x4 o; o.x = tp[0] | ((unsigned)tp[256] << 16); o.y = tp[512] | ((unsigned)tp[768] << 16); o.z = tp[1024] | ((unsigned)tp[1280] << 16); o.w = tp[1536] | ((unsigned)tp[1792] << 16);
              *(u32x4*)(WT + (size_t)(row_off + n0 + n) * ldt + k0 + kg * 8) = o; } }
        __syncthreads();
      } }
    for (int rx11_ = 0; rx11_ < 1 + ((REPX >> 11) & 1); ++rx11_)
    for (int it = F.wave * F.G + F.blk; it < MP / 16 + (NB * 256) / 16; it += NGW) {
        if (it < MP / 16) rows16_pass(F.in[0], WSP(bf16, WS_H), WSP(float, WS_SSQ0), WSP(float, WS_FLOW), Wf, it * 16, lane);
        else rows16_pass(F.in[6], WSP(bf16, WS_MN), WSP(float, WS_SSQ0) + MP, nullptr, Wf, (it - MP / 16) * 16, lane); }
}

template <bool NORM, class Epi>
__device__ __forceinline__ void skinny_gemm(const Frame& F, const float* A, int lda, const bf16* Bt, int ldb, int K, int nslab, int ksplit, const Epi& E) {
    const int lane = pg8::pg8_lane_id(), tid = F.wave * 64 + lane; (void)tid;
    const int fr = lane & 15, fq = lane >> 4;
    for (int item = F.blk; item < nslab * ksplit; item += F.G) {
        const int slab = item % nslab, ks = item / nslab;
        const float* ap = A + (size_t)(F.wave * 16 + fr) * lda + (size_t)ks * K + fq * 8;
        const bf16* bp = Bt + (size_t)(slab * 16 + fr) * ldb + (size_t)ks * K + fq * 8;
        f32x4 acc = {0.f, 0.f, 0.f, 0.f}; float ss = 0.f;
#pragma unroll 1
        for (int k0 = 0; k0 < K; k0 += 256) {
            f32x4 a[16]; bf16x8 b[8];
#pragma unroll
            for (int u = 0; u < 8; ++u) { a[2 * u] = *(const f32x4*)(ap + k0 + u * 32); a[2 * u + 1] = *(const f32x4*)(ap + k0 + u * 32 + 4); b[u] = *(const bf16x8*)(bp + k0 + u * 32); }
#pragma unroll
            for (int u = 0; u < 8; ++u) { const f32x4 a0 = a[2 * u], a1 = a[2 * u + 1];
                if (NORM) ss += ((a0[0] * a0[0] + a0[1] * a0[1]) + (a0[2] * a0[2] + a0[3] * a0[3])) + ((a1[0] * a1[0] + a1[1] * a1[1]) + (a1[2] * a1[2] + a1[3] * a1[3]));
                u32x4 aw; aw.x = pk2(a0[0], a0[1]); aw.y = pk2(a0[2], a0[3]); aw.z = pk2(a1[0], a1[1]); aw.w = pk2(a1[2], a1[3]);
                acc = mfma16(b[u], __builtin_bit_cast(bf16x8, aw), acc); }
        }
        if (NORM) { ss += __shfl_xor(ss, 16); ss += __shfl_xor(ss, 32); acc = acc * rsqrtf(ss / (float)K + EPS); }
        E(F.wave * 16 + fr, slab * 16 + fq * 4, ks, acc);
    }
}
struct SEpiStore { float* O; int ldc; float scale; __device__ __forceinline__ void operator()(int row, int col, int, f32x4 v) const { *(f32x4*)(O + (size_t)row * ldc + col) = v * scale; } };
struct SEpiPart  { float* O; __device__ __forceinline__ void operator()(int row, int col, int ks, f32x4 v) const { *(f32x4*)(O + ((size_t)ks * MS + row) * DM + col) = v; } };
struct SEpiAtomic { float* O; float scale; __device__ __forceinline__ void operator()(int row, int col, int, f32x4 v) const { float* p = O + (size_t)row * DM + col;
#pragma unroll
    for (int e = 0; e < 4; ++e) atomicAdd(p + e, v[e] * scale); } };
struct SEpiRes   { const float* base; float* O; __device__ __forceinline__ void operator()(int row, int col, int, f32x4 v) const { const f32x4 b = *(const f32x4*)(base + (size_t)row * DM + col); *(f32x4*)(O + (size_t)row * DM + col) = b + v; } };
struct SEpiRelu2 { float* O; __device__ __forceinline__ void operator()(int row, int col, int, f32x4 v) const { f32x4 o;
#pragma unroll
    for (int e = 0; e < 4; ++e) { const float a = fmaxf(v[e], 0.f); o[e] = a * a; } *(f32x4*)(O + (size_t)row * FF + col) = o; } };
__device__ __forceinline__ void p2_pool_prompt(const Frame& F, int first, int stride) {
    const bf16* proj = WSP(const bf16, WS_PROJ); bf16* mixed = WSP(bf16, WS_H);
    const int lane = pg8::pg8_lane_id(), tid = F.wave * 64 + lane; (void)tid;
    const int c8 = lane * 8, g = lane >> 4, w = 2 << g;
    for (int it = first; it < MP / 64; it += stride) {
        const int row0 = it * 64 + F.wave * 8, t0 = row0 & (SEQ - 1), b = row0 >> 11;
        u32x4 rw[23];
#pragma unroll
        for (int i = 0; i < 23; ++i) { rw[i] = (u32x4){0u, 0u, 0u, 0u}; if (t0 + i - 15 >= 0) rw[i] = *(const u32x4*)(proj + (size_t)(row0 + i - 15) * INP + c8); }
        float cs[23][8];
#pragma unroll
        for (int i = 0; i < 23; ++i) { const float u[8] = {bflo(rw[i].x), bfhi(rw[i].x), bflo(rw[i].y), bfhi(rw[i].y), bflo(rw[i].z), bfhi(rw[i].z), bflo(rw[i].w), bfhi(rw[i].w)};
#pragma unroll
            for (int e2 = 0; e2 < 8; ++e2) cs[i][e2] = (i ? cs[i - 1][e2] : 0.f) + u[e2]; }
#pragma unroll
        for (int i = 0; i < 8; ++i) { const int t = t0 + i, cnt = (t + 1 < w) ? (t + 1) : w; const float inv = 1.f / (float)cnt; float o[8]; const u32x4 ur = rw[15 + i]; const float un[8] = {bflo(ur.x), bfhi(ur.x), bflo(ur.y), bfhi(ur.y), bflo(ur.z), bfhi(ur.z), bflo(ur.w), bfhi(ur.w)};
#pragma unroll
            for (int e2 = 0; e2 < 8; ++e2) { const float lo2 = cs[15 + i - 2][e2], lo4 = cs[15 + i - 4][e2], lo8 = cs[15 + i - 8][e2], lo16 = (i ? cs[i - 1][e2] : 0.f);
                const float lo = (g == 0) ? lo2 : (g == 1) ? lo4 : (g == 2) ? lo8 : lo16;
                o[e2] = (cs[15 + i][e2] - lo) * inv - un[e2]; }
            u32x4 ov; ov.x = pk2(o[0], o[1]); ov.y = pk2(o[2], o[3]); ov.z = pk2(o[4], o[5]); ov.w = pk2(o[6], o[7]);
            *(u32x4*)(mixed + (size_t)(row0 + i) * DM + c8) = ov;
            if (t >= SEQ - 15) { float* sp = F.out + O_SPP + ((size_t)b * 15 + (t - (SEQ - 15))) * 512 + c8; *(f32x4*)sp = (f32x4){un[0], un[1], un[2], un[3]}; *(f32x4*)(sp + 4) = (f32x4){un[4], un[5], un[6], un[7]}; } }
    }
}
__device__ __forceinline__ void p2_gla_local(const Frame& F) {
    const bf16* proj = WSP(const bf16, WS_PROJ); float* GL = WSP(float, WS_GL); float* CUM = WSP(float, WS_CUM);
    LAS float* fl = (LAS float*)(F.lds);
    LAS float* segt = (LAS float*)(F.lds + 4096);
    LAS bf16* Aop = (LAS bf16*)(F.lds + 8192);
    LAS bf16* Bop = (LAS bf16*)(F.lds + 8192 + 9216);
    const int lane = pg8::pg8_lane_id(), tid = F.wave * 64 + lane; const int wave = F.wave, fr = lane & 15, fq = lane >> 4;
    for (int unit = F.blk; unit < 1024; unit += F.G) {
        const int b = unit >> 7, n = (unit >> 2) & 31, h = unit & 3; const size_t r0 = (size_t)b * SEQ + n * 64;
        for (int e = tid; e < 1024; e += 512) fl[e] = WSP(const float, WS_FLOW)[r0 * 16 + e];
        const int d = tid & 63, seg = tid >> 6;
        float wf[16];
#pragma unroll
        for (int r = 0; r < 16; ++r) wf[r] = F.in[9][r * 256 + h * 64 + d];
        const float bias = F.in[10][h * 64 + d];
        unsigned short kr[8], vv[16];
#pragma unroll
        for (int i = 0; i < 8; ++i) kr[i] = proj[(r0 + seg * 8 + i) * INP + C_K + h * 64 + d];
        { const int dv = tid & 127, ts = tid >> 7;
#pragma unroll
          for (int i = 0; i < 16; ++i) vv[i] = proj[(r0 + ts * 16 + i) * INP + C_V + h * 128 + dv]; }
        __syncthreads();
        float cum[8]; float run = 0.f;
#pragma unroll
        for (int i = 0; i < 8; ++i) { const int t = seg * 8 + i; float pre = bias;
#pragma unroll
            for (int r = 0; r < 16; ++r) pre += fl[t * 16 + r] * wf[r];
            run += logsig(pre) * (1.f / 16.f); cum[i] = run; }
        segt[seg * 64 + d] = run;
        __syncthreads();
        float pre_s = 0.f, tot = 0.f;
#pragma unroll
        for (int s2 = 0; s2 < 8; ++s2) { const float v = segt[s2 * 64 + d]; tot += v; if (s2 < seg) pre_s += v; }
        float ke[8];
#pragma unroll
        for (int i = 0; i < 8; ++i) { const int t = seg * 8 + i; cum[i] += pre_s; CUM[(size_t)unit * 4096 + t * 64 + d] = cum[i];
            ke[i] = bf2f(kr[i]) * __expf(tot - cum[i]); }
        { u32x4 o; o.x = pk2(ke[0], ke[1]); o.y = pk2(ke[2], ke[3]); o.z = pk2(ke[4], ke[5]); o.w = pk2(ke[6], ke[7]); *(LAS u32x4*)(Aop + d * 72 + seg * 8) = o; }
        { const int dv = tid & 127, ts = tid >> 7;
          u32x4 o0, o1; o0.x = vv[0] | ((unsigned)vv[1] << 16); o0.y = vv[2] | ((unsigned)vv[3] << 16); o0.z = vv[4] | ((unsigned)vv[5] << 16); o0.w = vv[6] | ((unsigned)vv[7] << 16);
          o1.x = vv[8] | ((unsigned)vv[9] << 16); o1.y = vv[10] | ((unsigned)vv[11] << 16); o1.z = vv[12] | ((unsigned)vv[13] << 16); o1.w = vv[14] | ((unsigned)vv[15] << 16);
          *(LAS u32x4*)(Bop + dv * 72 + ts * 16) = o0; *(LAS u32x4*)(Bop + dv * 72 + ts * 16 + 8) = o1; }
        __syncthreads();
        const int mi = wave & 3;
#pragma unroll
        for (int jj = 0; jj < 4; ++jj) { const int nj = (wave >> 2) * 4 + jj; f32x4 acc = {0.f, 0.f, 0.f, 0.f};
#pragma unroll
            for (int ks = 0; ks < 2; ++ks) { const bf16x8 a = *(const LAS bf16x8*)(Aop + (mi * 16 + fr) * 72 + ks * 32 + fq * 8); const bf16x8 bb = *(const LAS bf16x8*)(Bop + (nj * 16 + fr) * 72 + ks * 32 + fq * 8);
                acc = mfma16(bb, a, acc); }
            *(f32x4*)(GL + (size_t)unit * 8192 + (mi * 16 + fr) * 128 + nj * 16 + fq * 4) = acc; }
        __syncthreads();
    }
}
__device__ __forceinline__ void p3_gla_scan(const Frame& F) {
    const float* GL = WSP(const float, WS_GL); const float* CUM = WSP(const float, WS_CUM); bf16* ST = WSP(bf16, WS_ST);
    const int lane = pg8::pg8_lane_id(), tid = F.wave * 64 + lane; (void)tid;
    for (int e = F.blk * 512 + tid; e < 65536; e += F.G * 512) {
        const int dv = e & 127, dg = (e >> 7) & 15, bh = e >> 11, b = bh >> 2, h = bh & 3;
        float S[4] = {0.f, 0.f, 0.f, 0.f};
#pragma unroll 8
        for (int n = 0; n < 32; ++n) { const size_t unit = (size_t)(b * 32 + n) * 4 + h;
            const f32x4 cl = *(const f32x4*)(CUM + unit * 4096 + 63 * 64 + dg * 4);
            float Lv[4];
#pragma unroll
            for (int i = 0; i < 4; ++i) Lv[i] = __builtin_nontemporal_load(GL + unit * 8192 + (dg * 4 + i) * 128 + dv);
            u32x2 o; o.x = pk2(S[0], S[1]); o.y = pk2(S[2], S[3]); *(u32x2*)(ST + unit * 8192 + dv * 64 + dg * 4) = o;
#pragma unroll
            for (int i = 0; i < 4; ++i) S[i] = __expf(cl[i]) * S[i] + Lv[i]; }
#pragma unroll
        for (int i = 0; i < 4; ++i) F.out[O_SGP + ((size_t)(b * 4 + h) * 64 + dg * 4 + i) * 128 + dv] = S[i];
    }
}
__device__ __forceinline__ void p4_gla_out(const Frame& F, int nskip) {
    const bf16* proj = WSP(const bf16, WS_PROJ); const float* CUM = WSP(const float, WS_CUM); const bf16* ST = WSP(const bf16, WS_ST); bf16* mixed = WSP(bf16, WS_H);
    LAS bf16* Aq = (LAS bf16*)(F.lds);
    LAS bf16* Bk = (LAS bf16*)(F.lds + 9216);
    LAS bf16* Bv = (LAS bf16*)(F.lds + 18432);
    LAS bf16* Bs = (LAS bf16*)(F.lds + 36864);
    LAS bf16* Ap = (LAS bf16*)(F.lds + 55296);
    LAS float* red = (LAS float*)(F.lds + 64512);
    const int lane = pg8::pg8_lane_id(), tid = F.wave * 64 + lane; const int wave = F.wave, fr = lane & 15, fq = lane >> 4;
    int first, stride, count;
    if (nskip > 0 && F.G > nskip && 3 * nskip <= 1024) { const int rest = 1024 - 3 * nskip, others = F.G - nskip;
        if (F.blk < nskip) { first = F.blk; stride = nskip; count = 3; }
        else { first = 3 * nskip + (F.blk - nskip); stride = others; count = (rest - (F.blk - nskip) + others - 1) / others; } }
    else { first = F.blk; stride = F.G; count = (1024 - F.blk + F.G - 1) / F.G; }
    if (count <= 0) return;
    const int mi = wave & 3, t = tid >> 3, d8 = (tid & 7) * 8, dvl = tid & 127, ts = tid >> 7;
    f32x4 c0, c1; u32x4 qw, kw, st0, st1; unsigned short vv[16]; u32x2 gwv[4]; f32x4 gnv[4];
#define G3_LOAD(unit_) do { const int u_ = (unit_); const int b_ = u_ >> 7, n_ = (u_ >> 2) & 31, h_ = u_ & 3; const size_t r0_ = (size_t)b_ * SEQ + n_ * 64; \
        c0 = *(const f32x4*)(CUM + (size_t)u_ * 4096 + t * 64 + d8); c1 = *(const f32x4*)(CUM + (size_t)u_ * 4096 + t * 64 + d8 + 4); \
        qw = *(const u32x4*)(proj + (r0_ + t) * INP + C_Q + h_ * 64 + d8); kw = *(const u32x4*)(proj + (r0_ + t) * INP + C_K + h_ * 64 + d8); \
        _Pragma("unroll") for (int i = 0; i < 16; ++i) vv[i] = proj[(r0_ + ts * 16 + i) * INP + C_V + h_ * 128 + dvl]; \
        st0 = *(const u32x4*)(ST + (size_t)u_ * 8192 + (tid >> 3) * 64 + (tid & 7) * 8); st1 = *(const u32x4*)(ST + (size_t)u_ * 8192 + ((tid + 512) >> 3) * 64 + (tid & 7) * 8); \
        _Pragma("unroll") for (int jj = 0; jj < 4; ++jj) { const int dv0 = ((wave >> 2) * 4 + jj) * 16 + fq * 4; gnv[jj] = *(const f32x4*)(F.in[13] + h_ * 128 + dv0); gwv[jj] = *(const u32x2*)(proj + (r0_ + mi * 16 + fr) * INP + C_G + h_ * 128 + dv0); } } while (0)
    int unit = first; G3_LOAD(unit);
    for (int it = 0; it < count; ++it) {
        const int b = unit >> 7, n = (unit >> 2) & 31, h = unit & 3; const size_t r0 = (size_t)b * SEQ + n * 64;
        { float cu[8] = {c0[0], c0[1], c0[2], c0[3], c1[0], c1[1], c1[2], c1[3]};
          float qv[8] = {bflo(qw.x), bfhi(qw.x), bflo(qw.y), bfhi(qw.y), bflo(qw.z), bfhi(qw.z), bflo(qw.w), bfhi(qw.w)};
          float kv[8] = {bflo(kw.x), bfhi(kw.x), bflo(kw.y), bfhi(kw.y), bflo(kw.z), bfhi(kw.z), bflo(kw.w), bfhi(kw.w)};
#pragma unroll
          for (int e2 = 0; e2 < 8; ++e2) { const float ex = __expf(cu[e2]); qv[e2] = qv[e2] * 0.125f * ex; kv[e2] = kv[e2] / ex; }
          u32x4 o; o.x = pk2(qv[0], qv[1]); o.y = pk2(qv[2], qv[3]); o.z = pk2(qv[4], qv[5]); o.w = pk2(qv[6], qv[7]); *(LAS u32x4*)(Aq + t * 72 + d8) = o;
          o.x = pk2(kv[0], kv[1]); o.y = pk2(kv[2], kv[3]); o.z = pk2(kv[4], kv[5]); o.w = pk2(kv[6], kv[7]); *(LAS u32x4*)(Bk + t * 72 + d8) = o; }
        { u32x4 o0, o1; o0.x = vv[0] | ((unsigned)vv[1] << 16); o0.y = vv[2] | ((unsigned)vv[3] << 16); o0.z = vv[4] | ((unsigned)vv[5] << 16); o0.w = vv[6] | ((unsigned)vv[7] << 16);
          o1.x = vv[8] | ((unsigned)vv[9] << 16); o1.y = vv[10] | ((unsigned)vv[11] << 16); o1.z = vv[12] | ((unsigned)vv[13] << 16); o1.w = vv[14] | ((unsigned)vv[15] << 16);
          *(LAS u32x4*)(Bv + dvl * 72 + ts * 16) = o0; *(LAS u32x4*)(Bv + dvl * 72 + ts * 16 + 8) = o1; }
        *(LAS u32x4*)(Bs + (tid >> 3) * 72 + (tid & 7) * 8) = st0; *(LAS u32x4*)(Bs + ((tid + 512) >> 3) * 72 + (tid & 7) * 8) = st1;
        u32x2 gwc[4]; f32x4 gnc[4];
#pragma unroll
        for (int jj = 0; jj < 4; ++jj) { gwc[jj] = gwv[jj]; gnc[jj] = gnv[jj]; }
        const int nextu = unit + stride;
        if (it + 1 < count) G3_LOAD(nextu);
        __syncthreads();
#pragma unroll
        for (int jj = 0; jj < 2; ++jj) { const int nj = (wave >> 2) * 2 + jj; f32x4 acc = {0.f, 0.f, 0.f, 0.f};
#pragma unroll
            for (int ks = 0; ks < 2; ++ks) { const bf16x8 a = *(const LAS bf16x8*)(Aq + (mi * 16 + fr) * 72 + ks * 32 + fq * 8); const bf16x8 bb = *(const LAS bf16x8*)(Bk + (nj * 16 + fr) * 72 + ks * 32 + fq * 8);
                acc = mfma16(bb, a, acc); }
            const int i = mi * 16 + fr, j0 = nj * 16 + fq * 4;
#pragma unroll
            for (int r = 0; r < 4; ++r) if (j0 + r > i) acc[r] = 0.f;
            u32x2 o; o.x = pk2(acc[0], acc[1]); o.y = pk2(acc[2], acc[3]); *(LAS u32x2*)(Ap + i * 72 + j0) = o; }
        __syncthreads();
        f32x4 oacc[4]; float ssq = 0.f;
#pragma unroll
        for (int jj = 0; jj < 4; ++jj) { const int nj = (wave >> 2) * 4 + jj; f32x4 acc = {0.f, 0.f, 0.f, 0.f};
#pragma unroll
            for (int ks = 0; ks < 2; ++ks) {
                const bf16x8 ap = *(const LAS bf16x8*)(Ap + (mi * 16 + fr) * 72 + ks * 32 + fq * 8), bv = *(const LAS bf16x8*)(Bv + (nj * 16 + fr) * 72 + ks * 32 + fq * 8);
                acc = mfma16(bv, ap, acc);
                const bf16x8 aq = *(const LAS bf16x8*)(Aq + (mi * 16 + fr) * 72 + ks * 32 + fq * 8), bs = *(const LAS bf16x8*)(Bs + (nj * 16 + fr) * 72 + ks * 32 + fq * 8);
                acc = mfma16(bs, aq, acc); }
            oacc[jj] = acc; ssq += (acc[0] * acc[0] + acc[1] * acc[1]) + (acc[2] * acc[2] + acc[3] * acc[3]); }
        ssq += __shfl_xor(ssq, 16); ssq += __shfl_xor(ssq, 32);
        if (fq == 0) red[(wave >> 2) * 64 + mi * 16 + fr] = ssq;
        __syncthreads();
        const float rstd = rsqrtf((red[mi * 16 + fr] + red[64 + mi * 16 + fr]) * (1.f / 128.f) + EPS);
        const size_t row = r0 + mi * 16 + fr;
#pragma unroll
        for (int jj = 0; jj < 4; ++jj) { const int dv0 = ((wave >> 2) * 4 + jj) * 16 + fq * 4;
            const f32x4 gn = gnc[jj]; const u32x2 gw = gwc[jj];
            const float g0 = silu(bflo(gw.x)), g1 = silu(bfhi(gw.x)), g2 = silu(bflo(gw.y)), g3 = silu(bfhi(gw.y));
            u32x2 o; o.x = pk2(oacc[jj][0] * rstd * gn[0] * g0, oacc[jj][1] * rstd * gn[1] * g1); o.y = pk2(oacc[jj][2] * rstd * gn[2] * g2, oacc[jj][3] * rstd * gn[3] * g3);
            *(u32x2*)(mixed + row * DM + 512 + h * 128 + dv0) = o; }
        __syncthreads();
        unit = nextu;
    }
#undef G3_LOAD
}

__device__ __forceinline__ void s_mixers(const Frame& F) {
    const float* projs = WSP(const float, WS_PROJS); float* mixs = WSP(float, WS_MIXS);
    const float* spool = F.in[2]; const float* sgla = F.in[3];
    const int lane = pg8::pg8_lane_id(), tid = F.wave * 64 + lane; (void)tid;
    for (int e = F.blk * 512 + tid; e < MS * 512; e += F.G * 512) { const int b = e >> 9, c = e & 511, g = c >> 7, w = 2 << g;
        const float u = projs[(size_t)b * INC + c]; float s = u;
        for (int j = 1; j < w; ++j) s += spool[((size_t)b * 15 + 15 - j) * 512 + c];
        mixs[(size_t)b * DM + c] = s / (float)w - u;
        float* so = F.out + O_SPS + (size_t)b * 15 * 512 + c;
#pragma unroll
        for (int i = 0; i < 14; ++i) so[(size_t)i * 512] = spool[((size_t)b * 15 + i + 1) * 512 + c];
        so[(size_t)14 * 512] = u; }
    LAS float* dec = (LAS float*)(F.lds); LAS float* qs = dec + 64; LAS float* ks = dec + 128; LAS float* vs = dec + 192;
    LAS float* red = dec + 320;
    LAS float* red2 = red + 2048;
    for (int it = F.blk; it < MS * 4; it += F.G) { const int b = it >> 2, h = it & 3; const float* pr = projs + (size_t)b * INC;
        if (tid < 64) { float pre = F.in[10][h * 64 + tid];
#pragma unroll
            for (int r = 0; r < 16; ++r) pre += pr[C_F + r] * F.in[9][r * 256 + h * 64 + tid];
            dec[tid] = __expf(logsig(pre) * (1.f / 16.f)); qs[tid] = pr[C_Q + h * 64 + tid] * 0.125f; ks[tid] = pr[C_K + h * 64 + tid]; }
        else if (tid < 192) vs[tid - 64] = pr[C_V + h * 128 + (tid - 64)];
        __syncthreads();
        { const int v4 = (tid & 31) * 4, dgp = tid >> 5; const f32x4 vv = *(const LAS f32x4*)(vs + v4); f32x4 po = {0.f, 0.f, 0.f, 0.f};
#pragma unroll
          for (int i = 0; i < 4; ++i) { const int d = dgp * 4 + i; const size_t off = ((size_t)(b * 4 + h) * 64 + d) * 128 + v4;
              const f32x4 s0 = __builtin_nontemporal_load((const f32x4*)(sgla + off)); const f32x4 sn = s0 * dec[d] + vv * ks[d]; __builtin_nontemporal_store(sn, (f32x4*)(F.out + O_SGS + off)); po += sn * qs[d]; }
          *(LAS f32x4*)(red + dgp * 128 + v4) = po; }
        __syncthreads();
        float o = 0.f;
        if (tid < 128) {
#pragma unroll
            for (int g = 0; g < 16; ++g) o += red[g * 128 + tid];
            const float s2 = wave_sum(o * o); if (lane == 0) red2[tid >> 6] = s2; }
        __syncthreads();
        if (tid < 128) { const float rstd = rsqrtf((red2[0] + red2[1]) * (1.f / 128.f) + EPS);
            mixs[(size_t)b * DM + 512 + h * 128 + tid] = o * rstd * F.in[13][h * 128 + tid] * silu(pr[C_G + h * 128 + tid]); }
        __syncthreads();
    }
}
constexpr int KST = 264;
__device__ __forceinline__ void p7_attn_prompt(const Frame& F) {
    const bf16* Q = WSP(const bf16, WS_Q); const bf16* KB = WSP(const bf16, WS_KB); const bf16* VT = WSP(const bf16, WS_VT); bf16* CTX = WSP(bf16, WS_CTX);
    LAS bf16* L = (LAS bf16*)F.lds;
    const int lane = pg8::pg8_lane_id(), tid = F.wave * 64 + lane; const int wave = F.wave, fr = lane & 15, fq = lane >> 4;
    for (int unit = F.blk; unit < 256; unit += F.G) {
        const int b = unit >> 5, h = (unit >> 3) & 3, qt = unit & 7; const size_t row0 = (size_t)b * SEQ + qt * 256 + wave * 32;
        const bf16* kg = KB + (size_t)(b * 4 + h) * 65536; const bf16* vg = VT + (size_t)(b * 4 + h) * 65536;
        bf16x8 qf[2][8];
#pragma unroll
        for (int mi = 0; mi < 2; ++mi)
#pragma unroll
            for (int ks = 0; ks < 8; ++ks) qf[mi][ks] = *(const bf16x8*)(Q + (row0 + mi * 16 + fr) * DM + h * 256 + ks * 32 + fq * 8);
#pragma unroll 1
        for (int i0 = 0; i0 < 16; i0 += 8) { u32x4 t[8];
#pragma unroll
          for (int i = 0; i < 8; ++i) { const int p = tid + (i0 + i) * 512; t[i] = *(const u32x4*)(kg + (p >> 5) * 256 + (p & 31) * 8); }
#pragma unroll
          for (int i = 0; i < 8; ++i) { const int p = tid + (i0 + i) * 512; *(LAS u32x4*)(L + (p >> 5) * KST + (p & 31) * 8) = t[i]; } }
        __syncthreads();
        f32x4 sacc[2][16];
        unsigned koff = (unsigned)(fr * KST + fq * 8) * 2u;
#pragma unroll
        for (int nj = 0; nj < 16; ++nj) { sacc[0][nj] = (f32x4){0.f, 0.f, 0.f, 0.f}; sacc[1][nj] = (f32x4){0.f, 0.f, 0.f, 0.f};
            const LAS unsigned char* kp = F.lds + koff; koff += 16u * KST * 2u; asm volatile("" : "+v"(koff));
            bf16x8 kf[8];
#pragma unroll
            for (int ks = 0; ks < 8; ++ks) kf[ks] = *(const LAS bf16x8*)(kp + ks * 64);
            __builtin_amdgcn_sched_barrier(0);
#pragma unroll
            for (int ks = 0; ks < 8; ++ks) { sacc[0][nj] = mfma16(kf[ks], qf[0][ks], sacc[0][nj]); sacc[1][nj] = mfma16(kf[ks], qf[1][ks], sacc[1][nj]); }
            __builtin_amdgcn_sched_barrier(0); }
        float inv[2]; bf16x8 pf[2][8];
#pragma unroll
        for (int mi = 0; mi < 2; ++mi) { float mx = -3.0e38f;
#pragma unroll
            for (int nj = 0; nj < 16; ++nj) mx = fmaxf(mx, fmaxf(fmaxf(sacc[mi][nj][0], sacc[mi][nj][1]), fmaxf(sacc[mi][nj][2], sacc[mi][nj][3])));
            mx = fmaxf(mx, __shfl_xor(mx, 16)); mx = fmaxf(mx, __shfl_xor(mx, 32));
            float sm = 0.f;
#pragma unroll
            for (int s = 0; s < 8; ++s) { float e[8];
#pragma unroll
                for (int r = 0; r < 4; ++r) { e[r] = __expf(sacc[mi][2 * s][r] - mx); e[4 + r] = __expf(sacc[mi][2 * s + 1][r] - mx); }
                sm += ((e[0] + e[1]) + (e[2] + e[3])) + ((e[4] + e[5]) + (e[6] + e[7]));
                u32x4 w; w.x = pk2(e[0], e[1]); w.y = pk2(e[2], e[3]); w.z = pk2(e[4], e[5]); w.w = pk2(e[6], e[7]); pf[mi][s] = __builtin_bit_cast(bf16x8, w); }
            sm += __shfl_xor(sm, 16); sm += __shfl_xor(sm, 32); inv[mi] = 1.f / sm; }
        __syncthreads();
#pragma unroll 1
        for (int i0 = 0; i0 < 16; i0 += 8) { u32x4 t[8];
#pragma unroll
          for (int i = 0; i < 8; ++i) { const int p = tid + (i0 + i) * 512; t[i] = *(const u32x4*)(vg + (p >> 5) * 256 + (p & 31) * 8); }
#pragma unroll
          for (int i = 0; i < 8; ++i) { const int p = tid + (i0 + i) * 512; *(LAS u32x4*)(L + (p >> 5) * KST + (p & 31) * 8) = t[i]; } }
        __syncthreads();
        unsigned voff = (unsigned)(fr * KST + fq * 8) * 2u;
        bf16* cp = CTX + (row0 + fr) * DM + h * 256 + fq * 4;
#pragma unroll
        for (int nj = 0; nj < 16; ++nj) { f32x4 o0 = {0.f, 0.f, 0.f, 0.f}, o1 = {0.f, 0.f, 0.f, 0.f};
            const LAS unsigned char* vp = F.lds + voff; voff += 16u * KST * 2u; asm volatile("" : "+v"(voff));
            bf16x8 vf[8];
#pragma unroll
            for (int s = 0; s < 8; ++s) vf[s] = *(const LAS bf16x8*)(vp + s * 64);
            __builtin_amdgcn_sched_barrier(0);
#pragma unroll
            for (int s = 0; s < 8; ++s) { o0 = mfma16(vf[s], pf[0][s], o0); o1 = mfma16(vf[s], pf[1][s], o1); }
            __builtin_amdgcn_sched_barrier(0);
            u32x2 w0; w0.x = pk2(o0[0] * inv[0], o0[1] * inv[0]); w0.y = pk2(o0[2] * inv[0], o0[3] * inv[0]); *(u32x2*)(cp + nj * 16) = w0;
            u32x2 w1; w1.x = pk2(o1[0] * inv[1], o1[1] * inv[1]); w1.y = pk2(o1[2] * inv[1], o1[3] * inv[1]); *(u32x2*)(cp + 16 * DM + nj * 16) = w1; }
        __syncthreads();
    }
}
__device__ __forceinline__ void s_attn(const Frame& F) {
    const float* qsb = WSP(const float, WS_QS); float* ctxs = WSP(float, WS_CTXS); const float* ck = F.in[4]; const float* cv = F.in[5];
    LAS float* part = (LAS float*)F.lds; LAS float* ml = part + 8 * 256;
    const int lane = pg8::pg8_lane_id(), tid = F.wave * 64 + lane; const int wave = F.wave;
    for (int it = F.blk; it < MS * 4; it += F.G) { const int b = it >> 2, h = it & 3;
        const f32x4 q4 = *(const f32x4*)(qsb + (size_t)b * DM + h * 256 + lane * 4);
        const float* kb = ck + ((size_t)b * 256 * 4 + h) * 256 + lane * 4 + (size_t)(wave * 32) * 1024;
        const float* vb = cv + ((size_t)b * 256 * 4 + h) * 256 + lane * 4 + (size_t)(wave * 32) * 1024;
        float mrun = -3.0e38f, l = 0.f; f32x4 acc = {0.f, 0.f, 0.f, 0.f};
#pragma unroll 1
        for (int i0 = 0; i0 < 32; i0 += 8) { f32x4 k4[8], v4[8]; float sc[8];
#pragma unroll
            for (int u = 0; u < 8; ++u) { k4[u] = __builtin_nontemporal_load((const f32x4*)(kb + (size_t)(i0 + u) * 1024)); v4[u] = __builtin_nontemporal_load((const f32x4*)(vb + (size_t)(i0 + u) * 1024)); }
            float mx = mrun;
#pragma unroll
            for (int u = 0; u < 8; ++u) { sc[u] = wave_sum((k4[u][0] * q4[0] + k4[u][1] * q4[1]) + (k4[u][2] * q4[2] + k4[u][3] * q4[3])); mx = fmaxf(mx, sc[u]); }
            const float rescale = __expf(mrun - mx); l *= rescale; acc = acc * rescale; mrun = mx;
#pragma unroll
            for (int u = 0; u < 8; ++u) { const float p = __expf(sc[u] - mx); l += p; acc += v4[u] * p; } }
        *(LAS f32x4*)(part + wave * 256 + lane * 4) = acc; if (lane == 0) { ml[wave * 2] = mrun; ml[wave * 2 + 1] = l; }
        __syncthreads();
        if (tid < 256) { float M = -3.0e38f;
#pragma unroll
            for (int w = 0; w < 8; ++w) M = fmaxf(M, ml[w * 2]);
            float o = 0.f, L = 0.f;
#pragma unroll
            for (int w = 0; w < 8; ++w) { const float e = __expf(ml[w * 2] - M); L += e * ml[w * 2 + 1]; o += e * part[w * 256 + tid]; }
            ctxs[(size_t)b * DM + h * 256 + tid] = o / L; }
        __syncthreads();
    }
}
__device__ __forceinline__ void final_norm_prompt(const Frame& F) {
    const int lane = pg8::pg8_lane_id(), tid = F.wave * 64 + lane; (void)tid;
    const int gw = F.blk * NWAVES + F.wave, NGW = F.G * NWAVES; const f32x4* g4 = (const f32x4*)F.in[24] + lane;
    for (int m = gw; m < MP; m += NGW) { f32x4* xr = (f32x4*)(F.out + O_YP + (size_t)m * DM) + lane; f32x4 v[4]; float s = 0.f;
#pragma unroll
        for (int j = 0; j < 4; ++j) { v[j] = xr[64 * j]; s += (v[j].x * v[j].x + v[j].y * v[j].y) + (v[j].z * v[j].z + v[j].w * v[j].w); }
        const float rstd = rsqrtf(wave_sum(s) * (1.f / DM) + EPS);
#pragma unroll
        for (int j = 0; j < 4; ++j) xr[64 * j] = v[j] * rstd * g4[64 * j]; }
}
__device__ __forceinline__ void final_norm_sample(const Frame& F) {
    const int lane = pg8::pg8_lane_id(), tid = F.wave * 64 + lane; (void)tid;
    const int gw = F.blk * NWAVES + F.wave, NGW = F.G * NWAVES; const f32x4* g4 = (const f32x4*)F.in[24] + lane; const float* parts = WSP(const float, WS_PARTS);
    for (int m = gw; m < MS; m += NGW) { f32x4* xr = (f32x4*)(F.out + O_YS + (size_t)m * DM) + lane; f32x4 v[4]; float s = 0.f;
#pragma unroll
        for (int j = 0; j < 4; ++j) { v[j] = xr[64 * j];
#pragma unroll
            for (int ks = 0; ks < 4; ++ks) v[j] += ((const f32x4*)(parts + ((size_t)ks * MS + m) * DM) + lane)[64 * j];
            s += (v[j].x * v[j].x + v[j].y * v[j].y) + (v[j].z * v[j].z + v[j].w * v[j].w); }
        const float rstd = rsqrtf(wave_sum(s) * (1.f / DM) + EPS);
#pragma unroll
        for (int j = 0; j < 4; ++j) xr[64 * j] = v[j] * rstd * g4[64 * j]; }
}
#define RLX_AGENT __ATOMIC_RELAXED, __HIP_MEMORY_SCOPE_AGENT
#define XB_TMO      128
#define XB_XCNT(j)  (256  + 64 * (j))
#define XB_XSUB(j)  (1280 + 64 * (j))
#define XB_XGEN(j)  (2304 + 64 * (j))
#define XB_TOP      3328
#define XB_TOPGEN   3392
#define XCD_BAR_WORDS 3456
#define XB_SPIN_CAP (1u << 18)

__device__ __forceinline__ unsigned xb_ld(unsigned* p)              { return __hip_atomic_load(p, __ATOMIC_RELAXED, __HIP_MEMORY_SCOPE_AGENT); }
__device__ __forceinline__ unsigned xb_add(unsigned* p, unsigned v) { return __hip_atomic_fetch_add(p, v, __ATOMIC_RELAXED, __HIP_MEMORY_SCOPE_AGENT); }
__device__ __forceinline__ unsigned xb_xcc_id() { return (unsigned)__builtin_amdgcn_s_getreg((3 << 11) | 20) & 0xFu; }
#define XB_SPIN(cond, bar) do { unsigned _sp = 0; while (cond) { __builtin_amdgcn_s_sleep(1); \
    if ((++_sp & 255u) == 0u) { if (xb_ld(&(bar)[XB_TMO])) break; if (_sp > XB_SPIN_CAP) { atomicAdd(&(bar)[XB_TMO], 1u); break; } } } } while (0)

struct XcdBarrier {
    unsigned* bar; unsigned x;
    volatile LAS unsigned* st;
};

__device__ __forceinline__ XcdBarrier xcd_barrier_post(unsigned* bar, volatile LAS unsigned* st, bool t0) {
    XcdBarrier b; b.bar = bar; b.x = xb_xcc_id(); b.st = st;
    if (t0) (void)xb_add(&bar[XB_XCNT(b.x)], 1u);
    return b;
}
__device__ __forceinline__ void xcd_barrier_complete(unsigned* bar, unsigned x, unsigned& nloc, unsigned& nx) {
    const unsigned G = gridDim.x * gridDim.y * gridDim.z;
    unsigned sum, cnt, mine, sp = 0u;
    for (;;) {
        sum = 0u; cnt = 0u; mine = 0u;
#pragma unroll
        for (unsigned j = 0; j < 16; ++j) { const unsigned c = xb_ld(&bar[XB_XCNT(j)]); sum += c; cnt += (c > 0u) ? 1u : 0u; mine = (j == x) ? c : mine; }
        if (sum == G) break;
        __builtin_amdgcn_s_sleep(1);
        if ((++sp & 255u) == 0u) { if (xb_ld(&bar[XB_TMO])) break; if (sp > XB_SPIN_CAP) { atomicAdd(&bar[XB_TMO], 1u); break; } }
    }
    nloc = mine > 0u ? mine : 1u; nx = cnt > 0u ? cnt : 1u;
}

__device__ __forceinline__ void xcd_barrier(const XcdBarrier& b, int wave) {
    asm volatile("s_waitcnt vmcnt(0)" ::: "memory");
    __syncthreads();
    if (wave == 0 && pg8::pg8_lane_id() == 0) {
        unsigned* bar = b.bar;
        __builtin_amdgcn_s_waitcnt(0);
        unsigned nloc = b.st[0], nx = b.st[1];
        if (nloc == 0u) { xcd_barrier_complete(bar, b.x, nloc, nx); b.st[0] = nloc; b.st[1] = nx; }
        const unsigned old = xb_add(&bar[XB_XSUB(b.x)], 1u);
        const unsigned gen = old / nloc;
        if (old + 1u == (gen + 1u) * nloc) {
            __builtin_amdgcn_fence(__ATOMIC_RELEASE, "agent");
            asm volatile("s_waitcnt vmcnt(0)" ::: "memory");
            const unsigned og = xb_add(&bar[XB_TOP], 1u);
            const unsigned tg = og / nx;
            if (og + 1u == (tg + 1u) * nx) xb_add(&bar[XB_TOPGEN], 1u);
            else XB_SPIN(xb_ld(&bar[XB_TOPGEN]) == tg, bar);
            __builtin_amdgcn_fence(__ATOMIC_ACQUIRE, "agent");
            xb_add(&bar[XB_XGEN(b.x)], 1u);
            asm volatile("s_waitcnt vmcnt(0)" ::: "memory");
        } else {
            XB_SPIN(xb_ld(&bar[XB_XGEN(b.x)]) == gen, bar);
            __builtin_amdgcn_fence(__ATOMIC_ACQUIRE, "agent");
            asm volatile("s_waitcnt vmcnt(0)" ::: "memory");
        }
    }
    __syncthreads();
}
#ifndef MK_N_LAUNCHES
#define MK_N_LAUNCHES 1
#endif
constexpr int N_PHASES = 12;
#ifndef REPX
#define REPX 0
#endif
#define AMP_WAIT() do { __syncthreads(); const unsigned long long t1_ = __builtin_amdgcn_s_memrealtime(); while (__builtin_amdgcn_s_memrealtime() < t1_ + (t1_ - t0_)) __builtin_amdgcn_s_sleep(8); __syncthreads(); } while (0)
#define RX(bit) for (int rx_ = 0; rx_ < 1 + ((REPX >> (bit)) & 1); ++rx_)
struct Args { const float* in[25]; float* out; unsigned char* ws; int ph_lo, ph_hi; };
struct RotOrder {
    pg8::StaticOrder S;
    __device__ void init(int M, int N, int G, int c, int rot) { S.init(M, N, G, (c + G - (rot % G)) % G); }
    __device__ bool next(int i, pg8::Unit& u) const { return S.next(i, u); }
    __device__ __forceinline__ void a_ready(const pg8::Unit&) const {}
    __device__ __forceinline__ void done(const pg8::Unit&) const {}
};
__global__ void __launch_bounds__(NWAVES * 64, 2) mk_fwd(Args args) {
    extern __shared__ __attribute__((aligned(16))) unsigned char lds_raw[];
    Frame F;
    F.lds = (LAS unsigned char*)lds_raw;
    F.wave = __builtin_amdgcn_readfirstlane((int)threadIdx.x >> 6);
    F.G = gridDim.x; F.blk = blockIdx.x;
#pragma unroll
    for (int i = 0; i < 25; ++i) F.in[i] = args.in[i];
    F.out = args.out; F.ws = args.ws;
    const int lo = args.ph_lo, hi = args.ph_hi;
#define IN(k) (lo <= (k) && (k) < hi)
    volatile LAS unsigned* bst = (volatile LAS unsigned*)(F.lds + 143360);
    { const int l0 = pg8::pg8_lane_id(); if (F.wave == 0 && l0 < 2) bst[l0] = 0u; }
    __syncthreads();
    XcdBarrier bar = xcd_barrier_post((unsigned*)args.ws, bst, F.wave == 0 && pg8::pg8_lane_id() == 0);
    if (lo < 0) cg::this_grid().sync();
#define GRID_BAR() xcd_barrier(bar, F.wave)
#define SEAM(k) do { if (IN(k) && IN((k) + 1)) GRID_BAR(); } while (0)
    typedef pg8::bf16_t pb;
    if (IN(0)) { constexpr int rep = 0; (void)rep; p0_prologue(F); __syncthreads(); }
    SEAM(0);
    if (IN(1)) { constexpr int rep = 0; (void)rep;
        RX(10) { SEpiStore E{WSP(float, WS_PROJS), INC, 1.f}; skinny_gemm<true>(F, F.in[1], DM, WSP(const bf16, WS_WIN), DM, DM, INC / 16, 1, E); }
        { pg8::Gemm g{WSP(const pb, WS_H), WSP(const pb, WS_WIN), MP, INP, DM}; pg8::StaticOrder S; S.init(MP, INP, F.G, F.blk);
          pg8::EpiScale<0, 1> E{WSP(pb, WS_PROJ), INP, WSP(const float, WS_SSQ0), 1.f}; pg8::gemm_phase<pg8::EpiScale<0, 1>, pg8::StaticOrder, true, true>(F.lds, F.wave, g, S, E); }
    }
    SEAM(1);
    if (IN(2)) { constexpr int rep = 0; (void)rep; RX(7) s_mixers(F); if (F.G != 256) { RX(6) p2_pool_prompt(F, F.blk, F.G); } RX(5) p2_gla_local(F); }
    SEAM(2);
    if (IN(3)) { constexpr int rep = 0; (void)rep;
        { SEpiRes E{F.in[1], F.out + O_YS}; skinny_gemm<false>(F, WSP(const float, WS_MIXS), DM, WSP(const bf16, WS_WOUT), DM, DM, DM / 16, 1, E); }
        RX(2) p3_gla_scan(F);
        if (F.G == 256 && F.blk >= 192) p2_pool_prompt(F, F.blk - 192, 64);
        { pg8::Gemm g{WSP(const pb, WS_MN), WSP(const pb, WS_WKV), NB * 256, 2048, DM}; RotOrder S; S.init(NB * 256, 2048, F.G, F.blk, 128);
          pg8::EpiKV E{F.out + O_KP, F.out + O_VP, WSP(pb, WS_KB), WSP(pb, WS_VT), WSP(const float, WS_SSQ0) + MP}; pg8::gemm_phase<pg8::EpiKV, RotOrder, true, true>(F.lds, F.wave, g, S, E); }
    }
    SEAM(3);
    if (IN(4)) { constexpr int rep = 0; (void)rep;
        RX(4) { SEpiStore E{WSP(float, WS_QS), DM, 0.0625f}; skinny_gemm<true>(F, F.out + O_YS, DM, WSP(const bf16, WS_WQM), DM, DM, DM / 16, 1, E); }
        RX(3) p4_gla_out(F, DM / 16);
    }
    SEAM(4);
    if (IN(5)) { constexpr int rep = 0; (void)rep;
        if (F.blk & 1) { RX(9) s_attn(F); }
        { pg8::Gemm g{WSP(const pb, WS_H), WSP(const pb, WS_WOUT), MP, DM, DM}; pg8::StaticOrder S; S.init(MP, DM, F.G, F.blk);
          pg8::EpiRes<true, true, true, false, false> E{F.in[0], nullptr, WSP(pb, WS_XB), WSP(float, WS_SSQ1)}; pg8::gemm_phase<pg8::EpiRes<true, true, true, false, false>, pg8::StaticOrder, true, true>(F.lds, F.wave, g, S, E); }
        if (!(F.blk & 1)) { __syncthreads(); s_attn(F); }
    }
    SEAM(5);
    if (IN(6)) { constexpr int rep = 0; (void)rep;
        if (rep == 0) { SEpiAtomic E{F.out + O_YS, 1.f}; skinny_gemm<false>(F, WSP(const float, WS_CTXS), DM, WSP(const bf16, WS_WOM), DM, 256, DM / 16, 4, E); }
        { pg8::Gemm g{WSP(const pb, WS_XB), WSP(const pb, WS_WQM), MP, DM, DM}; pg8::StaticOrder S; S.init(MP, DM, F.G, F.blk);
          pg8::EpiScale<0> E{WSP(pb, WS_Q), DM, WSP(const float, WS_SSQ1), 0.0625f}; pg8::gemm_phase<pg8::EpiScale<0>, pg8::StaticOrder, true, true>(F.lds, F.wave, g, S, E); }
    }
    SEAM(6);
    if (IN(7)) { constexpr int rep = 0; (void)rep;
        if (F.blk & 1) { RX(0) { SEpiRelu2 E{WSP(float, WS_HFFS)}; skinny_gemm<true>(F, F.out + O_YS, DM, WSP(const bf16, WS_WUP), DM, DM, FF / 16, 1, E); } }
        __syncthreads();
        RX(1) p7_attn_prompt(F);
        if (!(F.blk & 1)) { SEpiRelu2 E{WSP(float, WS_HFFS)}; skinny_gemm<true>(F, F.out + O_YS, DM, WSP(const bf16, WS_WUP), DM, DM, FF / 16, 1, E); }
    }
    SEAM(7);
    if (IN(8)) { constexpr int rep = 0; (void)rep;
        if (F.blk & 1) { SEpiPart E{WSP(float, WS_PARTS)}; skinny_gemm<false>(F, WSP(const float, WS_HFFS), FF, WSP(const bf16, WS_WDN), FF, DM, DM / 16, 4, E); }
        { pg8::Gemm g{WSP(const pb, WS_CTX), WSP(const pb, WS_WOM), MP, DM, DM}; pg8::StaticOrder S; S.init(MP, DM, F.G, F.blk);
          pg8::EpiRes<true, true, false, true, false> E{nullptr, nullptr, WSP(pb, WS_XB), WSP(float, WS_SSQ2)}; pg8::gemm_phase<pg8::EpiRes<true, true, false, true, false>, pg8::StaticOrder, true, true>(F.lds, F.wave, g, S, E); }
        if (!(F.blk & 1)) { SEpiPart E{WSP(float, WS_PARTS)}; skinny_gemm<false>(F, WSP(const float, WS_HFFS), FF, WSP(const bf16, WS_WDN), FF, DM, DM / 16, 4, E); }
    }
    SEAM(8);
    if (IN(9)) { constexpr int rep = 0; (void)rep;
        if (rep == 0) final_norm_sample(F);
        { pg8::Gemm g{WSP(const pb, WS_XB), WSP(const pb, WS_WUP), MP, FF, DM}; pg8::StaticOrder S; S.init(MP, FF, F.G, F.blk);
          pg8::EpiScale<1> E{WSP(pb, WS_HFF), FF, WSP(const float, WS_SSQ2), 1.f}; pg8::gemm_phase<pg8::EpiScale<1>, pg8::StaticOrder, true, true>(F.lds, F.wave, g, S, E); }
    }
    SEAM(9);
    if (IN(10)) { constexpr int rep = 0; (void)rep;
        pg8::Gemm g{WSP(const pb, WS_HFF), WSP(const pb, WS_WDN), MP, DM, FF}; pg8::StaticOrder S; S.init(MP, DM, F.G, F.blk);
        if (F.G == 256) {
            pg8::EpiResRms E{WSP(const pb, WS_XB), F.out + O_YP, F.in[24], WSP(unsigned, WS_SSQ1), (unsigned*)(args.ws + 32768)};
            pg8::gemm_phase<pg8::EpiResRms, pg8::StaticOrder, false, true>(F.lds, F.wave, g, S, E);
        } else { pg8::EpiRes<false, false, false, true, true> E{nullptr, F.out + O_YP, WSP(pb, WS_XB), nullptr}; pg8::gemm_phase<pg8::EpiRes<false, false, false, true, true>, pg8::StaticOrder, true, true>(F.lds, F.wave, g, S, E); }
    }
    if (F.G != 256) SEAM(10);
    if (IN(11) && F.G != 256) { constexpr int rep = 0; (void)rep; final_norm_prompt(F); }
    if ((REPX >> 8) & 1) { for (int q = 0; q < 4; ++q) { GRID_BAR(); } }
#undef IN
#undef SEAM
}

extern "C" void kernel_launch(void* const* d_in, const int* in_sizes, int n_in, void* d_out, int out_size, void* d_ws, size_t ws_size, hipStream_t stream) {
    static int grid = 0;
    if (grid == 0) {
        if (n_in != 25 || ws_size < WS_END) { fprintf(stderr, "kernel_launch: unexpected inputs (n_in %d, ws %zu)\n", n_in, ws_size); grid = -1; return; }
        int dev = 0, cus = 0, per_cu = 0;
        hipGetDevice(&dev); hipDeviceGetAttribute(&cus, hipDeviceAttributeMultiprocessorCount, dev);
        if (hipFuncSetAttribute((const void*)mk_fwd, hipFuncAttributeMaxDynamicSharedMemorySize, LDS_BYTES) != hipSuccess) { fprintf(stderr, "kernel_launch: hipFuncSetAttribute failed\n"); grid = -1; return; }
        if (hipOccupancyMaxActiveBlocksPerMultiprocessor(&per_cu, (const void*)mk_fwd, NWAVES * 64, LDS_BYTES) != hipSuccess || per_cu < 1) { fprintf(stderr, "kernel_launch: occupancy query says %d\n", per_cu); per_cu = 1; }
        (void)hipGetLastError();
        grid = cus * 1;
        fprintf(stderr, "kernel_launch: grid %d (cus %d, per_cu %d)\n", grid, cus, per_cu);
    }
    if (grid < 0) return;
    if (hipMemsetAsync(d_ws, 0, 65536, stream) != hipSuccess) { fprintf(stderr, "kernel_launch: memset failed\n"); return; }
    Args a{};
    for (int i = 0; i < 25; ++i) a.in[i] = (const float*)d_in[i];
    a.out = (float*)d_out; a.ws = (unsigned char*)d_ws;
#if MK_N_LAUNCHES == 1
    a.ph_lo = 0; a.ph_hi = N_PHASES;
    void* kargs[] = {&a};
    hipError_t e = hipLaunchCooperativeKernel((const void*)mk_fwd, dim3(grid), dim3(NWAVES * 64), kargs, LDS_BYTES, stream);
    if (e != hipSuccess) fprintf(stderr, "cooperative launch failed: %s (grid %d)\n", hipGetErrorString(e), grid);
#else
    for (int p = 0; p < N_PHASES; ++p) { a.ph_lo = p; a.ph_hi = p + 1; hipLaunchKernelGGL(mk_fwd, dim3(grid), dim3(NWAVES * 64), LDS_BYTES, stream, a); }
#endif
}
```
